# Optimizing an MI355X kernel written in HIP

```python
import jax, jax.numpy as jnp
from jax import lax
import numpy as np

D_MODEL = 1024
BATCH = 1
SEQ = 16384
DEPTH = 1
DEC_BATCH = 16
DEC_SEQ = 16
PAST_LEN = 2048

CHUNK = 64
GLA_HEADS = 4
GLA_DK = 128
GLA_DV = 256
GLA_KEY = GLA_HEADS * GLA_DK
GLA_VAL = GLA_HEADS * GLA_DV
GLA_LOWRANK = 16
GLA_TAU = 16.0
GMLP_CHUNK = 128
GMLP_GROUPS = 4
GMLP_WIDTH = 1024
GMLP_DG = GMLP_WIDTH // GMLP_GROUPS
N_BRANCH = 2
EPS = 1e-6
PROJ_SIZES = (GLA_KEY, GLA_KEY, GLA_VAL, GLA_VAL, GLA_LOWRANK,
              GMLP_WIDTH, GMLP_WIDTH, GMLP_WIDTH, D_MODEL, D_MODEL)
PROJ_COLS = GLA_KEY * 2 + GLA_VAL * 2 + GLA_LOWRANK + GMLP_WIDTH * 3 + D_MODEL * N_BRANCH

kernel_name = "hybrid_gla_gmlp_stream_step"


def _split_points():
    pts, acc = [], 0
    for s in PROJ_SIZES[:-1]:
        acc += s
        pts.append(acc)
    return pts


def rmsnorm(x, w):
    xf = x.astype(jnp.float32)
    y = xf * lax.rsqrt(jnp.mean(xf * xf, axis=-1, keepdims=True) + EPS)
    return (y * w.astype(jnp.float32)).astype(x.dtype)


def layernorm(x, w, b):
    xf = x.astype(jnp.float32)
    mu = jnp.mean(xf, axis=-1, keepdims=True)
    var = jnp.mean(jnp.square(xf - mu), axis=-1, keepdims=True)
    y = (xf - mu) * lax.rsqrt(var + EPS)
    return (y * w.astype(jnp.float32) + b.astype(jnp.float32)).astype(x.dtype)


def gla_chunked(q, k, v, log_a, S0):
    B, L, H, _ = q.shape
    C = min(CHUNK, L)
    N = L // C
    def to_chunks(t):
        return t.astype(jnp.float32).reshape(B, N, C, H, t.shape[-1]).transpose(1, 0, 2, 3, 4)
    qc, kc, vc = to_chunks(q), to_chunks(k), to_chunks(v)
    bc = jnp.cumsum(to_chunks(log_a), axis=2)
    mask = jnp.tril(jnp.ones((C, C), dtype=bool))

    def step(S, inp):
        qn, kn, vn, bn = inp
        diff = bn[:, :, None] - bn[:, None, :]
        dec = jnp.exp(jnp.where(mask[None, :, :, None, None], diff, -jnp.inf))
        A = jnp.einsum('bthk,btshk,bshk->bhts', qn, dec, kn)
        intra = jnp.einsum('bhts,bshv->bthv', A, vn)
        inter = jnp.einsum('bthk,bhkv->bthv', qn * jnp.exp(bn), S)
        b_last = bn[:, -1]
        S = jnp.exp(b_last)[..., None] * S + jnp.einsum(
            'bshk,bshv->bhkv', kn * jnp.exp(b_last[:, None] - bn), vn)
        return S, intra + inter

    S_fin, o = lax.scan(step, S0.astype(jnp.float32), (qc, kc, vc, bc))
    o = o.transpose(1, 0, 2, 3, 4).reshape(B, L, H, v.shape[-1])
    return o, S_fin


def mixer_layer(x, c, S0, norm_w, w_ada, b_ada, w_in, w_a2, b_a, gla_norm_w,
                ln_v_w, ln_v_b, w_s, b_s, b_gate, w_proj_a, w_proj_b, w_out):
    B, L, _ = x.shape
    ada = jax.nn.silu(c) @ w_ada + b_ada
    shift, scale, gate = jnp.split(ada[:, None, :], 3, axis=-1)
    h = rmsnorm(x, norm_w) * (1.0 + scale) + shift
    proj = h @ w_in
    q, k, v, r, a_lr, u, gv, z, g_a, g_b = jnp.split(proj, _split_points(), axis=-1)

    log_a = jax.nn.log_sigmoid((a_lr @ w_a2 + b_a).astype(jnp.float32)) / GLA_TAU
    q = q.reshape(B, L, GLA_HEADS, GLA_DK) * (GLA_DK ** -0.5)
    k = k.reshape(B, L, GLA_HEADS, GLA_DK)
    v = v.reshape(B, L, GLA_HEADS, GLA_DV)
    log_a = log_a.reshape(B, L, GLA_HEADS, GLA_DK)
    o, S_new = gla_chunked(q, k, v, log_a, S0)
    o = rmsnorm(o, gla_norm_w).astype(x.dtype).reshape(B, L, GLA_VAL)
    y_a = (o * jax.nn.silu(r)) @ w_proj_a

    vn = layernorm(gv, ln_v_w, ln_v_b)
    C = min(GMLP_CHUNK, L)
    N = L // C
    idx = jnp.arange(C) // CHUNK
    smask = idx[:, None] >= idx[None, :]
    ws = jnp.where(smask[None], w_s[:, :C, :C], 0.0)
    vg = vn.reshape(B, N, C, GMLP_GROUPS, GMLP_DG)
    s = jnp.einsum('gij,bnjgc->bnigc', ws, vg) + b_s[:, :C].T[None, None, :, :, None]
    s = s.reshape(B, L, GMLP_WIDTH)
    y_b = (u * s * jax.nn.silu(z)) @ w_proj_b

    merged = jax.nn.sigmoid(g_a + b_gate[0]) * y_a + jax.nn.sigmoid(g_b + b_gate[1]) * y_b
    x = x + gate * (merged @ w_out)
    return x, S_new, vn


def setup_inputs(seed: int = 0) -> dict:
    key = jax.random.key(seed)
    ks = jax.random.split(key, 24)
    f32 = jnp.float32
    nrm = lambda k, shape, s: jax.random.normal(k, shape, f32) * s
    return {
        'x_prompt': nrm(ks[0], (BATCH, SEQ, D_MODEL), 1.0),
        'x_sample': nrm(ks[1], (DEC_BATCH, DEC_SEQ, D_MODEL), 1.0),
        'state_gla': nrm(ks[2], (DEPTH, DEC_BATCH, GLA_HEADS, GLA_DK, GLA_DV), 0.1),
        'c_prompt': nrm(ks[3], (BATCH, D_MODEL), 1.0),
        'c_sample': nrm(ks[4], (DEC_BATCH, D_MODEL), 1.0),
        'norm_w': 1.0 + nrm(ks[5], (DEPTH, D_MODEL), 0.02),
        'w_ada': nrm(ks[6], (DEPTH, D_MODEL, 3 * D_MODEL), 0.5 * D_MODEL ** -0.5),
        'b_ada': nrm(ks[7], (DEPTH, 3 * D_MODEL), 0.02),
        'w_in': nrm(ks[8], (DEPTH, D_MODEL, PROJ_COLS), D_MODEL ** -0.5),
        'w_a2': nrm(ks[9], (DEPTH, GLA_LOWRANK, GLA_KEY), GLA_LOWRANK ** -0.5),
        'b_a': nrm(ks[10], (DEPTH, GLA_KEY), 0.1),
        'gla_norm_w': 1.0 + nrm(ks[11], (DEPTH, GLA_DV), 0.02),
        'ln_v_w': 1.0 + nrm(ks[12], (DEPTH, GMLP_WIDTH), 0.02),
        'ln_v_b': nrm(ks[13], (DEPTH, GMLP_WIDTH), 0.02),
        'w_s': nrm(ks[14], (DEPTH, GMLP_GROUPS, GMLP_CHUNK, GMLP_CHUNK), GMLP_CHUNK ** -0.5),
        'b_s': 1.0 + nrm(ks[15], (DEPTH, GMLP_GROUPS, GMLP_CHUNK), 0.02),
        'b_gate': nrm(ks[16], (DEPTH, N_BRANCH, D_MODEL), 0.02),
        'w_proj_a': nrm(ks[17], (DEPTH, GLA_VAL, D_MODEL), GLA_VAL ** -0.5),
        'w_proj_b': nrm(ks[18], (DEPTH, GMLP_WIDTH, D_MODEL), GMLP_WIDTH ** -0.5),
        'w_out': nrm(ks[19], (DEPTH, D_MODEL, D_MODEL), D_MODEL ** -0.5),
        'final_norm_w': 1.0 + nrm(ks[20], (D_MODEL,), 0.02),
    }


def reference(x_prompt, x_sample, state_gla, c_prompt, c_sample, norm_w, w_ada, b_ada,
              w_in, w_a2, b_a, gla_norm_w, ln_v_w, ln_v_b, w_s, b_s, b_gate,
              w_proj_a, w_proj_b, w_out, final_norm_w):
    xp, xs = x_prompt, x_sample
    sp_list, ss_list, vs_list = [], [], []
    for l in range(DEPTH):
        params = (norm_w[l], w_ada[l], b_ada[l], w_in[l], w_a2[l], b_a[l], gla_norm_w[l],
                  ln_v_w[l], ln_v_b[l], w_s[l], b_s[l], b_gate[l],
                  w_proj_a[l], w_proj_b[l], w_out[l])
        s0_prompt = jnp.zeros((xp.shape[0], GLA_HEADS, GLA_DK, GLA_DV), jnp.float32)
        xp, sp, _ = mixer_layer(xp, c_prompt, s0_prompt, *params)
        xs, ss, vs = mixer_layer(xs, c_sample, state_gla[l], *params)
        sp_list.append(sp)
        ss_list.append(ss)
        vs_list.append(vs)
    y_prompt = rmsnorm(xp, final_norm_w)
    y_sample = rmsnorm(xs, final_norm_w)
    new_state_gla_prompt = jnp.stack(sp_list)
    new_state_gla_sample = jnp.stack(ss_list)
    new_gmlp_v_sample = jnp.stack(vs_list)
    return (y_prompt, y_sample, new_state_gla_prompt, new_state_gla_sample, new_gmlp_v_sample)
```

```cpp
#include <hip/hip_runtime.h>
#include <cstdio>

#define LAS __attribute__((address_space(3)))
typedef unsigned short bf16_t;
typedef short bf16x8 __attribute__((ext_vector_type(8)));
typedef short s16x4 __attribute__((ext_vector_type(4)));
typedef float f32x4 __attribute__((ext_vector_type(4)));
typedef float f32x2 __attribute__((ext_vector_type(2)));
typedef unsigned u32x4 __attribute__((ext_vector_type(4)));
typedef unsigned u32x2 __attribute__((ext_vector_type(2)));

constexpr int D = 1024, SEQ = 16384, NSAMP = 16, SAMP_T = 16, MTOT = SEQ + NSAMP * SAMP_T;
constexpr int WIN_LD = 8208;
constexpr int PJ = 7168;
constexpr int PC_Q = 0, PC_K = 512, PC_V = 1024, PC_R = 2048, PC_UZ = 3072, PC_GV = 4096, PC_GA = 5120;
constexpr int N1 = 8256;
constexpr int NSEG = 64, SEGCH = 4;
constexpr float EPS = 1e-6f;
constexpr int GEMM1_WGM = 4;
constexpr size_t WS_CTL = 0, WS_PCNT = 16384, WS_ADA = 32768, WS_ALR = WS_ADA + 17 * 3072 * 4, WS_DSEG = WS_ALR + (size_t)MTOT * 16 * 4,
                 WS_ROWSS = WS_DSEG + NSEG * 4 * 128 * 4, WS_BTA = WS_ROWSS + (size_t)MTOT * 16 * 4, WS_BTB = WS_BTA + 2097152,
                 WS_BTO = WS_BTB + 2097152, WS_PROJ = WS_BTO + 4194304, WS_GVST = WS_PROJ + (size_t)MTOT * PJ * 2, WS_DCH = WS_GVST + (size_t)SEQ * 16 * 8, WS_XB = WS_DCH + (size_t)272 * 4 * 128 * 4, WS_END = WS_XB + (size_t)64 * 256 * 4 * 4;
constexpr size_t RB_H = 0, RB_BT1 = (size_t)MTOT * D * 2, RB_USEG = 0, RB_SSTART = 16777216;
constexpr size_t OUT_YS = (size_t)SEQ * D, OUT_SP = OUT_YS + 256 * D, OUT_SS = OUT_SP + 4 * 128 * 256, OUT_VS = OUT_SS + 16 * 4 * 128 * 256;
constexpr int LDS_BAR = 156160, LDS_BYTES = 156672;

struct Params {
    const float* x_prompt; const float* x_sample; const float* state_gla; const float* c_prompt; const float* c_sample;
    const float* norm_w; const float* w_ada; const float* b_ada; const float* w_in; const float* w_a2; const float* b_a;
    const float* gla_norm_w; const float* ln_v_w; const float* ln_v_b; const float* w_s; const float* b_s; const float* b_gate;
    const float* w_proj_a; const float* w_proj_b; const float* w_out; const float* final_norm_w;
    float* out; unsigned char* ws; int ph_lo; int ph_hi;
};

__device__ __forceinline__ unsigned cvt_pk_bf16(float lo, float hi) { unsigned r; asm volatile("v_cvt_pk_bf16_f32 %0, %1, %2" : "=v"(r) : "v"(lo), "v"(hi)); return r; }
__device__ __forceinline__ bf16_t f2bf(float f) { return (bf16_t)(cvt_pk_bf16(f, 0.f) & 0xffffu); }
__device__ __forceinline__ float bf2f(bf16_t b) { return __uint_as_float(((unsigned)b) << 16); }
__device__ __forceinline__ float bflo(unsigned w) { return __uint_as_float(w << 16); }
__device__ __forceinline__ float bfhi(unsigned w) { return __uint_as_float(w & 0xffff0000u); }
__device__ __forceinline__ float sigmoidf_(float x) { return __builtin_amdgcn_rcpf(1.0f + __expf(-x)); }
__device__ __forceinline__ float siluf_(float x) { return x * __builtin_amdgcn_rcpf(1.0f + __expf(-x)); }
__device__ __forceinline__ float wave_sum(float v) {
#pragma unroll
    for (int o = 32; o > 0; o >>= 1) v += __shfl_xor(v, o);
    return v;
}
__device__ __forceinline__ bf16x8 row_frag(const LAS unsigned char* base, int rs, int lane) { return *(const LAS bf16x8*)(base + rs * (lane & 15) + 16 * (lane >> 4)); }
__device__ __forceinline__ bf16x8 tr_frag(const LAS unsigned char* base, int rs, int lane) {
    const int g = lane >> 4, q = (lane & 15) >> 2, pp = lane & 3;
    const LAS unsigned char* a = base + rs * (8 * g + q) + 8 * pp;
    const s16x4 lo = __builtin_amdgcn_ds_read_tr16_b64_v4i16((LAS s16x4*)a);
    const s16x4 hi = __builtin_amdgcn_ds_read_tr16_b64_v4i16((LAS s16x4*)(a + 4 * rs));
    bf16x8 r; r[0] = lo[0]; r[1] = lo[1]; r[2] = lo[2]; r[3] = lo[3]; r[4] = hi[0]; r[5] = hi[1]; r[6] = hi[2]; r[7] = hi[3]; return r;
}
#define MFMA16(a, b, c) __builtin_amdgcn_mfma_f32_16x16x32_bf16(a, b, c, 0, 0, 0)

#define XB_TMO      128
#define XB_XCNT(j)  (256  + 64 * (j))
#define XB_XSUB(j)  (1280 + 64 * (j))
#define XB_XGEN(j)  (2304 + 64 * (j))
#define XB_TOP      3328
#define XB_TOPGEN   3392
#define XCD_BAR_WORDS 3456
#define XB_SPIN_CAP (1u << 22)
__device__ __forceinline__ unsigned xb_ld(unsigned* p)              { return __hip_atomic_load(p, __ATOMIC_RELAXED, __HIP_MEMORY_SCOPE_AGENT); }
__device__ __forceinline__ unsigned xb_add(unsigned* p, unsigned v) { return __hip_atomic_fetch_add(p, v, __ATOMIC_RELAXED, __HIP_MEMORY_SCOPE_AGENT); }
__device__ __forceinline__ unsigned xb_xcc_id() { return (unsigned)__builtin_amdgcn_s_getreg((3 << 11) | 20) & 0xFu; }
#define XB_SPIN(cond, bar) do { unsigned _sp = 0; while (cond) { __builtin_amdgcn_s_sleep(1); \
    if ((++_sp & 255u) == 0u) { if (xb_ld(&(bar)[XB_TMO])) break; if (_sp > XB_SPIN_CAP) { atomicAdd(&(bar)[XB_TMO], 1u); break; } } } } while (0)
struct XcdBarrier { unsigned* bar; unsigned x; volatile LAS unsigned* st; };
__device__ __forceinline__ XcdBarrier xcd_barrier_post(unsigned* bar, volatile LAS unsigned* st) {
    XcdBarrier b; b.bar = bar; b.x = xb_xcc_id(); b.st = st;
    if (threadIdx.x == 0) (void)xb_add(&bar[XB_XCNT(b.x)], 1u);
    return b;
}
__device__ __forceinline__ void xcd_barrier_complete(unsigned* bar, unsigned x, unsigned& nloc, unsigned& nx) {
    const unsigned G = gridDim.x * gridDim.y * gridDim.z;
    unsigned sum, cnt, mine, sp = 0u;
    for (;;) {
        sum = 0u; cnt = 0u; mine = 0u;
#pragma unroll
        for (unsigned j = 0; j < 16; ++j) { const unsigned c = xb_ld(&bar[XB_XCNT(j)]); sum += c; cnt += (c > 0u) ? 1u : 0u; mine = (j == x) ? c : mine; }
        if (sum == G) break;
        __builtin_amdgcn_s_sleep(1);
        if ((++sp & 255u) == 0u) { if (xb_ld(&bar[XB_TMO])) break; if (sp > XB_SPIN_CAP) { atomicAdd(&bar[XB_TMO], 1u); break; } }
    }
    nloc = mine > 0u ? mine : 1u; nx = cnt > 0u ? cnt : 1u;
}
__device__ __forceinline__ void xcd_barrier(const XcdBarrier& b) {
    asm volatile("s_waitcnt vmcnt(0)" ::: "memory");
    __syncthreads();
    if (threadIdx.x == 0) {
        unsigned* bar = b.bar;
        __builtin_amdgcn_s_waitcnt(0);
        unsigned nloc = b.st[0], nx = b.st[1];
        if (nloc == 0u) { xcd_barrier_complete(bar, b.x, nloc, nx); b.st[0] = nloc; b.st[1] = nx; }
        const unsigned old = xb_add(&bar[XB_XSUB(b.x)], 1u);
        const unsigned gen = old / nloc;
        if (old + 1u == (gen + 1u) * nloc) {
            __builtin_amdgcn_fence(__ATOMIC_RELEASE, "agent");
            asm volatile("s_waitcnt vmcnt(0)" ::: "memory");
            const unsigned og = xb_add(&bar[XB_TOP], 1u);
            const unsigned tg = og / nx;
            if (og + 1u == (tg + 1u) * nx) xb_add(&bar[XB_TOPGEN], 1u);
            else XB_SPIN(xb_ld(&bar[XB_TOPGEN]) == tg, bar);
            __builtin_amdgcn_fence(__ATOMIC_ACQUIRE, "agent");
            xb_add(&bar[XB_XGEN(b.x)], 1u);
            asm volatile("s_waitcnt vmcnt(0)" ::: "memory");
        } else {
            XB_SPIN(xb_ld(&bar[XB_XGEN(b.x)]) == gen, bar);
            __builtin_amdgcn_fence(__ATOMIC_ACQUIRE, "agent");
            asm volatile("s_waitcnt vmcnt(0)" ::: "memory");
        }
    }
    __syncthreads();
}

namespace pg8 {
constexpr int BM = 256, BK = 64, HALF = 128, HTB = HALF * BK * 2, NXCD = 8, WGM = 8;
__device__ __forceinline__ int lds_byte(int r, int c) { const int st = (r >> 4) * 2 + (c >> 5), rr = r & 15, cc = c & 31, ob = rr * 64 + cc * 2; return st * 1024 + (ob ^ (((ob >> 9) & 1) << 5)); }
__device__ __forceinline__ void stage_rc(int b, int& R, int& C) { const int st = b / 1024, sb = b % 1024, swz = sb ^ (((sb >> 9) & 1) << 5); R = (st >> 1) * 16 + swz / 64; C = (st & 1) * 32 + (swz % 64) / 2; }
__device__ __forceinline__ int perm32(int rho) { const int n = rho >> 4, i = rho & 15; return 8 * (i >> 2) + 4 * n + (i & 3); }
struct Unit { int pm, pn; };
struct Order {
    int nM, nN, nwg, G, c, wgm;
    __device__ void init(int nM_, int nN_, int G_, int c_) { nM = nM_; nN = nN_; nwg = nM * nN; G = G_; c = c_; wgm = WGM; }
    __device__ bool next(int i, Unit& u) const {
        const long L = (long)i * G + c; if (L >= nwg) return false;
        int wgid = (int)L; { const int q = nwg / NXCD, r = nwg % NXCD, xcd = wgid % NXCD, off = wgid / NXCD; wgid = (xcd < r ? xcd * (q + 1) : r * (q + 1) + (xcd - r) * q) + off; }
        const int nig = wgm * nN, gid = wgid / nig, fm = gid * wgm, gsz = (nM - fm) < wgm ? (nM - fm) : wgm;
        u.pm = fm + ((wgid % nig) % gsz); u.pn = (wgid % nig) / gsz; return true;
    }
};
struct Order2 {
    int c;
    __device__ bool next(int i, Unit& u) const { if (i >= 2) return false; const int x = c & 7, q = c >> 3; u.pm = x * 8 + (q >> 2); u.pn = (q & 3) + 4 * i; return true; }
};
template <class Epi, class Ptr, class Ord>
__device__ __forceinline__ void gemm_phase(LAS unsigned char* lds, const Ord& S, const Ptr& P, const Epi& E, int K, int lda, int ldb) {
    int tid_ = threadIdx.x; asm volatile("" : "+v"(tid_));
    const int tid = tid_, wid = __builtin_amdgcn_readfirstlane(tid >> 6), lane = tid & 63, wr = wid >> 2, wc = wid & 3, fr = lane & 15, fq = lane >> 4;
    const int nt = K / BK;
    unsigned voffA[2], voffB[2];
#pragma unroll
    for (int i = 0; i < 2; ++i) { int R, C; stage_rc(tid * 16 + i * 8192, R, C); const int Rb = Epi::PERM ? ((R & ~31) + perm32(R & 31)) : R;
        voffA[i] = (unsigned)(R * lda + C) * 2u; voffB[i] = (unsigned)(Rb * ldb + C) * 2u; }
    const size_t kstep = (size_t)(BK * 2);
    const size_t hstepA = (size_t)HALF * lda * 2, hstepB = (size_t)HALF * ldb * 2;
    const unsigned ldsw = (unsigned)wid * 1024u;
    const int aoff = lds_byte(wr * 64 + fr, fq * 8), boff = lds_byte(wc * 32 + fr, fq * 8);
#define PG8_SA(b, h) (((b) * 2 + (h)) * HTB)
#define PG8_SB(b, h) ((4 + (b) * 2 + (h)) * HTB)
#define PG8_STAGE(bufoff, gbase, voff) do { _Pragma("unroll") for (int _i = 0; _i < 2; ++_i) \
        __builtin_amdgcn_global_load_lds((const unsigned*)((const char*)(gbase) + (voff)[_i]), (LAS unsigned*)(lds + (bufoff) + ldsw + _i * 8192), 16, 0, 0); } while (0)
#define PG8_LDA(dst, b, h) do { _Pragma("unroll") for (int m = 0; m < 4; ++m) _Pragma("unroll") for (int k = 0; k < 2; ++k) dst[m][k] = *(const LAS bf16x8*)(lds + PG8_SA(b, h) + aoff + m * 2048 + k * 1024); } while (0)
#define PG8_LDB(dst, b, h) do { _Pragma("unroll") for (int n = 0; n < 2; ++n) _Pragma("unroll") for (int k = 0; k < 2; ++k) dst[n][k] = *(const LAS bf16x8*)(lds + PG8_SB(b, h) + boff + n * 2048 + k * 1024); } while (0)
#define PG8_MMA(ai, bj, At, Bt) do { __builtin_amdgcn_s_setprio(1); _Pragma("unroll") for (int m = 0; m < 4; ++m) _Pragma("unroll") for (int n = 0; n < 2; ++n) _Pragma("unroll") for (int k = 0; k < 2; ++k) \
        acc[ai][bj][m][n] = __builtin_amdgcn_mfma_f32_16x16x32_bf16(Bt[n][k], At[m][k], acc[ai][bj][m][n], 0, 0, 0); __builtin_amdgcn_s_setprio(0); } while (0)
#define PG8_WAIT_V(n) asm volatile("s_waitcnt vmcnt(" #n ")" ::: "memory")
#define PG8_WAIT_L(n) asm volatile("s_waitcnt lgkmcnt(" #n ")" ::: "memory")
#define PG8_BAR __builtin_amdgcn_s_barrier()
#define PG8_SCHED __builtin_amdgcn_sched_barrier(0)
    Unit cur, nxt; int ui = 0;
    if (!S.next(0, cur)) return;
    f32x4 acc[2][2][4][2];
#pragma unroll
    for (int a = 0; a < 2; ++a)
#pragma unroll
        for (int b = 0; b < 2; ++b)
#pragma unroll
            for (int m = 0; m < 4; ++m)
#pragma unroll
                for (int n = 0; n < 2; ++n) acc[a][b][m][n] = (f32x4){0.f, 0.f, 0.f, 0.f};
    bf16x8 At[4][2], B0[2][2], B1[2][2];
    const char* cA = P.aptr(cur); const char* cB = P.bptr(cur);
    PG8_STAGE(PG8_SB(0, 0), cB, voffB); PG8_STAGE(PG8_SA(0, 0), cA, voffA); PG8_STAGE(PG8_SB(0, 1), cB + hstepB, voffB); PG8_STAGE(PG8_SA(0, 1), cA + hstepA, voffA);
    if (wr == 1) PG8_BAR;
    PG8_WAIT_V(4); PG8_BAR;
    PG8_STAGE(PG8_SB(1, 0), cB + kstep, voffB); PG8_STAGE(PG8_SA(1, 0), cA + kstep, voffA); PG8_STAGE(PG8_SB(1, 1), cB + hstepB + kstep, voffB);
    PG8_WAIT_V(6); PG8_BAR;
    for (;;) {
        const bool has_next = S.next(ui + 1, nxt);
        const char* nA = has_next ? P.aptr(nxt) : cA; const char* nB = has_next ? P.bptr(nxt) : cB;
        for (int t = 0; t < nt; t += 2) {
            const bool last = (t == nt - 2);
            const char* a1 = cA + (size_t)(t + 1) * kstep;
            const char* a2 = last ? nA : cA + (size_t)(t + 2) * kstep; const char* b2 = last ? nB : cB + (size_t)(t + 2) * kstep;
            const char* a3 = a2 + kstep; const char* b3 = b2 + kstep;
            PG8_LDB(B0, 0, 0); PG8_SCHED; PG8_LDA(At, 0, 0); PG8_STAGE(PG8_SA(1, 1), a1 + hstepA, voffA);
            PG8_WAIT_L(8); PG8_BAR; PG8_WAIT_L(0); PG8_MMA(0, 0, At, B0); PG8_BAR; PG8_SCHED;
            PG8_LDB(B1, 0, 1); PG8_STAGE(PG8_SB(0, 0), b2, voffB);
            PG8_BAR; PG8_WAIT_L(0); PG8_MMA(0, 1, At, B1); PG8_BAR;
            PG8_LDA(At, 0, 1); PG8_STAGE(PG8_SA(0, 0), a2, voffA);
            PG8_BAR; PG8_WAIT_L(0); PG8_MMA(1, 0, At, B0); PG8_BAR; PG8_SCHED;
            PG8_STAGE(PG8_SB(0, 1), b2 + hstepB, voffB);
            PG8_WAIT_V(6); PG8_BAR; PG8_MMA(1, 1, At, B1); PG8_BAR;
            PG8_LDB(B0, 1, 0); PG8_SCHED; PG8_LDA(At, 1, 0); PG8_STAGE(PG8_SA(0, 1), a2 + hstepA, voffA);
            PG8_WAIT_L(8); PG8_BAR; PG8_WAIT_L(0); PG8_MMA(0, 0, At, B0); PG8_BAR; PG8_SCHED;
            PG8_LDB(B1, 1, 1); PG8_STAGE(PG8_SB(1, 0), b3, voffB);
            PG8_BAR; PG8_WAIT_L(0); PG8_MMA(0, 1, At, B1); PG8_BAR;
            PG8_LDA(At, 1, 1); PG8_STAGE(PG8_SA(1, 0), a3, voffA);
            PG8_BAR; PG8_WAIT_L(0); PG8_MMA(1, 0, At, B0); PG8_BAR; PG8_SCHED;
            PG8_STAGE(PG8_SB(1, 1), b3 + hstepB, voffB);
            PG8_WAIT_V(6); PG8_BAR; PG8_MMA(1, 1, At, B1); PG8_BAR;
        }
        bool keep = false;
        if constexpr (!Epi::AFTER_DRAIN) keep = E(acc, cur, wr, wc, fr, fq);
        if (!has_next) break;
        if (!keep) {
#pragma unroll
        for (int a = 0; a < 2; ++a)
#pragma unroll
            for (int b = 0; b < 2; ++b)
#pragma unroll
                for (int m = 0; m < 4; ++m)
#pragma unroll
                    for (int n = 0; n < 2; ++n) acc[a][b][m][n] = (f32x4){0.f, 0.f, 0.f, 0.f};
        }
        cur = nxt; cA = nA; cB = nB; ++ui;
    }
    PG8_WAIT_V(0);
    if (wr == 0) PG8_BAR;
    PG8_BAR;
    if constexpr (Epi::AFTER_DRAIN) E.fused(acc, cur, wr, wc, fr, fq, lds, wid, lane);
#undef PG8_SA
#undef PG8_SB
#undef PG8_STAGE
#undef PG8_LDA
#undef PG8_LDB
#undef PG8_MMA
#undef PG8_WAIT_V
#undef PG8_WAIT_L
#undef PG8_BAR
#undef PG8_SCHED
}
}
using pg8::Unit;

struct Ptr1 { const char* A; const char* B; __device__ const char* aptr(const Unit& u) const { return A + (size_t)u.pm * 256 * D * 2; } __device__ const char* bptr(const Unit& u) const { return B + (size_t)u.pn * 256 * D * 2; } };
struct Epi1 {
    static constexpr bool PERM = true, AFTER_DRAIN = false;
    bf16_t* proj; float* gvst;
    __device__ __forceinline__ bool operator()(f32x4 (&acc)[2][2][4][2], const Unit& u, int wr, int wc, int fr, int fq) const {
        asm volatile("" : "+v"(fr), "+v"(fq));
        const int row0 = u.pm * 256 + wr * 64 + fr;
        if (u.pn >= 12 && u.pn < 20) {
            const int col = PC_UZ + (u.pn - 12) * 128 + wc * 32 + 8 * fq;
#pragma unroll
            for (int ai = 0; ai < 2; ++ai)
#pragma unroll
                for (int m = 0; m < 4; ++m) { bf16_t* rp = proj + (size_t)(row0 + ai * 128 + m * 16) * PJ + col;
                    const f32x4 u0 = acc[ai][0][m][0], u1 = acc[ai][0][m][1], z0 = acc[ai][1][m][0], z1 = acc[ai][1][m][1];
                    u32x4 w; w.x = cvt_pk_bf16(u0[0] * siluf_(z0[0]), u0[1] * siluf_(z0[1])); w.y = cvt_pk_bf16(u0[2] * siluf_(z0[2]), u0[3] * siluf_(z0[3]));
                    w.z = cvt_pk_bf16(u1[0] * siluf_(z1[0]), u1[1] * siluf_(z1[1])); w.w = cvt_pk_bf16(u1[2] * siluf_(z1[2]), u1[3] * siluf_(z1[3]));
                    __builtin_nontemporal_store(w, (u32x4*)rp); }
            return false;
        }
        const int col = (u.pn < 12 ? u.pn * 256 : PC_GV + (u.pn - 20) * 256) + wc * 32 + 8 * fq;
        const bool isgv = u.pn >= 20 && u.pn < 24;
#pragma unroll
        for (int ai = 0; ai < 2; ++ai)
#pragma unroll
            for (int m = 0; m < 4; ++m) { const int row = row0 + ai * 128 + m * 16; bf16_t* rp = proj + (size_t)row * PJ + col; float s = 0.f, q = 0.f;
#pragma unroll
                for (int bj = 0; bj < 2; ++bj) { const f32x4 v0 = acc[ai][bj][m][0], v1 = acc[ai][bj][m][1];
                    u32x4 w; w.x = cvt_pk_bf16(v0[0], v0[1]); w.y = cvt_pk_bf16(v0[2], v0[3]); w.z = cvt_pk_bf16(v1[0], v1[1]); w.w = cvt_pk_bf16(v1[2], v1[3]);
                    __builtin_nontemporal_store(w, (u32x4*)(rp + bj * 128));
                    s += (v0[0] + v0[1]) + (v0[2] + v0[3]) + (v1[0] + v1[1]) + (v1[2] + v1[3]);
                    q += (v0[0] * v0[0] + v0[1] * v0[1]) + (v0[2] * v0[2] + v0[3] * v0[3]) + (v1[0] * v1[0] + v1[1] * v1[1]) + (v1[2] * v1[2] + v1[3] * v1[3]); }
                if (isgv) { s += __shfl_xor(s, 16); s += __shfl_xor(s, 32); q += __shfl_xor(q, 16); q += __shfl_xor(q, 32);
                    if (fq == 0) *(f32x2*)(gvst + ((size_t)row * 16 + (u.pn - 20) * 4 + wc) * 2) = (f32x2){s, q}; } }
        return false;
    }
};
struct Ptr2 { const char* proj; const char* BA; const char* BB;
    __device__ const char* aptr(const Unit& u) const { return proj + ((size_t)u.pm * 256 * PJ + (u.pn < 4 ? PC_R : PC_UZ)) * 2; }
    __device__ const char* bptr(const Unit& u) const { return (u.pn < 4 ? BA : BB) + (size_t)(u.pn & 3) * 256 * D * 2; } };
struct Epi2 {
    static constexpr bool PERM = true, AFTER_DRAIN = false;
    bf16_t* proj; const float* b_gate; bool nostore;
    __device__ __forceinline__ bool operator()(f32x4 (&acc)[2][2][4][2], const Unit& u, int wr, int wc, int fr, int fq) const {
        asm volatile("" : "+v"(fr), "+v"(fq));
        const int row0 = u.pm * 256 + wr * 64 + fr, col = (u.pn & 3) * 256 + wc * 32 + 8 * fq; const bool first = u.pn < 4;
        bf16_t* base = proj + (size_t)row0 * PJ + PC_GA + col;
        if (first) {
#pragma unroll
            for (int bj = 0; bj < 2; ++bj) { const float* ba = b_gate + col + bj * 128; const f32x4 bA0 = *(const f32x4*)ba, bA1 = *(const f32x4*)(ba + 4), bB0 = *(const f32x4*)(ba + 1024), bB1 = *(const f32x4*)(ba + 1028);
#pragma unroll
                for (int ai = 0; ai < 2; ++ai) { u32x4 ga[4], gb[4];
#pragma unroll
                    for (int m = 0; m < 4; ++m) { const bf16_t* rp = base + (size_t)(ai * 128 + m * 16) * PJ + bj * 128; ga[m] = *(const u32x4*)rp; gb[m] = *(const u32x4*)(rp + 1024); }
                    __builtin_amdgcn_sched_barrier(0);
#pragma unroll
                    for (int m = 0; m < 4; ++m) { float ea[8], eb[8];
                        ea[0] = __expf(-(bflo(ga[m].x) + bA0[0])); ea[1] = __expf(-(bfhi(ga[m].x) + bA0[1])); ea[2] = __expf(-(bflo(ga[m].y) + bA0[2])); ea[3] = __expf(-(bfhi(ga[m].y) + bA0[3]));
                        ea[4] = __expf(-(bflo(ga[m].z) + bA1[0])); ea[5] = __expf(-(bfhi(ga[m].z) + bA1[1])); ea[6] = __expf(-(bflo(ga[m].w) + bA1[2])); ea[7] = __expf(-(bfhi(ga[m].w) + bA1[3]));
                        eb[0] = __expf(-(bflo(gb[m].x) + bB0[0])); eb[1] = __expf(-(bfhi(gb[m].x) + bB0[1])); eb[2] = __expf(-(bflo(gb[m].y) + bB0[2])); eb[3] = __expf(-(bfhi(gb[m].y) + bB0[3]));
                        eb[4] = __expf(-(bflo(gb[m].z) + bB1[0])); eb[5] = __expf(-(bfhi(gb[m].z) + bB1[1])); eb[6] = __expf(-(bflo(gb[m].w) + bB1[2])); eb[7] = __expf(-(bfhi(gb[m].w) + bB1[3]));
#pragma unroll
                        for (int j = 0; j < 4; ++j) { acc[ai][bj][m][0][j] *= (1.0f + eb[j]) * __builtin_amdgcn_rcpf(1.0f + ea[j]); acc[ai][bj][m][1][j] *= (1.0f + eb[4 + j]) * __builtin_amdgcn_rcpf(1.0f + ea[4 + j]); } } } }
            return true;
        }
#pragma unroll
        for (int bj = 0; bj < 2; ++bj) { const float* ba = b_gate + col + bj * 128; const f32x4 bB0 = *(const f32x4*)(ba + 1024), bB1 = *(const f32x4*)(ba + 1028);
#pragma unroll
            for (int ai = 0; ai < 2; ++ai) { u32x4 gb[4];
#pragma unroll
                for (int m = 0; m < 4; ++m) gb[m] = *(const u32x4*)(base + (size_t)(ai * 128 + m * 16) * PJ + bj * 128 + 1024);
                __builtin_amdgcn_sched_barrier(0);
#pragma unroll
                for (int m = 0; m < 4; ++m) { float sb[8];
                    sb[0] = sigmoidf_(bflo(gb[m].x) + bB0[0]); sb[1] = sigmoidf_(bfhi(gb[m].x) + bB0[1]); sb[2] = sigmoidf_(bflo(gb[m].y) + bB0[2]); sb[3] = sigmoidf_(bfhi(gb[m].y) + bB0[3]);
                    sb[4] = sigmoidf_(bflo(gb[m].z) + bB1[0]); sb[5] = sigmoidf_(bfhi(gb[m].z) + bB1[1]); sb[6] = sigmoidf_(bflo(gb[m].w) + bB1[2]); sb[7] = sigmoidf_(bfhi(gb[m].w) + bB1[3]);
                    const f32x4 v0 = acc[ai][bj][m][0], v1 = acc[ai][bj][m][1];
                    u32x4 w; w.x = cvt_pk_bf16(v0[0] * sb[0], v0[1] * sb[1]); w.y = cvt_pk_bf16(v0[2] * sb[2], v0[3] * sb[3]); w.z = cvt_pk_bf16(v1[0] * sb[4], v1[1] * sb[5]); w.w = cvt_pk_bf16(v1[2] * sb[6], v1[3] * sb[7]);
                    if (!nostore) *(u32x4*)(base + (size_t)(ai * 128 + m * 16) * PJ + bj * 128) = w; } } }
        return false;
    }
};
struct Ptr3 { const char* proj; const char* BO;
    __device__ const char* aptr(const Unit& u) const { return proj + ((size_t)u.pm * 256 * PJ + PC_GA) * 2; }
    __device__ const char* bptr(const Unit& u) const { return BO + (size_t)u.pn * 256 * D * 2; } };
struct Epi3 {
    static constexpr bool PERM = false, AFTER_DRAIN = true;
    const float* xp; const float* ada; const float* fw; float* out; float* xbuf; unsigned* cnt;
    __device__ __forceinline__ bool operator()(f32x4 (&acc)[2][2][4][2], const Unit& u, int wr, int wc, int fr, int fq) const { return false; }
    __device__ __forceinline__ void fused(f32x4 (&acc)[2][2][4][2], const Unit& u, int wr, int wc, int fr, int fq, LAS unsigned char* lds, int wid, int lane) const {
        asm volatile("" : "+v"(fr), "+v"(fq));
        LAS float* P = (LAS float*)lds; LAS float* S = (LAS float*)(lds + 4096);
        const int row0 = u.pm * 256 + wr * 64 + fr, col0 = u.pn * 256 + wc * 32 + 4 * fq;
        f32x4 gt[4];
#pragma unroll
        for (int q = 0; q < 4; ++q) gt[q] = *(const f32x4*)(ada + 2048 + col0 + (q >> 1) * 128 + (q & 1) * 16);
#pragma unroll
        for (int ai = 0; ai < 2; ++ai) { f32x4 xv[4][4];
#pragma unroll
            for (int m = 0; m < 4; ++m)
#pragma unroll
                for (int q = 0; q < 4; ++q) xv[m][q] = __builtin_nontemporal_load((const f32x4*)(xp + (size_t)(row0 + ai * 128 + m * 16) * D + col0 + (q >> 1) * 128 + (q & 1) * 16));
            __builtin_amdgcn_sched_barrier(0);
#pragma unroll
            for (int m = 0; m < 4; ++m) { const int lrow = ai * 128 + wr * 64 + m * 16 + fr; float ss = 0.f;
#pragma unroll
                for (int q = 0; q < 4; ++q) { const f32x4 r = xv[m][q] + gt[q] * acc[ai][q >> 1][m][q & 1]; acc[ai][q >> 1][m][q & 1] = r; ss += (r[0] * r[0] + r[1] * r[1]) + (r[2] * r[2] + r[3] * r[3]); }
                ss += __shfl_xor(ss, 16); ss += __shfl_xor(ss, 32);
                if (fq == 0) P[lrow * 4 + wc] = ss; } }
        __syncthreads();
        const int prow = wid * 32 + (lane & 31);
        if (lane < 32) { const f32x4 pp = *(const LAS f32x4*)(P + prow * 4);
            __hip_atomic_store(xbuf + ((size_t)u.pm * 256 + prow) * 4 + u.pn, (pp[0] + pp[1]) + (pp[2] + pp[3]), __ATOMIC_RELAXED, __HIP_MEMORY_SCOPE_AGENT); }
        asm volatile("s_waitcnt vmcnt(0)" ::: "memory");
        if (lane == 0) __hip_atomic_fetch_add(cnt + 64 * u.pm, 1u, __ATOMIC_RELAXED, __HIP_MEMORY_SCOPE_AGENT);
        if (wid == 0) { unsigned sp = 0u;
            while ((unsigned)__builtin_amdgcn_readfirstlane(__hip_atomic_load(cnt + 64 * u.pm, __ATOMIC_RELAXED, __HIP_MEMORY_SCOPE_AGENT)) < 32u) { __builtin_amdgcn_s_sleep(2); if (++sp > (1u << 22)) break; }
            __builtin_amdgcn_fence(__ATOMIC_ACQUIRE, "agent"); }
        asm volatile("s_waitcnt vmcnt(0) lgkmcnt(0)" ::: "memory"); __syncthreads();
        if (lane < 32) { const float* sl = xbuf + ((size_t)u.pm * 256 + prow) * 4; float t = 0.f;
#pragma unroll
            for (int q = 0; q < 4; ++q) t += __hip_atomic_load(sl + q, __ATOMIC_RELAXED, __HIP_MEMORY_SCOPE_AGENT);
            S[prow] = rsqrtf(t * (1.0f / D) + EPS); }
        __syncthreads();
        f32x4 fv[4];
#pragma unroll
        for (int q = 0; q < 4; ++q) fv[q] = *(const f32x4*)(fw + col0 + (q >> 1) * 128 + (q & 1) * 16);
#pragma unroll
        for (int ai = 0; ai < 2; ++ai)
#pragma unroll
            for (int m = 0; m < 4; ++m) { const int row = row0 + ai * 128 + m * 16, lrow = ai * 128 + wr * 64 + m * 16 + fr; const float rs = S[lrow]; float* orow = out + (size_t)row * D + col0;
#pragma unroll
                for (int q = 0; q < 4; ++q) __builtin_nontemporal_store(acc[ai][q >> 1][m][q & 1] * rs * fv[q], (f32x4*)(orow + (q >> 1) * 128 + (q & 1) * 16)); }
    }
};
template <int AM, int BN>
__device__ __forceinline__ void wave_gemm(const bf16_t* const (&Ar)[AM], int lda, const bf16_t* const (&Br)[BN], int ldb, int K, int lane, f32x4 (&acc)[AM][BN]) {
    const bf16_t* a[AM]; const bf16_t* b[BN];
#pragma unroll
    for (int i = 0; i < AM; ++i) a[i] = Ar[i] + (size_t)(lane & 15) * lda + 8 * (lane >> 4);
#pragma unroll
    for (int i = 0; i < BN; ++i) b[i] = Br[i] + (size_t)(lane & 15) * ldb + 8 * (lane >> 4);
    constexpr int KB = (AM + BN) >= 4 ? 8 : 16;
    for (int k0 = 0; k0 < K; k0 += 32 * KB) { bf16x8 fa[KB][AM], fb[KB][BN];
#pragma unroll
        for (int s = 0; s < KB; ++s) {
#pragma unroll
            for (int i = 0; i < AM; ++i) fa[s][i] = *(const bf16x8*)(a[i] + k0 + 32 * s);
#pragma unroll
            for (int i = 0; i < BN; ++i) fb[s][i] = *(const bf16x8*)(b[i] + k0 + 32 * s); }
        __builtin_amdgcn_sched_barrier(0);
#pragma unroll
        for (int s = 0; s < KB; ++s)
#pragma unroll
            for (int i = 0; i < AM; ++i)
#pragma unroll
                for (int j = 0; j < BN; ++j) acc[i][j] = MFMA16(fb[s][j], fa[s][i], acc[i][j]); }
}
__device__ __forceinline__ void sample_gemm1(const Params& p, LAS unsigned char* lds, int bid) {
    int tid_ = threadIdx.x; asm volatile("" : "+v"(tid_)); const int tid = tid_, lane = tid & 63, w = tid >> 6, g4 = lane >> 4, l15 = lane & 15;
    const bf16_t* H = (const bf16_t*)((const unsigned char*)p.out + RB_H); const bf16_t* bt1 = (const bf16_t*)((const unsigned char*)p.out + RB_BT1); bf16_t* proj = (bf16_t*)(p.ws + WS_PROJ);
    constexpr int RS = 528, LB = 256 * RS;
    int b0, b1, ocol; const bool uz = bid >= 96 && bid < 160;
    if (bid < 96) { b0 = 32 * bid; b1 = b0 + 16; ocol = 32 * bid; }
    else if (uz) { const int j = bid - 96; b0 = 3072 + (j >> 3) * 256 + (j & 7) * 16; b1 = b0 + 128; ocol = PC_UZ + 16 * j; }
    else { b0 = 5120 + 32 * (bid - 160); b1 = b0 + 16; ocol = PC_GV + 32 * (bid - 160); }
    u32x4 ra[16], rb[2];
    const int pr = tid >> 5, pc = tid & 31;
    const bf16_t* ag = H + (size_t)(SEQ + pr) * D + pc * 8;
    const bf16_t* bg0 = bt1 + (size_t)(b0 + pr) * D + pc * 8; const bf16_t* bg1 = bt1 + (size_t)(b1 + pr) * D + pc * 8;
#pragma unroll
    for (int i = 0; i < 16; ++i) ra[i] = *(const u32x4*)(ag + (size_t)i * 16 * D);
    rb[0] = *(const u32x4*)bg0; rb[1] = *(const u32x4*)bg1;
    f32x4 acc[2][2];
#pragma unroll
    for (int i = 0; i < 2; ++i)
#pragma unroll
        for (int j = 0; j < 2; ++j) acc[i][j] = (f32x4){0.f, 0.f, 0.f, 0.f};
    for (int kc = 0; kc < 4; ++kc) {
#pragma unroll
        for (int i = 0; i < 16; ++i) *(LAS u32x4*)(lds + (pr + 16 * i) * RS + pc * 16) = ra[i];
        *(LAS u32x4*)(lds + LB + pr * RS + pc * 16) = rb[0]; *(LAS u32x4*)(lds + LB + (16 + pr) * RS + pc * 16) = rb[1];
        __syncthreads();
        if (kc + 1 < 4) { int ko = (kc + 1) * 256; asm volatile("" : "+v"(ko));
#pragma unroll
            for (int i = 0; i < 16; ++i) ra[i] = *(const u32x4*)(ag + (size_t)i * 16 * D + ko);
            rb[0] = *(const u32x4*)(bg0 + ko); rb[1] = *(const u32x4*)(bg1 + ko); }
#pragma unroll
        for (int ks = 0; ks < 8; ++ks) { bf16x8 fa[2], fb[2];
#pragma unroll
            for (int i = 0; i < 2; ++i) { fa[i] = row_frag(lds + (32 * w + 16 * i) * RS + ks * 64, RS, lane); fb[i] = row_frag(lds + LB + 16 * i * RS + ks * 64, RS, lane); }
#pragma unroll
            for (int i = 0; i < 2; ++i)
#pragma unroll
                for (int j = 0; j < 2; ++j) acc[i][j] = MFMA16(fb[j], fa[i], acc[i][j]); }
        __syncthreads();
    }
    const int r0 = SEQ + 32 * w;
#pragma unroll
    for (int i = 0; i < 2; ++i) { bf16_t* rp = proj + (size_t)(r0 + 16 * i + l15) * PJ + ocol + 4 * g4;
        if (uz) { const f32x4 u = acc[i][0], z = acc[i][1]; u32x2 pk; pk.x = cvt_pk_bf16(u[0] * siluf_(z[0]), u[1] * siluf_(z[1])); pk.y = cvt_pk_bf16(u[2] * siluf_(z[2]), u[3] * siluf_(z[3])); *(u32x2*)rp = pk; }
        else {
#pragma unroll
            for (int j = 0; j < 2; ++j) { u32x2 pk; pk.x = cvt_pk_bf16(acc[i][j][0], acc[i][j][1]); pk.y = cvt_pk_bf16(acc[i][j][2], acc[i][j][3]); *(u32x2*)(rp + 16 * j) = pk; } } }
}
__device__ __forceinline__ void sample_gemm2(const Params& p, int bid, bool nostore) {
    int tid_ = threadIdx.x; asm volatile("" : "+v"(tid_)); const int lane = tid_ & 63, w = tid_ >> 6, g4 = lane >> 4, l15 = lane & 15;
    if (w >= 4) return;
    bf16_t* proj = (bf16_t*)(p.ws + WS_PROJ); const bf16_t* bta = (const bf16_t*)(p.ws + WS_BTA); const bf16_t* btb = (const bf16_t*)(p.ws + WS_BTB);
    const int tile = bid * 4 + w, rt = tile >> 6, ct = tile & 63, r0 = SEQ + 16 * rt, c0 = 16 * ct;
    f32x4 aa[1][1], ab[1][1]; aa[0][0] = (f32x4){0.f, 0.f, 0.f, 0.f}; ab[0][0] = aa[0][0];
    { const bf16_t* const Ar[1] = {proj + (size_t)r0 * PJ + PC_R}; const bf16_t* const Br[1] = {bta + (size_t)c0 * D}; wave_gemm<1, 1>(Ar, PJ, Br, D, D, lane, aa); }
    { const bf16_t* const Ar[1] = {proj + (size_t)r0 * PJ + PC_UZ}; const bf16_t* const Br[1] = {btb + (size_t)c0 * D}; wave_gemm<1, 1>(Ar, PJ, Br, D, D, lane, ab); }
    bf16_t* rp = proj + (size_t)(r0 + l15) * PJ + PC_GA + c0 + 4 * g4; const u32x2 ga = *(const u32x2*)rp, gb = *(const u32x2*)(rp + 1024);
    const f32x4 bA = *(const f32x4*)(p.b_gate + c0 + 4 * g4), bB = *(const f32x4*)(p.b_gate + 1024 + c0 + 4 * g4);
    float o[4];
    o[0] = sigmoidf_(bflo(ga.x) + bA[0]) * aa[0][0][0] + sigmoidf_(bflo(gb.x) + bB[0]) * ab[0][0][0]; o[1] = sigmoidf_(bfhi(ga.x) + bA[1]) * aa[0][0][1] + sigmoidf_(bfhi(gb.x) + bB[1]) * ab[0][0][1];
    o[2] = sigmoidf_(bflo(ga.y) + bA[2]) * aa[0][0][2] + sigmoidf_(bflo(gb.y) + bB[2]) * ab[0][0][2]; o[3] = sigmoidf_(bfhi(ga.y) + bA[3]) * aa[0][0][3] + sigmoidf_(bfhi(gb.y) + bB[3]) * ab[0][0][3];
    u32x2 pk; pk.x = cvt_pk_bf16(o[0], o[1]); pk.y = cvt_pk_bf16(o[2], o[3]); if (!nostore) *(u32x2*)rp = pk;
}
__device__ __forceinline__ void sample_gemm3(const Params& p, int bid) {
    int tid_ = threadIdx.x; asm volatile("" : "+v"(tid_)); const int lane = tid_ & 63, w = tid_ >> 6, g4 = lane >> 4, l15 = lane & 15;
    if (w >= 4) return;
    const bf16_t* proj = (const bf16_t*)(p.ws + WS_PROJ); const bf16_t* bto = (const bf16_t*)(p.ws + WS_BTO); const float* ada = (const float*)(p.ws + WS_ADA);
    const int tile = bid * 4 + w, rt = tile >> 6, ct = tile & 63, c0 = 16 * ct + 4 * g4, rs = 16 * rt + l15;
    f32x4 acc[1][1]; acc[0][0] = (f32x4){0.f, 0.f, 0.f, 0.f};
    { const bf16_t* const Ar[1] = {proj + (size_t)(SEQ + 16 * rt) * PJ + PC_GA}; const bf16_t* const Br[1] = {bto + (size_t)16 * ct * D}; wave_gemm<1, 1>(Ar, PJ, Br, D, D, lane, acc); }
    const f32x4 xv = *(const f32x4*)(p.x_sample + (size_t)rs * D + c0), gt = *(const f32x4*)(ada + (1 + rt) * 3072 + 2048 + c0);
    *(f32x4*)(p.out + OUT_YS + (size_t)rs * D + c0) = xv + gt * acc[0][0];
}

__device__ __forceinline__ void transpose_tile(LAS unsigned char* lds, const float* src, int ldsrc, int scol0, int nvalid, float scale, bf16_t* dst, int ldd, int n0, int k0) {
    int tid_ = threadIdx.x; asm volatile("" : "+v"(tid_)); const int tid = tid_;
    f32x4 v[8];
#pragma unroll
    for (int i = 0; i < 8; ++i) { const int e = tid + 512 * i, k = e >> 4, n4 = (e & 15) * 4; f32x4 t = (f32x4){0.f, 0.f, 0.f, 0.f};
        if (n4 < nvalid) t = __builtin_nontemporal_load((const f32x4*)(src + (size_t)(k0 + k) * ldsrc + scol0 + n4));
        v[i] = t; }
#pragma unroll
    for (int i = 0; i < 8; ++i) { const int e = tid + 512 * i, k = e >> 4, n4 = (e & 15) * 4, m = (e & 15) & 7;
        const f32x4 t = v[i];
        *(LAS bf16_t*)(lds + (n4 + 0) * 528 + (((k >> 3) ^ m) << 4) + (k & 7) * 2) = f2bf(t[0] * scale);
        *(LAS bf16_t*)(lds + (n4 + 1) * 528 + (((k >> 3) ^ m) << 4) + (k & 7) * 2) = f2bf(t[1] * scale);
        *(LAS bf16_t*)(lds + (n4 + 2) * 528 + (((k >> 3) ^ m) << 4) + (k & 7) * 2) = f2bf(t[2] * scale);
        *(LAS bf16_t*)(lds + (n4 + 3) * 528 + (((k >> 3) ^ m) << 4) + (k & 7) * 2) = f2bf(t[3] * scale); }
    __syncthreads();
#pragma unroll
    for (int i = 0; i < 4; ++i) { const int e = tid + 512 * i, n = e >> 5, kc = e & 31; const u32x4 w = *(const LAS u32x4*)(lds + n * 528 + ((kc ^ ((n >> 2) & 7)) << 4));
        *(u32x4*)(dst + (size_t)(n0 + n) * ldd + k0 + kc * 8) = w; }
    __syncthreads();
}
__device__ __forceinline__ void ada_item(const Params& p, LAS unsigned char* lds, int slab) {
    int tid_ = threadIdx.x; asm volatile("" : "+v"(tid_)); const int tid = tid_; float* ada = (float*)(p.ws + WS_ADA);
    LAS float* sc = (LAS float*)lds;
    LAS float* red = (LAS float*)(lds + 17 * 1024 * 4);
    for (int i = tid; i < 17 * 1024; i += 512) { const int b = i >> 10, k = i & 1023; const float c = b == 0 ? p.c_prompt[k] : p.c_sample[(b - 1) * 1024 + k]; sc[i] = siluf_(c); }
    __syncthreads();
    const int nl = tid & 31, kg = tid >> 5, n = slab * 32 + nl;
    float a[17];
#pragma unroll
    for (int b = 0; b < 17; ++b) a[b] = 0.f;
    for (int k16 = 0; k16 < 4; ++k16) { float w[16]; const float* wp = p.w_ada + (size_t)(kg * 64 + k16 * 16) * 3072 + n;
#pragma unroll
        for (int i = 0; i < 16; ++i) w[i] = wp[(size_t)i * 3072];
        __builtin_amdgcn_sched_barrier(0);
#pragma unroll
        for (int k4 = 0; k4 < 4; ++k4) { const int k = kg * 64 + k16 * 16 + k4 * 4;
#pragma unroll
            for (int b = 0; b < 17; ++b) { const f32x4 s = *(const LAS f32x4*)(sc + b * 1024 + k); a[b] += s[0] * w[k4 * 4] + s[1] * w[k4 * 4 + 1] + s[2] * w[k4 * 4 + 2] + s[3] * w[k4 * 4 + 3]; } } }
#pragma unroll
    for (int b = 0; b < 17; ++b) red[(kg * 17 + b) * 32 + nl] = a[b];
    __syncthreads();
    for (int i = tid; i < 17 * 32; i += 512) { const int b = i >> 5, c = i & 31; float s = p.b_ada[slab * 32 + c];
#pragma unroll
        for (int g = 0; g < 16; ++g) s += red[(g * 17 + b) * 32 + c];
        ada[b * 3072 + slab * 32 + c] = s; }
    __syncthreads();
}
__device__ __forceinline__ void phase0(const Params& p, LAS unsigned char* lds) {
    bf16_t* bt1 = (bf16_t*)((unsigned char*)p.out + RB_BT1); bf16_t* bta = (bf16_t*)(p.ws + WS_BTA); bf16_t* btb = (bf16_t*)(p.ws + WS_BTB); bf16_t* bto = (bf16_t*)(p.ws + WS_BTO);
    constexpr int N_ADA = 96, N_T1 = (N1 / 64) * 4, N_TS = 64;
    int bid_ = blockIdx.x; asm volatile("" : "+s"(bid_)); const int bid = bid_;
    for (int it = bid; it < N_ADA + N_T1 + 3 * N_TS; it += gridDim.x) {
        if (it < N_ADA) { ada_item(p, lds, it); continue; }
        int j = it - N_ADA;
        if (j < N_T1) { const int nt = j >> 2, kt = j & 3, n0 = nt * 64; int sc0, nv = 64;
            if (n0 < 3072) sc0 = n0;
            else if (n0 < 5120) { const int t = (n0 - 3072) >> 8, w = (n0 - 3072) & 255; sc0 = w < 128 ? 3088 + t * 128 + w : 5136 + t * 128 + (w - 128); }
            else if (n0 < 6144) sc0 = 4112 + (n0 - 5120);
            else if (n0 < 7168) sc0 = 6160 + (n0 - 6144);
            else if (n0 < 8192) sc0 = 7184 + (n0 - 7168);
            else { sc0 = 3072; nv = 16; }
            transpose_tile(lds, p.w_in, WIN_LD, sc0, nv, n0 < 512 ? 0.08838834764831845f : 1.0f, bt1, D, n0, kt * 256); continue; }
        j -= N_T1;
        const int which = j >> 6, nt = (j & 63) >> 2, kt = j & 3;
        if (which == 0) transpose_tile(lds, p.w_proj_a, D, nt * 64, 64, 1.0f, bta, D, nt * 64, kt * 256);
        else if (which == 1) transpose_tile(lds, p.w_proj_b, D, nt * 64, 64, 1.0f, btb, D, nt * 64, kt * 256);
        else transpose_tile(lds, p.w_out, D, nt * 64, 64, 1.0f, bto, D, nt * 64, kt * 256);
    }
}
__device__ __forceinline__ void phase1(const Params& p) {
    int tid_ = threadIdx.x; asm volatile("" : "+v"(tid_)); const int tid = tid_; int bid_ = blockIdx.x; asm volatile("" : "+s"(bid_)); const int bid = bid_;
    const int lane = tid & 63, wv = tid >> 6, l15 = lane & 15, g4 = lane >> 4; const float* ada = (const float*)(p.ws + WS_ADA); bf16_t* H = (bf16_t*)((unsigned char*)p.out + RB_H);
#pragma unroll 2
    for (int row = bid * 8 + wv; row < MTOT; row += gridDim.x * 8) {
        const float* xr = row < SEQ ? p.x_prompt + (size_t)row * D : p.x_sample + (size_t)(row - SEQ) * D; const int b = row < SEQ ? 0 : 1 + ((row - SEQ) >> 4);
        f32x4 v[4]; float ss = 0.f;
#pragma unroll
        for (int i = 0; i < 4; ++i) { v[i] = __builtin_nontemporal_load((const f32x4*)(xr + i * 256 + lane * 4)); ss += (v[i][0] * v[i][0] + v[i][1] * v[i][1]) + (v[i][2] * v[i][2] + v[i][3] * v[i][3]); }
        ss = wave_sum(ss); const float rstd = rsqrtf(ss * (1.0f / D) + EPS);
#pragma unroll
        for (int i = 0; i < 4; ++i) { const int c = i * 256 + lane * 4; const f32x4 nw = *(const f32x4*)(p.norm_w + c), sh = *(const f32x4*)(ada + b * 3072 + c), scl = *(const f32x4*)(ada + b * 3072 + 1024 + c);
            const f32x4 h = v[i] * rstd * nw * (scl + 1.0f) + sh; u32x2 w; w.x = cvt_pk_bf16(h[0], h[1]); w.y = cvt_pk_bf16(h[2], h[3]); *(u32x2*)(H + (size_t)row * D + c) = w; }
    }
    asm volatile("s_waitcnt vmcnt(0)" ::: "memory");
    __syncthreads();
    float* alr = (float*)(p.ws + WS_ALR);
    const bf16_t* w16 = (const bf16_t*)((const unsigned char*)p.out + RB_BT1) + (size_t)(8192 + l15) * D + 8 * g4;
    for (int gi = wv; bid * 8 + 2048 * gi < MTOT; gi += 8) { const int r0 = bid * 8 + 2048 * gi;
        f32x4 acc = (f32x4){0.f, 0.f, 0.f, 0.f};
        const bf16_t* ap = H + (size_t)(r0 + (l15 & 7)) * D + 8 * g4;
#pragma unroll
        for (int kb = 0; kb < 2; ++kb) { bf16x8 fa[16], fb[16];
#pragma unroll
            for (int s = 0; s < 16; ++s) { fa[s] = *(const bf16x8*)(ap + (kb * 16 + s) * 32); fb[s] = *(const bf16x8*)(w16 + (kb * 16 + s) * 32); }
#pragma unroll
            for (int s = 0; s < 16; ++s) acc = MFMA16(fb[s], fa[s], acc); }
        if (l15 < 8) *(f32x4*)(alr + (size_t)(r0 + l15) * 16 + 4 * g4) = acc; }
}
__device__ __forceinline__ void gla_prep(const Params& p, LAS unsigned char* lds, int tokbase, int nchunk, int nvalid, int h, int chunk0, bool tolds, int ldsK, int ldsDV) {
    int tid_ = threadIdx.x; asm volatile("" : "+v"(tid_)); const int tid = tid_, kap = tid & 127; const int c = __builtin_amdgcn_readfirstlane(tid >> 7);
    bf16_t* proj = (bf16_t*)(p.ws + WS_PROJ); const float* alr = (const float*)(p.ws + WS_ALR); float* dch = (float*)(p.ws + WS_DCH);
    if (c < nchunk) {
        float w2[16];
#pragma unroll
        for (int j = 0; j < 16; ++j) w2[j] = p.w_a2[j * 512 + h * 128 + kap];
        const float ba = p.b_a[h * 128 + kap];
        const int tok0 = tokbase + 64 * c; float run = 0.f;
        bf16_t* kp = proj + (size_t)tok0 * PJ + PC_K + h * 128 + kap; bf16_t* qp = proj + (size_t)tok0 * PJ + PC_Q + h * 128 + kap;
        const float* ar0 = alr + (size_t)tok0 * 16;
#pragma unroll 8
        for (int t = 0; t < nvalid; ++t) { const float* ar = ar0 + t * 16; float x = ba;
#pragma unroll
            for (int j = 0; j < 16; ++j) x += ar[j] * w2[j];
            const float la = -(fmaxf(-x, 0.f) + __logf(1.0f + __expf(-fabsf(x)))) * 0.0625f; run += la;
            const float kk = bf2f(kp[(size_t)t * PJ]), qq = bf2f(qp[(size_t)t * PJ]);
            const bf16_t kt = f2bf(kk * __expf(-run)); kp[(size_t)t * PJ] = kt; qp[(size_t)t * PJ] = f2bf(qq * __expf(run));
            if (tolds) *(LAS bf16_t*)(lds + ldsK + (64 * c + t) * 272 + kap * 2) = kt; }
        const float d = __expf(run); dch[((chunk0 + c) * 4 + h) * 128 + kap] = d; if (tolds) *(LAS float*)(lds + ldsDV + (c * 128 + kap) * 4) = d;
    }
}
constexpr int LA_K = 0, LA_V0 = 69632, LA_V1 = 103424, LA_DV = 137216;
constexpr int RS_QK = 272, RS_V = 528, RS_P = 144, RS_S = 272;
__device__ __forceinline__ void gla_segA(const Params& p, LAS unsigned char* lds, int seg, int h) {
    int tid_ = threadIdx.x; asm volatile("" : "+v"(tid_));
    const int tid = tid_, lane = tid & 63, w = tid >> 6, g4 = lane >> 4, l15 = lane & 15;
    const bf16_t* proj = (const bf16_t*)(p.ws + WS_PROJ); const int tokbase = seg * (SEGCH * 64);
    u32x4 vr[4];
#pragma unroll
    for (int i = 0; i < 4; ++i) { const int e = tid + 512 * i, r = e >> 5, c = e & 31; vr[i] = *(const u32x4*)(proj + (size_t)(tokbase + r) * PJ + PC_V + h * 256 + c * 8); }
    gla_prep(p, lds, tokbase, SEGCH, 64, h, seg * SEGCH, true, LA_K, LA_DV);
#pragma unroll
    for (int i = 0; i < 4; ++i) { const int e = tid + 512 * i, r = e >> 5, c = e & 31; *(LAS u32x4*)(lds + LA_V0 + r * RS_V + c * 16) = vr[i]; }
    __syncthreads();
    f32x4 acc[8][2];
#pragma unroll
    for (int kt = 0; kt < 8; ++kt)
#pragma unroll
        for (int j2 = 0; j2 < 2; ++j2) acc[kt][j2] = (f32x4){0.f, 0.f, 0.f, 0.f};
    for (int ch = 0; ch < SEGCH; ++ch) {
        int tok1 = tokbase + (ch + 1) * 64; asm volatile("" : "+v"(tok1));
        const int vb = (ch & 1) ? LA_V1 : LA_V0, vn = (ch & 1) ? LA_V0 : LA_V1;
        if (ch + 1 < SEGCH) {
#pragma unroll
            for (int i = 0; i < 4; ++i) { const int e = tid + 512 * i, r = e >> 5, c = e & 31; vr[i] = *(const u32x4*)(proj + (size_t)(tok1 + r) * PJ + PC_V + h * 256 + c * 8); } }
#pragma unroll
        for (int ks = 0; ks < 2; ++ks) { bf16x8 Bv[2];
#pragma unroll
            for (int j2 = 0; j2 < 2; ++j2) Bv[j2] = tr_frag(lds + vb + 32 * ks * RS_V + (32 * w + 16 * j2) * 2, RS_V, lane);
#pragma unroll
            for (int kt = 0; kt < 8; ++kt) { const bf16x8 Ak = tr_frag(lds + LA_K + (64 * ch + 32 * ks) * RS_QK + 16 * kt * 2, RS_QK, lane);
#pragma unroll
                for (int j2 = 0; j2 < 2; ++j2) acc[kt][j2] = MFMA16(Ak, Bv[j2], acc[kt][j2]); } }
#pragma unroll
        for (int kt = 0; kt < 8; ++kt) { const f32x4 d = *(const LAS f32x4*)(lds + LA_DV + (ch * 128 + 16 * kt + 4 * g4) * 4);
#pragma unroll
            for (int j2 = 0; j2 < 2; ++j2) acc[kt][j2] = acc[kt][j2] * d; }
        if (ch + 1 < SEGCH) {
#pragma unroll
            for (int i = 0; i < 4; ++i) { const int e = tid + 512 * i, r = e >> 5, c = e & 31; *(LAS u32x4*)(lds + vn + r * RS_V + c * 16) = vr[i]; } }
        __syncthreads();
    }
    bf16_t* us = (bf16_t*)((unsigned char*)p.out + RB_USEG) + ((size_t)(seg * 4 + h) * 256) * 128;
#pragma unroll
    for (int kt = 0; kt < 8; ++kt)
#pragma unroll
        for (int j2 = 0; j2 < 2; ++j2) { u32x2 pk; pk.x = cvt_pk_bf16(acc[kt][j2][0], acc[kt][j2][1]); pk.y = cvt_pk_bf16(acc[kt][j2][2], acc[kt][j2][3]);
            *(u32x2*)(us + (size_t)(32 * w + 16 * j2 + l15) * 128 + 16 * kt + 4 * g4) = pk; }
    if (tid < 128) { float d = 1.f;
#pragma unroll
        for (int c = 0; c < 4; ++c) d *= *(const LAS float*)(lds + LA_DV + (c * 128 + tid) * 4);
        ((float*)(p.ws + WS_DSEG))[(seg * 4 + h) * 128 + tid] = d; }
    __syncthreads();
}
constexpr int L_DV = 6144, L_RED = 6656, L_Q = 8704, L_K = 26112, L_V = 43520, L_P = 77312, L_S = 86528;
__device__ __forceinline__ void gla_out(const Params& p, LAS unsigned char* lds, int sample, int idx  , int h, bool nostore) {
    int tid_ = threadIdx.x; asm volatile("" : "+v"(tid_));
    const int tid = tid_, lane = tid & 63, w = tid >> 6, g4 = lane >> 4, l15 = lane & 15;
    bf16_t* proj = (bf16_t*)(p.ws + WS_PROJ); const float* dch = (const float*)(p.ws + WS_DCH);
    const int nchunk = sample ? 1 : SEGCH, nvalid = sample ? SAMP_T : 64, tokbase = sample ? SEQ + idx * SAMP_T : idx * (SEGCH * 64), chunk0 = sample ? 256 + idx : idx * SEGCH;
    f32x4 acc[8][2];
    if (!sample) { const bf16_t* ss = (const bf16_t*)((unsigned char*)p.out + RB_SSTART) + ((size_t)(idx * 4 + h) * 256) * 128;
#pragma unroll
        for (int kt = 0; kt < 8; ++kt)
#pragma unroll
            for (int j2 = 0; j2 < 2; ++j2) { const u32x2 pk = *(const u32x2*)(ss + (size_t)(32 * w + 16 * j2 + l15) * 128 + 16 * kt + 4 * g4);
                acc[kt][j2] = (f32x4){bflo(pk.x), bfhi(pk.x), bflo(pk.y), bfhi(pk.y)}; }
    } else { const float* s0 = p.state_gla + (size_t)(idx * 4 + h) * 128 * 256;
#pragma unroll
        for (int kt = 0; kt < 8; ++kt)
#pragma unroll
            for (int j2 = 0; j2 < 2; ++j2)
#pragma unroll
                for (int r = 0; r < 4; ++r) acc[kt][j2][r] = s0[(size_t)(16 * kt + 4 * g4 + r) * 256 + 32 * w + 16 * j2 + l15];
    }
    if (tid < 128) {
#pragma unroll
        for (int c = 0; c < SEGCH; ++c) if (c < nchunk) *(LAS float*)(lds + (c * 128 + tid) * 4) = dch[((chunk0 + c) * 4 + h) * 128 + tid]; }
    u32x4 rq[2], rk[2], rv[4];
#define GLA_LOAD_TILES(T0) do { \
        _Pragma("unroll") for (int i = 0; i < 2; ++i) { const int e = tid + 512 * i, r = e >> 4, c = e & 15; const bool ok = r < nvalid; const bf16_t* bp = proj + (size_t)((T0) + r) * PJ + h * 128 + c * 8; \
            rq[i] = ok ? __builtin_nontemporal_load((const u32x4*)(bp + PC_Q)) : (u32x4){0u, 0u, 0u, 0u}; rk[i] = ok ? __builtin_nontemporal_load((const u32x4*)(bp + PC_K)) : (u32x4){0u, 0u, 0u, 0u}; } \
        _Pragma("unroll") for (int i = 0; i < 4; ++i) { const int e = tid + 512 * i, r = e >> 5, c = e & 31; \
            rv[i] = (r < nvalid) ? __builtin_nontemporal_load((const u32x4*)(proj + (size_t)((T0) + r) * PJ + PC_V + h * 256 + c * 8)) : (u32x4){0u, 0u, 0u, 0u}; } } while (0)
    GLA_LOAD_TILES(tokbase);
    for (int ch = 0; ch < nchunk; ++ch) {
        int tok0 = tokbase + ch * 64; asm volatile("" : "+v"(tok0));
#pragma unroll
        for (int i = 0; i < 2; ++i) { const int e = tid + 512 * i, r = e >> 4, c = e & 15; *(LAS u32x4*)(lds + L_Q + r * RS_QK + c * 16) = rq[i]; *(LAS u32x4*)(lds + L_K + r * RS_QK + c * 16) = rk[i]; }
#pragma unroll
        for (int i = 0; i < 4; ++i) { const int e = tid + 512 * i, r = e >> 5, c = e & 31; *(LAS u32x4*)(lds + L_V + r * RS_V + c * 16) = rv[i]; }
#pragma unroll
        for (int kt = 0; kt < 8; ++kt)
#pragma unroll
            for (int j2 = 0; j2 < 2; ++j2) { u32x2 pk; pk.x = cvt_pk_bf16(acc[kt][j2][0], acc[kt][j2][1]); pk.y = cvt_pk_bf16(acc[kt][j2][2], acc[kt][j2][3]);
                *(LAS u32x2*)(lds + L_S + (32 * w + 16 * j2 + l15) * RS_S + (16 * kt + 4 * g4) * 2) = pk; }
        __syncthreads();
        if (ch + 1 < nchunk) { const int tok1 = tok0 + 64; GLA_LOAD_TILES(tok1); }
#pragma unroll
        for (int e = 0; e < 2; ++e) { const int tile = 2 * w + e, st = tile >> 2, tt = tile & 3; f32x4 ap = (f32x4){0.f, 0.f, 0.f, 0.f};
            if (st <= tt) {
#pragma unroll
                for (int ks = 0; ks < 4; ++ks) { const bf16x8 A = row_frag(lds + L_K + 16 * st * RS_QK + ks * 64, RS_QK, lane), B = row_frag(lds + L_Q + 16 * tt * RS_QK + ks * 64, RS_QK, lane); ap = MFMA16(A, B, ap); } }
            const int t = 16 * tt + l15, s0 = 16 * st + 4 * g4;
            u32x2 pk; pk.x = cvt_pk_bf16(s0 <= t ? ap[0] : 0.f, s0 + 1 <= t ? ap[1] : 0.f); pk.y = cvt_pk_bf16(s0 + 2 <= t ? ap[2] : 0.f, s0 + 3 <= t ? ap[3] : 0.f);
            *(LAS u32x2*)(lds + L_P + t * RS_P + s0 * 2) = pk; }
        __syncthreads();
        u32x2 rrv[4][2];
#pragma unroll
        for (int tt = 0; tt < 4; ++tt)
#pragma unroll
            for (int j2 = 0; j2 < 2; ++j2) rrv[tt][j2] = (16 * tt + l15 < nvalid) ? *(const u32x2*)(proj + (size_t)(tok0 + 16 * tt + l15) * PJ + PC_R + h * 256 + 32 * w + 16 * j2 + 4 * g4) : (u32x2){0u, 0u};
        f32x4 ao[2][4];
#pragma unroll
        for (int j2 = 0; j2 < 2; ++j2)
#pragma unroll
            for (int tt = 0; tt < 4; ++tt) ao[j2][tt] = (f32x4){0.f, 0.f, 0.f, 0.f};
#pragma unroll
        for (int ks = 0; ks < 2; ++ks) { bf16x8 Av[2];
#pragma unroll
            for (int j2 = 0; j2 < 2; ++j2) Av[j2] = tr_frag(lds + L_V + 32 * ks * RS_V + (32 * w + 16 * j2) * 2, RS_V, lane);
#pragma unroll
            for (int tt = 0; tt < 4; ++tt) { const bf16x8 Bp = row_frag(lds + L_P + 16 * tt * RS_P + ks * 64, RS_P, lane);
#pragma unroll
                for (int j2 = 0; j2 < 2; ++j2) ao[j2][tt] = MFMA16(Av[j2], Bp, ao[j2][tt]); } }
#pragma unroll
        for (int ks = 0; ks < 4; ++ks) { bf16x8 As[2];
#pragma unroll
            for (int j2 = 0; j2 < 2; ++j2) As[j2] = row_frag(lds + L_S + (32 * w + 16 * j2) * RS_S + ks * 64, RS_S, lane);
#pragma unroll
            for (int tt = 0; tt < 4; ++tt) { const bf16x8 Bq = row_frag(lds + L_Q + 16 * tt * RS_QK + ks * 64, RS_QK, lane);
#pragma unroll
                for (int j2 = 0; j2 < 2; ++j2) ao[j2][tt] = MFMA16(As[j2], Bq, ao[j2][tt]); } }
#pragma unroll
        for (int tt = 0; tt < 4; ++tt) { float ss = 0.f;
#pragma unroll
            for (int j2 = 0; j2 < 2; ++j2) ss += (ao[j2][tt][0] * ao[j2][tt][0] + ao[j2][tt][1] * ao[j2][tt][1]) + (ao[j2][tt][2] * ao[j2][tt][2] + ao[j2][tt][3] * ao[j2][tt][3]);
            ss += __shfl_xor(ss, 16); ss += __shfl_xor(ss, 32);
            if (g4 == 0) *(LAS float*)(lds + L_RED + (w * 64 + 16 * tt + l15) * 4) = ss; }
        __syncthreads();
#pragma unroll
        for (int tt = 0; tt < 4; ++tt) { const int t = 16 * tt + l15; float tot = 0.f;
#pragma unroll
            for (int ww = 0; ww < 8; ++ww) tot += *(const LAS float*)(lds + L_RED + (ww * 64 + t) * 4);
            const float rstd = rsqrtf(tot * (1.0f / 256.0f) + EPS);
            if (t < nvalid && !nostore) {
#pragma unroll
                for (int j2 = 0; j2 < 2; ++j2) { const int v0 = 32 * w + 16 * j2 + 4 * g4; bf16_t* rp = proj + (size_t)(tok0 + t) * PJ + PC_R + h * 256 + v0;
                    const u32x2 rr = rrv[tt][j2]; const f32x4 gn = *(const f32x4*)(p.gla_norm_w + v0); const f32x4 o = ao[j2][tt];
                    u32x2 pk; pk.x = cvt_pk_bf16(o[0] * rstd * gn[0] * siluf_(bflo(rr.x)), o[1] * rstd * gn[1] * siluf_(bfhi(rr.x)));
                    pk.y = cvt_pk_bf16(o[2] * rstd * gn[2] * siluf_(bflo(rr.y)), o[3] * rstd * gn[3] * siluf_(bfhi(rr.y)));
                    *(u32x2*)rp = pk; } } }
#pragma unroll
        for (int ks = 0; ks < 2; ++ks) { bf16x8 Bv[2];
#pragma unroll
            for (int j2 = 0; j2 < 2; ++j2) Bv[j2] = tr_frag(lds + L_V + 32 * ks * RS_V + (32 * w + 16 * j2) * 2, RS_V, lane);
#pragma unroll
            for (int kt = 0; kt < 8; ++kt) { const bf16x8 Ak = tr_frag(lds + L_K + 32 * ks * RS_QK + 16 * kt * 2, RS_QK, lane);
#pragma unroll
                for (int j2 = 0; j2 < 2; ++j2) acc[kt][j2] = MFMA16(Ak, Bv[j2], acc[kt][j2]); } }
#pragma unroll
        for (int kt = 0; kt < 8; ++kt) { const f32x4 d = *(const LAS f32x4*)(lds + (ch * 128 + 16 * kt + 4 * g4) * 4);
#pragma unroll
            for (int j2 = 0; j2 < 2; ++j2) acc[kt][j2] = acc[kt][j2] * d; }
        __syncthreads();
    }
#undef GLA_LOAD_TILES
    if (sample && !nostore) { float* so = p.out + OUT_SS + (size_t)(idx * 4 + h) * 128 * 256;
#pragma unroll
        for (int kt = 0; kt < 8; ++kt)
#pragma unroll
            for (int j2 = 0; j2 < 2; ++j2)
#pragma unroll
                for (int r = 0; r < 4; ++r) so[(size_t)(16 * kt + 4 * g4 + r) * 256 + 32 * w + 16 * j2 + l15] = acc[kt][j2][r];
    }
}
constexpr int G_VN = 0, G_WS = 67584, G_ST = 102400, RS_VN = 528, RS_WS = 272;
__device__ __forceinline__ void gmlp_item(const Params& p, LAS unsigned char* lds, int chunk, int g, bool nostore = false, bool build_ws = true) {
    int tid_ = threadIdx.x; asm volatile("" : "+v"(tid_));
    const int tid = tid_, lane = tid & 63, w = tid >> 6, g4 = lane >> 4, l15 = lane & 15;
    bf16_t* proj = (bf16_t*)(p.ws + WS_PROJ); const int tok0 = chunk * 128;
    u32x4 gvr[8]; u32x2 uzr[8][2];
#pragma unroll
    for (int i = 0; i < 8; ++i) { const int e = tid + 512 * i, r = e >> 5, c = e & 31; gvr[i] = *(const u32x4*)(proj + (size_t)(tok0 + r) * PJ + PC_GV + g * 256 + c * 8); }
#pragma unroll
    for (int it = 0; it < 8; ++it)
#pragma unroll
        for (int j2 = 0; j2 < 2; ++j2) uzr[it][j2] = *(const u32x2*)(proj + (size_t)(tok0 + 16 * it + l15) * PJ + PC_UZ + g * 256 + 32 * w + 16 * j2 + 4 * g4);
    if (tid < 128) { const float* gp = (const float*)(p.ws + WS_GVST) + (size_t)(tok0 + tid) * 32; float s = 0.f, q = 0.f;
#pragma unroll
        for (int k = 0; k < 8; ++k) { const f32x4 v = *(const f32x4*)(gp + 4 * k); s += v[0] + v[2]; q += v[1] + v[3]; }
        const float mean = s * (1.0f / 1024.0f), var = fmaxf(q * (1.0f / 1024.0f) - mean * mean, 0.f);
        *(LAS f32x2*)(lds + G_ST + tid * 8) = (f32x2){mean, rsqrtf(var + EPS)}; }
    if (build_ws)
#pragma unroll
    for (int i = 0; i < 8; ++i) { const int e = tid + 512 * i, r = e >> 5, j4 = (e & 31) * 4; f32x4 v = *(const f32x4*)(p.w_s + (size_t)(g * 128 + r) * 128 + j4);
        if (r < 64 && j4 >= 64) v = (f32x4){0.f, 0.f, 0.f, 0.f};
        u32x2 pk; pk.x = cvt_pk_bf16(v[0], v[1]); pk.y = cvt_pk_bf16(v[2], v[3]); *(LAS u32x2*)(lds + G_WS + r * RS_WS + j4 * 2) = pk; }
    __syncthreads();
#pragma unroll
    for (int i = 0; i < 8; ++i) { const int e = tid + 512 * i, r = e >> 5, c = e & 31; const u32x4 a = gvr[i];
        const f32x2 st = *(const LAS f32x2*)(lds + G_ST + r * 8); const float* lw = p.ln_v_w + g * 256 + c * 8; const float* lb = p.ln_v_b + g * 256 + c * 8;
        const f32x4 w0 = *(const f32x4*)lw, w1 = *(const f32x4*)(lw + 4), b0 = *(const f32x4*)lb, b1 = *(const f32x4*)(lb + 4);
        u32x4 o; o.x = cvt_pk_bf16((bflo(a.x) - st[0]) * st[1] * w0[0] + b0[0], (bfhi(a.x) - st[0]) * st[1] * w0[1] + b0[1]);
        o.y = cvt_pk_bf16((bflo(a.y) - st[0]) * st[1] * w0[2] + b0[2], (bfhi(a.y) - st[0]) * st[1] * w0[3] + b0[3]);
        o.z = cvt_pk_bf16((bflo(a.z) - st[0]) * st[1] * w1[0] + b1[0], (bfhi(a.z) - st[0]) * st[1] * w1[1] + b1[1]);
        o.w = cvt_pk_bf16((bflo(a.w) - st[0]) * st[1] * w1[2] + b1[2], (bfhi(a.w) - st[0]) * st[1] * w1[3] + b1[3]);
        *(LAS u32x4*)(lds + G_VN + r * RS_VN + c * 16) = o; }
    __syncthreads();
    f32x4 acc[2][8];
#pragma unroll
    for (int j2 = 0; j2 < 2; ++j2)
#pragma unroll
        for (int it = 0; it < 8; ++it) acc[j2][it] = (f32x4){0.f, 0.f, 0.f, 0.f};
#pragma unroll
    for (int ks = 0; ks < 4; ++ks) { bf16x8 Av[2];
#pragma unroll
        for (int j2 = 0; j2 < 2; ++j2) Av[j2] = tr_frag(lds + G_VN + 32 * ks * RS_VN + (32 * w + 16 * j2) * 2, RS_VN, lane);
#pragma unroll
        for (int it = 0; it < 8; ++it) { if (ks >= 2 && it < 4) continue; const bf16x8 Bw = row_frag(lds + G_WS + 16 * it * RS_WS + ks * 64, RS_WS, lane);
#pragma unroll
            for (int j2 = 0; j2 < 2; ++j2) acc[j2][it] = MFMA16(Av[j2], Bw, acc[j2][it]); } }
#pragma unroll
    for (int it = 0; it < 8; ++it) { const int i = 16 * it + l15; const float bs = p.b_s[g * 128 + i];
#pragma unroll
        for (int j2 = 0; j2 < 2; ++j2) { bf16_t* rp = proj + (size_t)(tok0 + i) * PJ + PC_UZ + g * 256 + 32 * w + 16 * j2 + 4 * g4; const u32x2 uz = uzr[it][j2]; const f32x4 a = acc[j2][it];
            u32x2 pk; pk.x = cvt_pk_bf16(bflo(uz.x) * (a[0] + bs), bfhi(uz.x) * (a[1] + bs)); pk.y = cvt_pk_bf16(bflo(uz.y) * (a[2] + bs), bfhi(uz.y) * (a[3] + bs)); if (!nostore) *(u32x2*)rp = pk; } }
    __syncthreads();
}
__device__ __forceinline__ void gmlp_sample_item(const Params& p, LAS unsigned char* lds, int b, bool nostore = false) {
    int tid_ = threadIdx.x; asm volatile("" : "+v"(tid_));
    const int tid = tid_, lane = tid & 63, w = tid >> 6; bf16_t* proj = (bf16_t*)(p.ws + WS_PROJ); const int tok0 = SEQ + b * SAMP_T;
    LAS float* vn = (LAS float*)lds; LAS float* wsm = (LAS float*)(lds + 65536); LAS float* st = (LAS float*)(lds + 65536 + 4096);
    for (int i = 0; i < 2; ++i) { const int r = 2 * w + i; const bf16_t* rp = proj + (size_t)(tok0 + r) * PJ + PC_GV;
        const u32x4 a = *(const u32x4*)(rp + lane * 8), bb = *(const u32x4*)(rp + 512 + lane * 8);
        float x[16]; x[0] = bflo(a.x); x[1] = bfhi(a.x); x[2] = bflo(a.y); x[3] = bfhi(a.y); x[4] = bflo(a.z); x[5] = bfhi(a.z); x[6] = bflo(a.w); x[7] = bfhi(a.w);
        x[8] = bflo(bb.x); x[9] = bfhi(bb.x); x[10] = bflo(bb.y); x[11] = bfhi(bb.y); x[12] = bflo(bb.z); x[13] = bfhi(bb.z); x[14] = bflo(bb.w); x[15] = bfhi(bb.w);
        float s = 0.f;
#pragma unroll
        for (int k = 0; k < 16; ++k) s += x[k];
        const float mean = wave_sum(s) * (1.0f / 1024.0f); float q = 0.f;
#pragma unroll
        for (int k = 0; k < 16; ++k) { const float d = x[k] - mean; q += d * d; }
        const float rstd = rsqrtf(wave_sum(q) * (1.0f / 1024.0f) + EPS);
        if (lane == 0) { st[r * 2] = mean; st[r * 2 + 1] = rstd; } }
    for (int e = tid; e < 1024; e += 512) { const int g = e >> 8, i = (e >> 4) & 15, j = e & 15; wsm[e] = p.w_s[(size_t)(g * 128 + i) * 128 + j]; }
    __syncthreads();
    float* vs = p.out + OUT_VS + (size_t)b * SAMP_T * 1024;
    for (int i = 0; i < 4; ++i) { const int e = tid + 512 * i, r = e >> 7, c = (e & 127) * 8; const u32x4 a = *(const u32x4*)(proj + (size_t)(tok0 + r) * PJ + PC_GV + c);
        const float mean = st[r * 2], rstd = st[r * 2 + 1]; const f32x4 w0 = *(const f32x4*)(p.ln_v_w + c), w1 = *(const f32x4*)(p.ln_v_w + c + 4), b0 = *(const f32x4*)(p.ln_v_b + c), b1 = *(const f32x4*)(p.ln_v_b + c + 4);
        f32x4 o0, o1; o0[0] = (bflo(a.x) - mean) * rstd * w0[0] + b0[0]; o0[1] = (bfhi(a.x) - mean) * rstd * w0[1] + b0[1]; o0[2] = (bflo(a.y) - mean) * rstd * w0[2] + b0[2]; o0[3] = (bfhi(a.y) - mean) * rstd * w0[3] + b0[3];
        o1[0] = (bflo(a.z) - mean) * rstd * w1[0] + b1[0]; o1[1] = (bfhi(a.z) - mean) * rstd * w1[1] + b1[1]; o1[2] = (bflo(a.w) - mean) * rstd * w1[2] + b1[2]; o1[3] = (bfhi(a.w) - mean) * rstd * w1[3] + b1[3];
        *(LAS f32x4*)(vn + r * 1024 + c) = o0; *(LAS f32x4*)(vn + r * 1024 + c + 4) = o1; *(f32x4*)(vs + r * 1024 + c) = o0; *(f32x4*)(vs + r * 1024 + c + 4) = o1; }
    __syncthreads();
    { const int c = tid * 2, g = c >> 8; f32x2 v[16];
#pragma unroll
      for (int j = 0; j < 16; ++j) v[j] = *(const LAS f32x2*)(vn + j * 1024 + c);
#pragma unroll
      for (int i = 0; i < 16; ++i) { float s0 = p.b_s[g * 128 + i], s1 = s0;
#pragma unroll
          for (int j = 0; j < 16; ++j) { const float wv = wsm[g * 256 + i * 16 + j]; s0 += wv * v[j][0]; s1 += wv * v[j][1]; }
          bf16_t* rp = proj + (size_t)(tok0 + i) * PJ + PC_UZ + c; const unsigned uz = *(const unsigned*)rp; if (!nostore) *(unsigned*)rp = cvt_pk_bf16(bflo(uz) * s0, bfhi(uz) * s1); } }
    __syncthreads();
}
__device__ __forceinline__ void phase4(const Params& p) {
    const unsigned* useg = (const unsigned*)((unsigned char*)p.out + RB_USEG); unsigned* sst = (unsigned*)((unsigned char*)p.out + RB_SSTART); const float* dseg = (const float*)(p.ws + WS_DSEG);
    int tid_ = threadIdx.x; asm volatile("" : "+v"(tid_)); const int tid = tid_; int bid_ = blockIdx.x; asm volatile("" : "+s"(bid_)); const int bid = bid_;
    for (int e2 = bid * 512 + tid; e2 < 65536; e2 += gridDim.x * 512) {
        const int e = e2 * 2, h = e >> 15, v = (e >> 7) & 255, kap = e & 127; float S0 = 0.f, S1 = 0.f;
        for (int s0 = 0; s0 < NSEG; s0 += 32) { unsigned u[32]; f32x2 dd[32];
#pragma unroll
            for (int s = 0; s < 32; ++s) { u[s] = __builtin_nontemporal_load(useg + (size_t)(s0 + s) * 65536 + e2); dd[s] = *(const f32x2*)(dseg + ((s0 + s) * 4 + h) * 128 + kap); }
#pragma unroll
            for (int s = 0; s < 32; ++s) { sst[(size_t)(s0 + s) * 65536 + e2] = cvt_pk_bf16(S0, S1); S0 = dd[s][0] * S0 + bflo(u[s]); S1 = dd[s][1] * S1 + bfhi(u[s]); } }
        p.out[OUT_SP + (size_t)(h * 128 + kap) * 256 + v] = S0; p.out[OUT_SP + (size_t)(h * 128 + kap + 1) * 256 + v] = S1; }
}
__device__ __forceinline__ void phase8(const Params& p, bool nostore = false) {
    int tid_ = threadIdx.x; asm volatile("" : "+v"(tid_)); const int tid = tid_; int bid_ = blockIdx.x; asm volatile("" : "+s"(bid_)); const int bid = bid_;
    const int lane = tid & 63, wv = tid >> 6;
    for (int row = SEQ + bid * 8 + wv; row < MTOT; row += gridDim.x * 8) { float* yr = p.out + (size_t)row * D;
        f32x4 v[4]; float ss = 0.f;
#pragma unroll
        for (int i = 0; i < 4; ++i) { v[i] = *(const f32x4*)(yr + i * 256 + lane * 4); ss += (v[i][0] * v[i][0] + v[i][1] * v[i][1]) + (v[i][2] * v[i][2] + v[i][3] * v[i][3]); }
        const float rstd = rsqrtf(wave_sum(ss) * (1.0f / D) + EPS);
#pragma unroll
        for (int i = 0; i < 4; ++i) { const int c = i * 256 + lane * 4; const f32x4 fw = *(const f32x4*)(p.final_norm_w + c); if (!nostore) *(f32x4*)(yr + c) = v[i] * rstd * fw; } }
}

__global__ __launch_bounds__(512, 2) void mega(Params p0) {
    extern __shared__ __attribute__((aligned(16))) unsigned char shm[];
    LAS unsigned char* lds = (LAS unsigned char*)shm;
    const bool multi = (p0.ph_hi - p0.ph_lo) > 1;
    if (multi) { volatile LAS unsigned* st = (volatile LAS unsigned*)(lds + LDS_BAR);
        if (threadIdx.x == 0) { st[0] = 0u; st[1] = 0u; }
        __syncthreads();
        (void)xcd_barrier_post((unsigned*)(p0.ws + WS_CTL), st); }
#ifdef PROBE_PH
    constexpr int PDUP = PROBE_PH >= 30 ? 3 : (PROBE_PH >= 20 ? 2 : PROBE_PH);
    const int nph = p0.ph_hi + 1;
#else
    const int nph = p0.ph_hi;
#endif
    for (int pi = p0.ph_lo; pi < nph; ++pi) {
#if defined(__HIP_DEVICE_COMPILE__)
        const __attribute__((address_space(4))) Params* kp = (const __attribute__((address_space(4))) Params*)__builtin_amdgcn_kernarg_segment_ptr();
        asm volatile("" : "+s"(kp));
        const Params p = *kp;
#else
        const Params p = p0;
#endif
        int bid_ = blockIdx.x; asm volatile("" : "+s"(bid_)); const int bid = bid_;
#ifdef PROBE_PH
        const int ph = pi > PDUP ? pi - 1 : pi; const bool first = (pi == PDUP); const bool nostore = first && (p.ph_hi < 100);
#else
        const int ph = pi; const bool nostore = false;
#endif
      {
        if (ph == 0) phase0(p, lds);
        else if (ph == 1) phase1(p);
        else if (ph == 2) { pg8::Order S; S.init(SEQ / 256, 32, gridDim.x, bid); S.wgm = GEMM1_WGM; Ptr1 P{(const char*)p.out + RB_H, (const char*)p.out + RB_BT1};
            Epi1 E{(bf16_t*)(p.ws + WS_PROJ), (float*)(p.ws + WS_GVST)};
#ifdef PROBE_PH
            if (!(first && PROBE_PH == 20)) pg8::gemm_phase<Epi1, Ptr1, pg8::Order>(lds, S, P, E, D, D, D);
            if (!(first && PROBE_PH == 21)) sample_gemm1(p, lds, bid);
#else
            pg8::gemm_phase<Epi1, Ptr1, pg8::Order>(lds, S, P, E, D, D, D); sample_gemm1(p, lds, bid);
#endif
            }
        else if (ph == 3) {
            const int pm = (bid & 7) * 8 + (bid >> 5), hg = (bid >> 3) & 3;
            gla_segA(p, lds, pm, hg);
            gmlp_item(p, lds, 2 * pm, hg, nostore, true);
            gmlp_item(p, lds, 2 * pm + 1, hg, nostore, false);
            if (bid >= 16 && bid < 80) { const int it = bid - 16; gla_prep(p, lds, SEQ + (it >> 2) * SAMP_T, 1, SAMP_T, it & 3, 256 + (it >> 2), false, 0, 0); __syncthreads(); } }
        else if (ph == 4) { phase4(p); if (bid >= 128 && bid < 192) gla_out(p, lds, 1, (bid - 128) >> 2, (bid - 128) & 3, nostore);
            else if (bid >= 192 && bid < 208) gmlp_sample_item(p, lds, bid - 192, nostore); }
        else if (ph == 5) {
            gla_out(p, lds, 0, (bid & 7) * 8 + (bid >> 5), (bid >> 3) & 3, nostore); }
        else if (ph == 6) { pg8::Order2 S; S.c = bid; Ptr2 P{(const char*)(p.ws + WS_PROJ), (const char*)(p.ws + WS_BTA), (const char*)(p.ws + WS_BTB)};
            Epi2 E{(bf16_t*)(p.ws + WS_PROJ), p.b_gate, nostore}; pg8::gemm_phase<Epi2, Ptr2, pg8::Order2>(lds, S, P, E, D, PJ, D); sample_gemm2(p, bid, nostore); }
        else if (ph == 7) { pg8::Order S; S.init(SEQ / 256, 4, gridDim.x, bid); Ptr3 P{(const char*)(p.ws + WS_PROJ), (const char*)(p.ws + WS_BTO)};
            Epi3 E{p.x_prompt, (const float*)(p.ws + WS_ADA), p.final_norm_w, p.out, (float*)(p.ws + WS_XB), (unsigned*)(p.ws + WS_PCNT)}; pg8::gemm_phase<Epi3, Ptr3, pg8::Order>(lds, S, P, E, D, PJ, D); sample_gemm3(p, bid); }
        else if (ph == 8) phase8(p, nostore);
      }
        if (multi && pi + 1 < nph) { XcdBarrier xb; xb.bar = (unsigned*)(p.ws + WS_CTL); xb.x = xb_xcc_id(); xb.st = (volatile LAS unsigned*)(lds + LDS_BAR); xcd_barrier(xb); }
    }
}

#ifndef MK_LAUNCHES
#define MK_LAUNCHES 1
#endif
extern "C" void kernel_launch(void* const* d_in, const int* in_sizes, int n_in, void* d_out, int out_size, void* d_ws, size_t ws_size, hipStream_t stream) {
    static int ready = 0;
    if (ready == 0) {
        if (n_in != 21 || ws_size < WS_END) { fprintf(stderr, "kernel_launch: need 21 inputs and >= %zu bytes of workspace (got %d, %zu)\n", (size_t)WS_END, n_in, ws_size); ready = -1; return; }
        if (hipFuncSetAttribute((const void*)mega, hipFuncAttributeMaxDynamicSharedMemorySize, LDS_BYTES) != hipSuccess) { fprintf(stderr, "kernel_launch: hipFuncSetAttribute failed\n"); ready = -1; return; }
        int per_cu = 0; (void)hipOccupancyMaxActiveBlocksPerMultiprocessor(&per_cu, (const void*)mega, 512, LDS_BYTES); (void)hipGetLastError();
        if (per_cu < 1) fprintf(stderr, "kernel_launch: occupancy query reports %d blocks per CU\n", per_cu);
        ready = 1;
    }
    if (ready < 0) return;
    (void)hipMemsetAsync((char*)d_ws + WS_CTL, 0, 32768, stream);
    Params p{};
    const float** pp = (const float**)&p;
    for (int i = 0; i < 21; ++i) pp[i] = (const float*)d_in[i];
    p.out = (float*)d_out; p.ws = (unsigned char*)d_ws;
    const int nl = MK_LAUNCHES;
    for (int li = 0; li < nl; ++li) {
        p.ph_lo = (nl == 1) ? 0 : li; p.ph_hi = (nl == 1) ? 9 : li + 1;
        void* args[] = {&p};
        hipError_t e;
        if (nl == 1) e = hipLaunchCooperativeKernel((const void*)mega, dim3(256), dim3(512), args, LDS_BYTES, stream);
        else { hipLaunchKernelGGL(mega, dim3(256), dim3(512), LDS_BYTES, stream, p); e = hipPeekAtLastError(); }
        if (e != hipSuccess) { fprintf(stderr, "kernel_launch: launch %d failed: %s\n", li, hipGetErrorString(e)); break; }
    }
}
```

```cpp
#include <hip/hip_runtime.h>
#include <cstdio>

#define LAS __attribute__((address_space(3)))
typedef unsigned short bf16_t;
typedef short bf16x8 __attribute__((ext_vector_type(8)));
typedef short s16x4 __attribute__((ext_vector_type(4)));
typedef float f32x4 __attribute__((ext_vector_type(4)));
typedef float f32x2 __attribute__((ext_vector_type(2)));
typedef unsigned u32x4 __attribute__((ext_vector_type(4)));
typedef unsigned u32x2 __attribute__((ext_vector_type(2)));

constexpr int D = 1024, SEQ = 16384, NSAMP = 16, SAMP_T = 16, MTOT = SEQ + NSAMP * SAMP_T;
constexpr int WIN_LD = 8208;
constexpr int PJ = 7168;
constexpr int PC_Q = 0, PC_K = 512, PC_V = 1024, PC_R = 2048, PC_UZ = 3072, PC_GV = 4096, PC_GA = 5120;
constexpr int N1 = 8256;
constexpr int NSEG = 64, SEGCH = 4;
constexpr float EPS = 1e-6f;
constexpr size_t WS_CTL = 0, WS_PCNT = 16384, WS_ADA = 32768, WS_ALR = WS_ADA + 17 * 3072 * 4, WS_DSEG = WS_ALR + (size_t)MTOT * 16 * 4,
                 WS_ROWSS = WS_DSEG + NSEG * 4 * 128 * 4, WS_BTA = WS_ROWSS + (size_t)MTOT * 16 * 4, WS_BTB = WS_BTA + 2097152,
                 WS_BTO = WS_BTB + 2097152, WS_PROJ = WS_BTO + 4194304, WS_GVST = WS_PROJ + (size_t)MTOT * PJ * 2, WS_DCH = WS_GVST + (size_t)SEQ * 16 * 8, WS_XB = WS_DCH + (size_t)272 * 4 * 128 * 4, WS_END = WS_XB + (size_t)64 * 256 * 4 * 4;
constexpr size_t RB_H = 0, RB_BT1 = (size_t)MTOT * D * 2, RB_USEG = 0, RB_SSTART = 16777216;
constexpr size_t OUT_YS = (size_t)SEQ * D, OUT_SP = OUT_YS + 256 * D, OUT_SS = OUT_SP + 4 * 128 * 256, OUT_VS = OUT_SS + 16 * 4 * 128 * 256;
constexpr int LDS_BAR = 156160, LDS_BYTES = 156672;

struct Params {
    const float* x_prompt; const float* x_sample; const float* state_gla; const float* c_prompt; const float* c_sample;
    const float* norm_w; const float* w_ada; const float* b_ada; const float* w_in; const float* w_a2; const float* b_a;
    const float* gla_norm_w; const float* ln_v_w; const float* ln_v_b; const float* w_s; const float* b_s; const float* b_gate;
    const float* w_proj_a; const float* w_proj_b; const float* w_out; const float* final_norm_w;
    float* out; unsigned char* ws; int ph_lo; int ph_hi;
};

__device__ __forceinline__ unsigned cvt_pk_bf16(float lo, float hi) { unsigned r; asm volatile("v_cvt_pk_bf16_f32 %0, %1, %2" : "=v"(r) : "v"(lo), "v"(hi)); return r; }
__device__ __forceinline__ bf16_t f2bf(float f) { return (bf16_t)(cvt_pk_bf16(f, 0.f) & 0xffffu); }
__device__ __forceinline__ float bf2f(bf16_t b) { return __uint_as_float(((unsigned)b) << 16); }
__device__ __forceinline__ float bflo(unsigned w) { return __uint_as_float(w << 16); }
__device__ __forceinline__ float bfhi(unsigned w) { return __uint_as_float(w & 0xffff0000u); }
__device__ __forceinline__ float sigmoidf_(float x) { return __builtin_amdgcn_rcpf(1.0f + __expf(-x)); }
__device__ __forceinline__ float siluf_(float x) { return x * __builtin_amdgcn_rcpf(1.0f + __expf(-x)); }
__device__ __forceinline__ float wave_sum(float v) {
#pragma unroll
    for (int o = 32; o > 0; o >>= 1) v += __shfl_xor(v, o);
    return v;
}
__device__ __forceinline__ bf16x8 row_frag(const LAS unsigned char* base, int rs, int lane) { return *(const LAS bf16x8*)(base + rs * (lane & 15) + 16 * (lane >> 4)); }
__device__ __forceinline__ bf16x8 tr_frag(const LAS unsigned char* base, int rs, int lane) {
    const int g = lane >> 4, q = (lane & 15) >> 2, pp = lane & 3;
    const LAS unsigned char* a = base + rs * (8 * g + q) + 8 * pp;
    const s16x4 lo = __builtin_amdgcn_ds_read_tr16_b64_v4i16((LAS s16x4*)a);
    const s16x4 hi = __builtin_amdgcn_ds_read_tr16_b64_v4i16((LAS s16x4*)(a + 4 * rs));
    bf16x8 r; r[0] = lo[0]; r[1] = lo[1]; r[2] = lo[2]; r[3] = lo[3]; r[4] = hi[0]; r[5] = hi[1]; r[6] = hi[2]; r[7] = hi[3]; return r;
}
#define MFMA16(a, b, c) __builtin_amdgcn_mfma_f32_16x16x32_bf16(a, b, c, 0, 0, 0)

#define XB_TMO      128
#define XB_XCNT(j)  (256  + 64 * (j))
#define XB_XSUB(j)  (1280 + 64 * (j))
#define XB_XGEN(j)  (2304 + 64 * (j))
#define XB_TOP      3328
#define XB_TOPGEN   3392
#define XCD_BAR_WORDS 3456
#define XB_SPIN_CAP (1u << 22)
__device__ __forceinline__ unsigned xb_ld(unsigned* p)              { return __hip_atomic_load(p, __ATOMIC_RELAXED, __HIP_MEMORY_SCOPE_AGENT); }
__device__ __forceinline__ unsigned xb_add(unsigned* p, unsigned v) { return __hip_atomic_fetch_add(p, v, __ATOMIC_RELAXED, __HIP_MEMORY_SCOPE_AGENT); }
__device__ __forceinline__ unsigned xb_xcc_id() { return (unsigned)__builtin_amdgcn_s_getreg((3 << 11) | 20) & 0xFu; }
#define XB_SPIN(cond, bar) do { unsigned _sp = 0; while (cond) { __builtin_amdgcn_s_sleep(1); \
    if ((++_sp & 255u) == 0u) { if (xb_ld(&(bar)[XB_TMO])) break; if (_sp > XB_SPIN_CAP) { atomicAdd(&(bar)[XB_TMO], 1u); break; } } } } while (0)
struct XcdBarrier { unsigned* bar; unsigned x; volatile LAS unsigned* st; };
__device__ __forceinline__ XcdBarrier xcd_barrier_post(unsigned* bar, volatile LAS unsigned* st) {
    XcdBarrier b; b.bar = bar; b.x = xb_xcc_id(); b.st = st;
    if (threadIdx.x == 0) (void)xb_add(&bar[XB_XCNT(b.x)], 1u);
    return b;
}
__device__ __forceinline__ void xcd_barrier_complete(unsigned* bar, unsigned x, unsigned& nloc, unsigned& nx) {
    const unsigned G = gridDim.x * gridDim.y * gridDim.z;
    unsigned sum, cnt, mine, sp = 0u;
    for (;;) {
        sum = 0u; cnt = 0u; mine = 0u;
#pragma unroll
        for (unsigned j = 0; j < 16; ++j) { const unsigned c = xb_ld(&bar[XB_XCNT(j)]); sum += c; cnt += (c > 0u) ? 1u : 0u; mine = (j == x) ? c : mine; }
        if (sum == G) break;
        __builtin_amdgcn_s_sleep(1);
        if ((++sp & 255u) == 0u) { if (xb_ld(&bar[XB_TMO])) break; if (sp > XB_SPIN_CAP) { atomicAdd(&bar[XB_TMO], 1u); break; } }
    }
    nloc = mine > 0u ? mine : 1u; nx = cnt > 0u ? cnt : 1u;
}
__device__ __forceinline__ void xcd_barrier(const XcdBarrier& b) {
    asm volatile("s_waitcnt vmcnt(0)" ::: "memory");
    __syncthreads();
    if (threadIdx.x == 0) {
        unsigned* bar = b.bar;
        __builtin_amdgcn_s_waitcnt(0);
        unsigned nloc = b.st[0], nx = b.st[1];
        if (nloc == 0u) { xcd_barrier_complete(bar, b.x, nloc, nx); b.st[0] = nloc; b.st[1] = nx; }
        const unsigned old = xb_add(&bar[XB_XSUB(b.x)], 1u);
        const unsigned gen = old / nloc;
        if (old + 1u == (gen + 1u) * nloc) {
            __builtin_amdgcn_fence(__ATOMIC_RELEASE, "agent");
            asm volatile("s_waitcnt vmcnt(0)" ::: "memory");
            const unsigned og = xb_add(&bar[XB_TOP], 1u);
            const unsigned tg = og / nx;
            if (og + 1u == (tg + 1u) * nx) xb_add(&bar[XB_TOPGEN], 1u);
            else XB_SPIN(xb_ld(&bar[XB_TOPGEN]) == tg, bar);
            __builtin_amdgcn_fence(__ATOMIC_ACQUIRE, "agent");
            xb_add(&bar[XB_XGEN(b.x)], 1u);
            asm volatile("s_waitcnt vmcnt(0)" ::: "memory");
        } else {
            XB_SPIN(xb_ld(&bar[XB_XGEN(b.x)]) == gen, bar);
            __builtin_amdgcn_fence(__ATOMIC_ACQUIRE, "agent");
            asm volatile("s_waitcnt vmcnt(0)" ::: "memory");
        }
    }
    __syncthreads();
}

namespace pg8 {
constexpr int BM = 256, BK = 64, HALF = 128, HTB = HALF * BK * 2, NXCD = 8, WGM = 8;
__device__ __forceinline__ int lds_byte(int r, int c) { const int st = (r >> 4) * 2 + (c >> 5), rr = r & 15, cc = c & 31, ob = rr * 64 + cc * 2; return st * 1024 + (ob ^ (((ob >> 9) & 1) << 5)); }
__device__ __forceinline__ void stage_rc(int b, int& R, int& C) { const int st = b / 1024, sb = b % 1024, swz = sb ^ (((sb >> 9) & 1) << 5); R = (st >> 1) * 16 + swz / 64; C = (st & 1) * 32 + (swz % 64) / 2; }
__device__ __forceinline__ int perm32(int rho) { const int n = rho >> 4, i = rho & 15; return 8 * (i >> 2) + 4 * n + (i & 3); }
struct Unit { int pm, pn; };
struct Order {
    int nM, nN, nwg, G, c;
    __device__ void init(int nM_, int nN_, int G_, int c_) { nM = nM_; nN = nN_; nwg = nM * nN; G = G_; c = c_; }
    __device__ bool next(int i, Unit& u) const {
        const long L = (long)i * G + c; if (L >= nwg) return false;
        int wgid = (int)L; { const int q = nwg / NXCD, r = nwg % NXCD, xcd = wgid % NXCD, off = wgid / NXCD; wgid = (xcd < r ? xcd * (q + 1) : r * (q + 1) + (xcd - r) * q) + off; }
        const int nig = WGM * nN, gid = wgid / nig, fm = gid * WGM, gsz = (nM - fm) < WGM ? (nM - fm) : WGM;
        u.pm = fm + ((wgid % nig) % gsz); u.pn = (wgid % nig) / gsz; return true;
    }
};
struct Order2 {
    int c;
    __device__ bool next(int i, Unit& u) const { if (i >= 2) return false; const int x = c & 7, q = c >> 3; u.pm = x * 8 + (q >> 2); u.pn = (q & 3) + 4 * i; return true; }
};
template <class Epi, class Ptr, class Ord>
__device__ __forceinline__ void gemm_phase(LAS unsigned char* lds, const Ord& S, const Ptr& P, const Epi& E, int K, int lda, int ldb) {
    int tid_ = threadIdx.x; asm volatile("" : "+v"(tid_));
    const int tid = tid_, wid = __builtin_amdgcn_readfirstlane(tid >> 6), lane = tid & 63, wr = wid >> 2, wc = wid & 3, fr = lane & 15, fq = lane >> 4;
    const int nt = K / BK;
    unsigned voffA[2], voffB[2];
#pragma unroll
    for (int i = 0; i < 2; ++i) { int R, C; stage_rc(tid * 16 + i * 8192, R, C); const int Rb = Epi::PERM ? ((R & ~31) + perm32(R & 31)) : R;
        voffA[i] = (unsigned)(R * lda + C) * 2u; voffB[i] = (unsigned)(Rb * ldb + C) * 2u; }
    const size_t kstep = (size_t)(BK * 2);
    const size_t hstepA = (size_t)HALF * lda * 2, hstepB = (size_t)HALF * ldb * 2;
    const unsigned ldsw = (unsigned)wid * 1024u;
    const int aoff = lds_byte(wr * 64 + fr, fq * 8), boff = lds_byte(wc * 32 + fr, fq * 8);
#define PG8_SA(b, h) (((b) * 2 + (h)) * HTB)
#define PG8_SB(b, h) ((4 + (b) * 2 + (h)) * HTB)
#define PG8_STAGE(bufoff, gbase, voff) do { _Pragma("unroll") for (int _i = 0; _i < 2; ++_i) \
        __builtin_amdgcn_global_load_lds((const unsigned*)((const char*)(gbase) + (voff)[_i]), (LAS unsigned*)(lds + (bufoff) + ldsw + _i * 8192), 16, 0, 0); } while (0)
#define PG8_LDA(dst, b, h) do { _Pragma("unroll") for (int m = 0; m < 4; ++m) _Pragma("unroll") for (int k = 0; k < 2; ++k) dst[m][k] = *(const LAS bf16x8*)(lds + PG8_SA(b, h) + aoff + m * 2048 + k * 1024); } while (0)
#define PG8_LDB(dst, b, h) do { _Pragma("unroll") for (int n = 0; n < 2; ++n) _Pragma("unroll") for (int k = 0; k < 2; ++k) dst[n][k] = *(const LAS bf16x8*)(lds + PG8_SB(b, h) + boff + n * 2048 + k * 1024); } while (0)
#define PG8_MMA(ai, bj, At, Bt) do { __builtin_amdgcn_s_setprio(1); _Pragma("unroll") for (int m = 0; m < 4; ++m) _Pragma("unroll") for (int n = 0; n < 2; ++n) _Pragma("unroll") for (int k = 0; k < 2; ++k) \
        acc[ai][bj][m][n] = __builtin_amdgcn_mfma_f32_16x16x32_bf16(Bt[n][k], At[m][k], acc[ai][bj][m][n], 0, 0, 0); __builtin_amdgcn_s_setprio(0); } while (0)
#define PG8_WAIT_V(n) asm volatile("s_waitcnt vmcnt(" #n ")" ::: "memory")
#define PG8_WAIT_L(n) asm volatile("s_waitcnt lgkmcnt(" #n ")" ::: "memory")
#define PG8_BAR __builtin_amdgcn_s_barrier()
#define PG8_SCHED __builtin_amdgcn_sched_barrier(0)
    Unit cur, nxt; int ui = 0;
    if (!S.next(0, cur)) return;
    f32x4 acc[2][2][4][2];
#pragma unroll
    for (int a = 0; a < 2; ++a)
#pragma unroll
        for (int b = 0; b < 2; ++b)
#pragma unroll
            for (int m = 0; m < 4; ++m)
#pragma unroll
                for (int n = 0; n < 2; ++n) acc[a][b][m][n] = (f32x4){0.f, 0.f, 0.f, 0.f};
    bf16x8 At[4][2], B0[2][2], B1[2][2];
    const char* cA = P.aptr(cur); const char* cB = P.bptr(cur);
    PG8_STAGE(PG8_SB(0, 0), cB, voffB); PG8_STAGE(PG8_SA(0, 0), cA, voffA); PG8_STAGE(PG8_SB(0, 1), cB + hstepB, voffB); PG8_STAGE(PG8_SA(0, 1), cA + hstepA, voffA);
    if (wr == 1) PG8_BAR;
    PG8_WAIT_V(4); PG8_BAR;
    PG8_STAGE(PG8_SB(1, 0), cB + kstep, voffB); PG8_STAGE(PG8_SA(1, 0), cA + kstep, voffA); PG8_STAGE(PG8_SB(1, 1), cB + hstepB + kstep, voffB);
    PG8_WAIT_V(6); PG8_BAR;
    for (;;) {
        const bool has_next = S.next(ui + 1, nxt);
        const char* nA = has_next ? P.aptr(nxt) : cA; const char* nB = has_next ? P.bptr(nxt) : cB;
        for (int t = 0; t < nt; t += 2) {
            const bool last = (t == nt - 2);
            const char* a1 = cA + (size_t)(t + 1) * kstep;
            const char* a2 = last ? nA : cA + (size_t)(t + 2) * kstep; const char* b2 = last ? nB : cB + (size_t)(t + 2) * kstep;
            const char* a3 = a2 + kstep; const char* b3 = b2 + kstep;
            PG8_LDB(B0, 0, 0); PG8_SCHED; PG8_LDA(At, 0, 0); PG8_STAGE(PG8_SA(1, 1), a1 + hstepA, voffA);
            PG8_WAIT_L(8); PG8_BAR; PG8_WAIT_L(0); PG8_MMA(0, 0, At, B0); PG8_BAR; PG8_SCHED;
            PG8_LDB(B1, 0, 1); PG8_STAGE(PG8_SB(0, 0), b2, voffB);
            PG8_BAR; PG8_WAIT_L(0); PG8_MMA(0, 1, At, B1); PG8_BAR;
            PG8_LDA(At, 0, 1); PG8_STAGE(PG8_SA(0, 0), a2, voffA);
            PG8_BAR; PG8_WAIT_L(0); PG8_MMA(1, 0, At, B0); PG8_BAR; PG8_SCHED;
            PG8_STAGE(PG8_SB(0, 1), b2 + hstepB, voffB);
            PG8_WAIT_V(6); PG8_BAR; PG8_MMA(1, 1, At, B1); PG8_BAR;
            PG8_LDB(B0, 1, 0); PG8_SCHED; PG8_LDA(At, 1, 0); PG8_STAGE(PG8_SA(0, 1), a2 + hstepA, voffA);
            PG8_WAIT_L(8); PG8_BAR; PG8_WAIT_L(0); PG8_MMA(0, 0, At, B0); PG8_BAR; PG8_SCHED;
            PG8_LDB(B1, 1, 1); PG8_STAGE(PG8_SB(1, 0), b3, voffB);
            PG8_BAR; PG8_WAIT_L(0); PG8_MMA(0, 1, At, B1); PG8_BAR;
            PG8_LDA(At, 1, 1); PG8_STAGE(PG8_SA(1, 0), a3, voffA);
            PG8_BAR; PG8_WAIT_L(0); PG8_MMA(1, 0, At, B0); PG8_BAR; PG8_SCHED;
            PG8_STAGE(PG8_SB(1, 1), b3 + hstepB, voffB);
            PG8_WAIT_V(6); PG8_BAR; PG8_MMA(1, 1, At, B1); PG8_BAR;
        }
        bool keep = false;
        if constexpr (!Epi::AFTER_DRAIN) keep = E(acc, cur, wr, wc, fr, fq);
        if (!has_next) break;
        if (!keep) {
#pragma unroll
        for (int a = 0; a < 2; ++a)
#pragma unroll
            for (int b = 0; b < 2; ++b)
#pragma unroll
                for (int m = 0; m < 4; ++m)
#pragma unroll
                    for (int n = 0; n < 2; ++n) acc[a][b][m][n] = (f32x4){0.f, 0.f, 0.f, 0.f};
        }
        cur = nxt; cA = nA; cB = nB; ++ui;
    }
    PG8_WAIT_V(0);
    if (wr == 0) PG8_BAR;
    PG8_BAR;
    if constexpr (Epi::AFTER_DRAIN) E.fused(acc, cur, wr, wc, fr, fq, lds, wid, lane);
#undef PG8_SA
#undef PG8_SB
#undef PG8_STAGE
#undef PG8_LDA
#undef PG8_LDB
#undef PG8_MMA
#undef PG8_WAIT_V
#undef PG8_WAIT_L
#undef PG8_BAR
#undef PG8_SCHED
}
}
using pg8::Unit;

struct Ptr1 { const char* A; const char* B; __device__ const char* aptr(const Unit& u) const { return A + (size_t)u.pm * 256 * D * 2; } __device__ const char* bptr(const Unit& u) const { return B + (size_t)u.pn * 256 * D * 2; } };
struct Epi1 {
    static constexpr bool PERM = true, AFTER_DRAIN = false;
    bf16_t* proj; float* gvst;
    __device__ __forceinline__ bool operator()(f32x4 (&acc)[2][2][4][2], const Unit& u, int wr, int wc, int fr, int fq) const {
        asm volatile("" : "+v"(fr), "+v"(fq));
        const int row0 = u.pm * 256 + wr * 64 + fr;
        if (u.pn >= 12 && u.pn < 20) {
            const int col = PC_UZ + (u.pn - 12) * 128 + wc * 32 + 8 * fq;
#pragma unroll
            for (int ai = 0; ai < 2; ++ai)
#pragma unroll
                for (int m = 0; m < 4; ++m) { bf16_t* rp = proj + (size_t)(row0 + ai * 128 + m * 16) * PJ + col;
                    const f32x4 u0 = acc[ai][0][m][0], u1 = acc[ai][0][m][1], z0 = acc[ai][1][m][0], z1 = acc[ai][1][m][1];
                    u32x4 w; w.x = cvt_pk_bf16(u0[0] * siluf_(z0[0]), u0[1] * siluf_(z0[1])); w.y = cvt_pk_bf16(u0[2] * siluf_(z0[2]), u0[3] * siluf_(z0[3]));
                    w.z = cvt_pk_bf16(u1[0] * siluf_(z1[0]), u1[1] * siluf_(z1[1])); w.w = cvt_pk_bf16(u1[2] * siluf_(z1[2]), u1[3] * siluf_(z1[3]));
                    __builtin_nontemporal_store(w, (u32x4*)rp); }
            return false;
        }
        const int col = (u.pn < 12 ? u.pn * 256 : PC_GV + (u.pn - 20) * 256) + wc * 32 + 8 * fq;
        const bool isgv = u.pn >= 20 && u.pn < 24;
#pragma unroll
        for (int ai = 0; ai < 2; ++ai)
#pragma unroll
            for (int m = 0; m < 4; ++m) { const int row = row0 + ai * 128 + m * 16; bf16_t* rp = proj + (size_t)row * PJ + col; float s = 0.f, q = 0.f;
#pragma unroll
                for (int bj = 0; bj < 2; ++bj) { const f32x4 v0 = acc[ai][bj][m][0], v1 = acc[ai][bj][m][1];
                    u32x4 w; w.x = cvt_pk_bf16(v0[0], v0[1]); w.y = cvt_pk_bf16(v0[2], v0[3]); w.z = cvt_pk_bf16(v1[0], v1[1]); w.w = cvt_pk_bf16(v1[2], v1[3]);
                    __builtin_nontemporal_store(w, (u32x4*)(rp + bj * 128));
                    s += (v0[0] + v0[1]) + (v0[2] + v0[3]) + (v1[0] + v1[1]) + (v1[2] + v1[3]);
                    q += (v0[0] * v0[0] + v0[1] * v0[1]) + (v0[2] * v0[2] + v0[3] * v0[3]) + (v1[0] * v1[0] + v1[1] * v1[1]) + (v1[2] * v1[2] + v1[3] * v1[3]); }
                if (isgv) { s += __shfl_xor(s, 16); s += __shfl_xor(s, 32); q += __shfl_xor(q, 16); q += __shfl_xor(q, 32);
                    if (fq == 0) *(f32x2*)(gvst + ((size_t)row * 16 + (u.pn - 20) * 4 + wc) * 2) = (f32x2){s, q}; } }
        return false;
    }
};
struct Ptr2 { const char* proj; const char* BA; const char* BB;
    __device__ const char* aptr(const Unit& u) const { return proj + ((size_t)u.pm * 256 * PJ + (u.pn < 4 ? PC_R : PC_UZ)) * 2; }
    __device__ const char* bptr(const Unit& u) const { return (u.pn < 4 ? BA : BB) + (size_t)(u.pn & 3) * 256 * D * 2; } };
struct Epi2 {
    static constexpr bool PERM = true, AFTER_DRAIN = false;
    bf16_t* proj; const float* b_gate; bool nostore;
    __device__ __forceinline__ bool operator()(f32x4 (&acc)[2][2][4][2], const Unit& u, int wr, int wc, int fr, int fq) const {
        asm volatile("" : "+v"(fr), "+v"(fq));
        const int row0 = u.pm * 256 + wr * 64 + fr, col = (u.pn & 3) * 256 + wc * 32 + 8 * fq; const bool first = u.pn < 4;
        bf16_t* base = proj + (size_t)row0 * PJ + PC_GA + col;
        if (first) {
            f32x4 bgA[2][2], bgB[2][2];
#pragma unroll
            for (int bj = 0; bj < 2; ++bj) { const float* ba = b_gate + col + bj * 128; bgA[bj][0] = *(const f32x4*)ba; bgA[bj][1] = *(const f32x4*)(ba + 4); bgB[bj][0] = *(const f32x4*)(ba + 1024); bgB[bj][1] = *(const f32x4*)(ba + 1028); }
#pragma unroll
            for (int bj = 0; bj < 2; ++bj) { const f32x4 bA0 = bgA[bj][0], bA1 = bgA[bj][1], bB0 = bgB[bj][0], bB1 = bgB[bj][1];
#pragma unroll
                for (int ai = 0; ai < 2; ++ai) { u32x4 ga[4], gb[4];
#pragma unroll
                    for (int m = 0; m < 4; ++m) { const bf16_t* rp = base + (size_t)(ai * 128 + m * 16) * PJ + bj * 128; ga[m] = *(const u32x4*)rp; gb[m] = *(const u32x4*)(rp + 1024); }
                    __builtin_amdgcn_sched_barrier(0);
#pragma unroll
                    for (int m = 0; m < 4; ++m) { float ea[8], eb[8];
                        ea[0] = __expf(-(bflo(ga[m].x) + bA0[0])); ea[1] = __expf(-(bfhi(ga[m].x) + bA0[1])); ea[2] = __expf(-(bflo(ga[m].y) + bA0[2])); ea[3] = __expf(-(bfhi(ga[m].y) + bA0[3]));
                        ea[4] = __expf(-(bflo(ga[m].z) + bA1[0])); ea[5] = __expf(-(bfhi(ga[m].z) + bA1[1])); ea[6] = __expf(-(bflo(ga[m].w) + bA1[2])); ea[7] = __expf(-(bfhi(ga[m].w) + bA1[3]));
                        eb[0] = __expf(-(bflo(gb[m].x) + bB0[0])); eb[1] = __expf(-(bfhi(gb[m].x) + bB0[1])); eb[2] = __expf(-(bflo(gb[m].y) + bB0[2])); eb[3] = __expf(-(bfhi(gb[m].y) + bB0[3]));
                        eb[4] = __expf(-(bflo(gb[m].z) + bB1[0])); eb[5] = __expf(-(bfhi(gb[m].z) + bB1[1])); eb[6] = __expf(-(bflo(gb[m].w) + bB1[2])); eb[7] = __expf(-(bfhi(gb[m].w) + bB1[3]));
#pragma unroll
                        for (int j = 0; j < 4; ++j) { acc[ai][bj][m][0][j] *= (1.0f + eb[j]) * __builtin_amdgcn_rcpf(1.0f + ea[j]); acc[ai][bj][m][1][j] *= (1.0f + eb[4 + j]) * __builtin_amdgcn_rcpf(1.0f + ea[4 + j]); } } } }
            return true;
        }
        f32x4 bgB2[2][2];
#pragma unroll
        for (int bj = 0; bj < 2; ++bj) { const float* ba = b_gate + col + bj * 128; bgB2[bj][0] = *(const f32x4*)(ba + 1024); bgB2[bj][1] = *(const f32x4*)(ba + 1028); }
#pragma unroll
        for (int bj = 0; bj < 2; ++bj) { const f32x4 bB0 = bgB2[bj][0], bB1 = bgB2[bj][1];
#pragma unroll
            for (int ai = 0; ai < 2; ++ai) { u32x4 gb[4];
#pragma unroll
                for (int m = 0; m < 4; ++m) gb[m] = *(const u32x4*)(base + (size_t)(ai * 128 + m * 16) * PJ + bj * 128 + 1024);
                __builtin_amdgcn_sched_barrier(0);
#pragma unroll
                for (int m = 0; m < 4; ++m) { float sb[8];
                    sb[0] = sigmoidf_(bflo(gb[m].x) + bB0[0]); sb[1] = sigmoidf_(bfhi(gb[m].x) + bB0[1]); sb[2] = sigmoidf_(bflo(gb[m].y) + bB0[2]); sb[3] = sigmoidf_(bfhi(gb[m].y) + bB0[3]);
                    sb[4] = sigmoidf_(bflo(gb[m].z) + bB1[0]); sb[5] = sigmoidf_(bfhi(gb[m].z) + bB1[1]); sb[6] = sigmoidf_(bflo(gb[m].w) + bB1[2]); sb[7] = sigmoidf_(bfhi(gb[m].w) + bB1[3]);
                    const f32x4 v0 = acc[ai][bj][m][0], v1 = acc[ai][bj][m][1];
                    u32x4 w; w.x = cvt_pk_bf16(v0[0] * sb[0], v0[1] * sb[1]); w.y = cvt_pk_bf16(v0[2] * sb[2], v0[3] * sb[3]); w.z = cvt_pk_bf16(v1[0] * sb[4], v1[1] * sb[5]); w.w = cvt_pk_bf16(v1[2] * sb[6], v1[3] * sb[7]);
                    if (!nostore) *(u32x4*)(base + (size_t)(ai * 128 + m * 16) * PJ + bj * 128) = w; } } }
        return false;
    }
};
struct Ptr3 { const char* proj; const char* BO;
    __device__ const char* aptr(const Unit& u) const { return proj + ((size_t)u.pm * 256 * PJ + PC_GA) * 2; }
    __device__ const char* bptr(const Unit& u) const { return BO + (size_t)u.pn * 256 * D * 2; } };
struct Epi3 {
    static constexpr bool PERM = false, AFTER_DRAIN = true;
    const float* xp; const float* ada; const float* fw; float* out; float* xbuf; unsigned* cnt;
    __device__ __forceinline__ bool operator()(f32x4 (&acc)[2][2][4][2], const Unit& u, int wr, int wc, int fr, int fq) const { return false; }
    __device__ __forceinline__ void fused(f32x4 (&acc)[2][2][4][2], const Unit& u, int wr, int wc, int fr, int fq, LAS unsigned char* lds, int wid, int lane) const {
        asm volatile("" : "+v"(fr), "+v"(fq));
        LAS float* P = (LAS float*)lds; LAS float* S = (LAS float*)(lds + 4096);
        const int row0 = u.pm * 256 + wr * 64 + fr, col0 = u.pn * 256 + wc * 32 + 4 * fq;
        f32x4 gt[4];
#pragma unroll
        for (int q = 0; q < 4; ++q) gt[q] = *(const f32x4*)(ada + 2048 + col0 + (q >> 1) * 128 + (q & 1) * 16);
#pragma unroll
        for (int ai = 0; ai < 2; ++ai) { f32x4 xv[4][4];
#pragma unroll
            for (int m = 0; m < 4; ++m)
#pragma unroll
                for (int q = 0; q < 4; ++q) xv[m][q] = __builtin_nontemporal_load((const f32x4*)(xp + (size_t)(row0 + ai * 128 + m * 16) * D + col0 + (q >> 1) * 128 + (q & 1) * 16));
            __builtin_amdgcn_sched_barrier(0);
#pragma unroll
            for (int m = 0; m < 4; ++m) { const int lrow = ai * 128 + wr * 64 + m * 16 + fr; float ss = 0.f;
#pragma unroll
                for (int q = 0; q < 4; ++q) { const f32x4 r = xv[m][q] + gt[q] * acc[ai][q >> 1][m][q & 1]; acc[ai][q >> 1][m][q & 1] = r; ss += (r[0] * r[0] + r[1] * r[1]) + (r[2] * r[2] + r[3] * r[3]); }
                ss += __shfl_xor(ss, 16); ss += __shfl_xor(ss, 32);
                if (fq == 0) P[lrow * 4 + wc] = ss; } }
        __syncthreads();
        const int prow = wid * 32 + (lane & 31);
        if (lane < 32) { const f32x4 pp = *(const LAS f32x4*)(P + prow * 4);
            __hip_atomic_store(xbuf + ((size_t)u.pm * 256 + prow) * 4 + u.pn, (pp[0] + pp[1]) + (pp[2] + pp[3]), __ATOMIC_RELAXED, __HIP_MEMORY_SCOPE_AGENT); }
        asm volatile("s_waitcnt vmcnt(0)" ::: "memory");
        if (lane == 0) __hip_atomic_fetch_add(cnt + 64 * u.pm, 1u, __ATOMIC_RELAXED, __HIP_MEMORY_SCOPE_AGENT);
        if (wid == 0) { unsigned sp = 0u;
            while ((unsigned)__builtin_amdgcn_readfirstlane(__hip_atomic_load(cnt + 64 * u.pm, __ATOMIC_RELAXED, __HIP_MEMORY_SCOPE_AGENT)) < 32u) { __builtin_amdgcn_s_sleep(2); if (++sp > (1u << 22)) break; }
            __builtin_amdgcn_fence(__ATOMIC_ACQUIRE, "agent"); }
        asm volatile("s_waitcnt vmcnt(0) lgkmcnt(0)" ::: "memory"); __syncthreads();
        if (lane < 32) { const float* sl = xbuf + ((size_t)u.pm * 256 + prow) * 4; float t = 0.f;
#pragma unroll
            for (int q = 0; q < 4; ++q) t += __hip_atomic_load(sl + q, __ATOMIC_RELAXED, __HIP_MEMORY_SCOPE_AGENT);
            S[prow] = rsqrtf(t * (1.0f / D) + EPS); }
        __syncthreads();
        f32x4 fv[4];
#pragma unroll
        for (int q = 0; q < 4; ++q) fv[q] = *(const f32x4*)(fw + col0 + (q >> 1) * 128 + (q & 1) * 16);
#pragma unroll
        for (int ai = 0; ai < 2; ++ai)
#pragma unroll
            for (int m = 0; m < 4; ++m) { const int row = row0 + ai * 128 + m * 16, lrow = ai * 128 + wr * 64 + m * 16 + fr; const float rs = S[lrow]; float* orow = out + (size_t)row * D + col0;
#pragma unroll
                for (int q = 0; q < 4; ++q) __builtin_nontemporal_store(acc[ai][q >> 1][m][q & 1] * rs * fv[q], (f32x4*)(orow + (q >> 1) * 128 + (q & 1) * 16)); }
    }
};
template <int AM, int BN>
__device__ __forceinline__ void wave_gemm(const bf16_t* const (&Ar)[AM], int lda, const bf16_t* const (&Br)[BN], int ldb, int K, int lane, f32x4 (&acc)[AM][BN]) {
    const bf16_t* a[AM]; const bf16_t* b[BN];
#pragma unroll
    for (int i = 0; i < AM; ++i) a[i] = Ar[i] + (size_t)(lane & 15) * lda + 8 * (lane >> 4);
#pragma unroll
    for (int i = 0; i < BN; ++i) b[i] = Br[i] + (size_t)(lane & 15) * ldb + 8 * (lane >> 4);
    constexpr int KB = (AM + BN) >= 4 ? 8 : 16;
    for (int k0 = 0; k0 < K; k0 += 32 * KB) { bf16x8 fa[KB][AM], fb[KB][BN];
#pragma unroll
        for (int s = 0; s < KB; ++s) {
#pragma unroll
            for (int i = 0; i < AM; ++i) fa[s][i] = *(const bf16x8*)(a[i] + k0 + 32 * s);
#pragma unroll
            for (int i = 0; i < BN; ++i) fb[s][i] = *(const bf16x8*)(b[i] + k0 + 32 * s); }
        __builtin_amdgcn_sched_barrier(0);
#pragma unroll
        for (int s = 0; s < KB; ++s)
#pragma unroll
            for (int i = 0; i < AM; ++i)
#pragma unroll
                for (int j = 0; j < BN; ++j) acc[i][j] = MFMA16(fb[s][j], fa[s][i], acc[i][j]); }
}
__device__ __forceinline__ void sample_gemm1(const Params& p, LAS unsigned char* lds, int bid) {
    int tid_ = threadIdx.x; asm volatile("" : "+v"(tid_)); const int tid = tid_, lane = tid & 63, w = tid >> 6, g4 = lane >> 4, l15 = lane & 15;
    const bf16_t* H = (const bf16_t*)((const unsigned char*)p.out + RB_H); const bf16_t* bt1 = (const bf16_t*)((const unsigned char*)p.out + RB_BT1); bf16_t* proj = (bf16_t*)(p.ws + WS_PROJ);
    constexpr int RS = 528, LB = 256 * RS;
    int b0, b1, ocol; const bool uz = bid >= 96 && bid < 160;
    if (bid < 96) { b0 = 32 * bid; b1 = b0 + 16; ocol = 32 * bid; }
    else if (uz) { const int j = bid - 96; b0 = 3072 + (j >> 3) * 256 + (j & 7) * 16; b1 = b0 + 128; ocol = PC_UZ + 16 * j; }
    else { b0 = 5120 + 32 * (bid - 160); b1 = b0 + 16; ocol = PC_GV + 32 * (bid - 160); }
    u32x4 ra[16], rb[2];
    const int pr = tid >> 5, pc = tid & 31;
    const bf16_t* ag = H + (size_t)(SEQ + pr) * D + pc * 8;
    const bf16_t* bg0 = bt1 + (size_t)(b0 + pr) * D + pc * 8; const bf16_t* bg1 = bt1 + (size_t)(b1 + pr) * D + pc * 8;
#pragma unroll
    for (int i = 0; i < 16; ++i) ra[i] = *(const u32x4*)(ag + (size_t)i * 16 * D);
    rb[0] = *(const u32x4*)bg0; rb[1] = *(const u32x4*)bg1;
    f32x4 acc[2][2];
#pragma unroll
    for (int i = 0; i < 2; ++i)
#pragma unroll
        for (int j = 0; j < 2; ++j) acc[i][j] = (f32x4){0.f, 0.f, 0.f, 0.f};
    for (int kc = 0; kc < 4; ++kc) {
#pragma unroll
        for (int i = 0; i < 16; ++i) *(LAS u32x4*)(lds + (pr + 16 * i) * RS + pc * 16) = ra[i];
        *(LAS u32x4*)(lds + LB + pr * RS + pc * 16) = rb[0]; *(LAS u32x4*)(lds + LB + (16 + pr) * RS + pc * 16) = rb[1];
        __syncthreads();
        if (kc + 1 < 4) { int ko = (kc + 1) * 256; asm volatile("" : "+v"(ko));
#pragma unroll
            for (int i = 0; i < 16; ++i) ra[i] = *(const u32x4*)(ag + (size_t)i * 16 * D + ko);
            rb[0] = *(const u32x4*)(bg0 + ko); rb[1] = *(const u32x4*)(bg1 + ko); }
#pragma unroll
        for (int ks = 0; ks < 8; ++ks) { bf16x8 fa[2], fb[2];
#pragma unroll
            for (int i = 0; i < 2; ++i) { fa[i] = row_frag(lds + (32 * w + 16 * i) * RS + ks * 64, RS, lane); fb[i] = row_frag(lds + LB + 16 * i * RS + ks * 64, RS, lane); }
#pragma unroll
            for (int i = 0; i < 2; ++i)
#pragma unroll
                for (int j = 0; j < 2; ++j) acc[i][j] = MFMA16(fb[j], fa[i], acc[i][j]); }
        __syncthreads();
    }
    const int r0 = SEQ + 32 * w;
#pragma unroll
    for (int i = 0; i < 2; ++i) { bf16_t* rp = proj + (size_t)(r0 + 16 * i + l15) * PJ + ocol + 4 * g4;
        if (uz) { const f32x4 u = acc[i][0], z = acc[i][1]; u32x2 pk; pk.x = cvt_pk_bf16(u[0] * siluf_(z[0]), u[1] * siluf_(z[1])); pk.y = cvt_pk_bf16(u[2] * siluf_(z[2]), u[3] * siluf_(z[3])); *(u32x2*)rp = pk; }
        else {
#pragma unroll
            for (int j = 0; j < 2; ++j) { u32x2 pk; pk.x = cvt_pk_bf16(acc[i][j][0], acc[i][j][1]); pk.y = cvt_pk_bf16(acc[i][j][2], acc[i][j][3]); *(u32x2*)(rp + 16 * j) = pk; } } }
}
__device__ __forceinline__ void sample_gemm2(const Params& p, int bid, bool nostore) {
    int tid_ = threadIdx.x; asm volatile("" : "+v"(tid_)); const int lane = tid_ & 63, w = tid_ >> 6, g4 = lane >> 4, l15 = lane & 15;
    if (w >= 4) return;
    bf16_t* proj = (bf16_t*)(p.ws + WS_PROJ); const bf16_t* bta = (const bf16_t*)(p.ws + WS_BTA); const bf16_t* btb = (const bf16_t*)(p.ws + WS_BTB);
    const int tile = bid * 4 + w, rt = tile >> 6, ct = tile & 63, r0 = SEQ + 16 * rt, c0 = 16 * ct;
    f32x4 aa[1][1], ab[1][1]; aa[0][0] = (f32x4){0.f, 0.f, 0.f, 0.f}; ab[0][0] = aa[0][0];
    { const bf16_t* const Ar[1] = {proj + (size_t)r0 * PJ + PC_R}; const bf16_t* const Br[1] = {bta + (size_t)c0 * D}; wave_gemm<1, 1>(Ar, PJ, Br, D, D, lane, aa); }
    { const bf16_t* const Ar[1] = {proj + (size_t)r0 * PJ + PC_UZ}; const bf16_t* const Br[1] = {btb + (size_t)c0 * D}; wave_gemm<1, 1>(Ar, PJ, Br, D, D, lane, ab); }
    bf16_t* rp = proj + (size_t)(r0 + l15) * PJ + PC_GA + c0 + 4 * g4; const u32x2 ga = *(const u32x2*)rp, gb = *(const u32x2*)(rp + 1024);
    const f32x4 bA = *(const f32x4*)(p.b_gate + c0 + 4 * g4), bB = *(const f32x4*)(p.b_gate + 1024 + c0 + 4 * g4);
    float o[4];
    o[0] = sigmoidf_(bflo(ga.x) + bA[0]) * aa[0][0][0] + sigmoidf_(bflo(gb.x) + bB[0]) * ab[0][0][0]; o[1] = sigmoidf_(bfhi(ga.x) + bA[1]) * aa[0][0][1] + sigmoidf_(bfhi(gb.x) + bB[1]) * ab[0][0][1];
    o[2] = sigmoidf_(bflo(ga.y) + bA[2]) * aa[0][0][2] + sigmoidf_(bflo(gb.y) + bB[2]) * ab[0][0][2]; o[3] = sigmoidf_(bfhi(ga.y) + bA[3]) * aa[0][0][3] + sigmoidf_(bfhi(gb.y) + bB[3]) * ab[0][0][3];
    u32x2 pk; pk.x = cvt_pk_bf16(o[0], o[1]); pk.y = cvt_pk_bf16(o[2], o[3]); if (!nostore) *(u32x2*)rp = pk;
}
__device__ __forceinline__ void sample_gemm3(const Params& p, int bid) {
    int tid_ = threadIdx.x; asm volatile("" : "+v"(tid_)); const int lane = tid_ & 63, w = tid_ >> 6, g4 = lane >> 4, l15 = lane & 15;
    if (w >= 4) return;
    const bf16_t* proj = (const bf16_t*)(p.ws + WS_PROJ); const bf16_t* bto = (const bf16_t*)(p.ws + WS_BTO); const float* ada = (const float*)(p.ws + WS_ADA);
    const int tile = bid * 4 + w, rt = tile >> 6, ct = tile & 63, c0 = 16 * ct + 4 * g4, rs = 16 * rt + l15;
    f32x4 acc[1][1]; acc[0][0] = (f32x4){0.f, 0.f, 0.f, 0.f};
    { const bf16_t* const Ar[1] = {proj + (size_t)(SEQ + 16 * rt) * PJ + PC_GA}; const bf16_t* const Br[1] = {bto + (size_t)16 * ct * D}; wave_gemm<1, 1>(Ar, PJ, Br, D, D, lane, acc); }
    const f32x4 xv = *(const f32x4*)(p.x_sample + (size_t)rs * D + c0), gt = *(const f32x4*)(ada + (1 + rt) * 3072 + 2048 + c0);
    *(f32x4*)(p.out + OUT_YS + (size_t)rs * D + c0) = xv + gt * acc[0][0];
}

__device__ __forceinline__ void transpose_tile(LAS unsigned char* lds, const float* src, int ldsrc, int scol0, int nvalid, float scale, bf16_t* dst, int ldd, int n0, int k0) {
    int tid_ = threadIdx.x; asm volatile("" : "+v"(tid_)); const int tid = tid_;
    f32x4 v[8];
#pragma unroll
    for (int i = 0; i < 8; ++i) { const int e = tid + 512 * i, k = e >> 4, n4 = (e & 15) * 4; f32x4 t = (f32x4){0.f, 0.f, 0.f, 0.f};
        if (n4 < nvalid) t = __builtin_nontemporal_load((const f32x4*)(src + (size_t)(k0 + k) * ldsrc + scol0 + n4));
        v[i] = t; }
#pragma unroll
    for (int i = 0; i < 8; ++i) { const int e = tid + 512 * i, k = e >> 4, n4 = (e & 15) * 4, m = (e & 15) & 7;
        const f32x4 t = v[i];
        *(LAS bf16_t*)(lds + (n4 + 0) * 528 + (((k >> 3) ^ m) << 4) + (k & 7) * 2) = f2bf(t[0] * scale);
        *(LAS bf16_t*)(lds + (n4 + 1) * 528 + (((k >> 3) ^ m) << 4) + (k & 7) * 2) = f2bf(t[1] * scale);
        *(LAS bf16_t*)(lds + (n4 + 2) * 528 + (((k >> 3) ^ m) << 4) + (k & 7) * 2) = f2bf(t[2] * scale);
        *(LAS bf16_t*)(lds + (n4 + 3) * 528 + (((k >> 3) ^ m) << 4) + (k & 7) * 2) = f2bf(t[3] * scale); }
    __syncthreads();
#pragma unroll
    for (int i = 0; i < 4; ++i) { const int e = tid + 512 * i, n = e >> 5, kc = e & 31; const u32x4 w = *(const LAS u32x4*)(lds + n * 528 + ((kc ^ ((n >> 2) & 7)) << 4));
        *(u32x4*)(dst + (size_t)(n0 + n) * ldd + k0 + kc * 8) = w; }
    __syncthreads();
}
__device__ __forceinline__ void ada_item(const Params& p, LAS unsigned char* lds, int slab) {
    int tid_ = threadIdx.x; asm volatile("" : "+v"(tid_)); const int tid = tid_; float* ada = (float*)(p.ws + WS_ADA);
    LAS float* sc = (LAS float*)lds;
    LAS float* red = (LAS float*)(lds + 17 * 1024 * 4);
    for (int i = tid; i < 17 * 1024; i += 512) { const int b = i >> 10, k = i & 1023; const float c = b == 0 ? p.c_prompt[k] : p.c_sample[(b - 1) * 1024 + k]; sc[i] = siluf_(c); }
    __syncthreads();
    const int nl = tid & 31, kg = tid >> 5, n = slab * 32 + nl;
    float a[17];
#pragma unroll
    for (int b = 0; b < 17; ++b) a[b] = 0.f;
    for (int k16 = 0; k16 < 4; ++k16) { float w[16]; const float* wp = p.w_ada + (size_t)(kg * 64 + k16 * 16) * 3072 + n;
#pragma unroll
        for (int i = 0; i < 16; ++i) w[i] = wp[(size_t)i * 3072];
        __builtin_amdgcn_sched_barrier(0);
#pragma unroll
        for (int k4 = 0; k4 < 4; ++k4) { const int k = kg * 64 + k16 * 16 + k4 * 4;
#pragma unroll
            for (int b = 0; b < 17; ++b) { const f32x4 s = *(const LAS f32x4*)(sc + b * 1024 + k); a[b] += s[0] * w[k4 * 4] + s[1] * w[k4 * 4 + 1] + s[2] * w[k4 * 4 + 2] + s[3] * w[k4 * 4 + 3]; } } }
#pragma unroll
    for (int b = 0; b < 17; ++b) red[(kg * 17 + b) * 32 + nl] = a[b];
    __syncthreads();
    for (int i = tid; i < 17 * 32; i += 512) { const int b = i >> 5, c = i & 31; float s = p.b_ada[slab * 32 + c];
#pragma unroll
        for (int g = 0; g < 16; ++g) s += red[(g * 17 + b) * 32 + c];
        ada[b * 3072 + slab * 32 + c] = s; }
    __syncthreads();
}
__device__ __forceinline__ void phase0(const Params& p, LAS unsigned char* lds) {
    bf16_t* bt1 = (bf16_t*)((unsigned char*)p.out + RB_BT1); bf16_t* bta = (bf16_t*)(p.ws + WS_BTA); bf16_t* btb = (bf16_t*)(p.ws + WS_BTB); bf16_t* bto = (bf16_t*)(p.ws + WS_BTO);
    constexpr int N_ADA = 96, N_T1 = (N1 / 64) * 4, N_TS = 64;
    int bid_ = blockIdx.x; asm volatile("" : "+s"(bid_)); const int bid = bid_;
    for (int it = bid; it < N_ADA + N_T1 + 3 * N_TS; it += gridDim.x) {
        if (it < N_ADA) { ada_item(p, lds, it); continue; }
        int j = it - N_ADA;
        if (j < N_T1) { const int nt = j >> 2, kt = j & 3, n0 = nt * 64; int sc0, nv = 64;
            if (n0 < 3072) sc0 = n0;
            else if (n0 < 5120) { const int t = (n0 - 3072) >> 8, w = (n0 - 3072) & 255; sc0 = w < 128 ? 3088 + t * 128 + w : 5136 + t * 128 + (w - 128); }
            else if (n0 < 6144) sc0 = 4112 + (n0 - 5120);
            else if (n0 < 7168) sc0 = 6160 + (n0 - 6144);
            else if (n0 < 8192) sc0 = 7184 + (n0 - 7168);
            else { sc0 = 3072; nv = 16; }
            transpose_tile(lds, p.w_in, WIN_LD, sc0, nv, n0 < 512 ? 0.08838834764831845f : 1.0f, bt1, D, n0, kt * 256); continue; }
        j -= N_T1;
        const int which = j >> 6, nt = (j & 63) >> 2, kt = j & 3;
        if (which == 0) transpose_tile(lds, p.w_proj_a, D, nt * 64, 64, 1.0f, bta, D, nt * 64, kt * 256);
        else if (which == 1) transpose_tile(lds, p.w_proj_b, D, nt * 64, 64, 1.0f, btb, D, nt * 64, kt * 256);
        else transpose_tile(lds, p.w_out, D, nt * 64, 64, 1.0f, bto, D, nt * 64, kt * 256);
    }
}
__device__ __forceinline__ void phase1(const Params& p) {
    int tid_ = threadIdx.x; asm volatile("" : "+v"(tid_)); const int tid = tid_; int bid_ = blockIdx.x; asm volatile("" : "+s"(bid_)); const int bid = bid_;
    const int lane = tid & 63, wv = tid >> 6, l15 = lane & 15, g4 = lane >> 4; const float* ada = (const float*)(p.ws + WS_ADA); bf16_t* H = (bf16_t*)((unsigned char*)p.out + RB_H);
#pragma unroll 2
    for (int row = bid * 8 + wv; row < MTOT; row += gridDim.x * 8) {
        const float* xr = row < SEQ ? p.x_prompt + (size_t)row * D : p.x_sample + (size_t)(row - SEQ) * D; const int b = row < SEQ ? 0 : 1 + ((row - SEQ) >> 4);
        f32x4 v[4]; float ss = 0.f;
#pragma unroll
        for (int i = 0; i < 4; ++i) { v[i] = __builtin_nontemporal_load((const f32x4*)(xr + i * 256 + lane * 4)); ss += (v[i][0] * v[i][0] + v[i][1] * v[i][1]) + (v[i][2] * v[i][2] + v[i][3] * v[i][3]); }
        ss = wave_sum(ss); const float rstd = rsqrtf(ss * (1.0f / D) + EPS);
#pragma unroll
        for (int i = 0; i < 4; ++i) { const int c = i * 256 + lane * 4; const f32x4 nw = *(const f32x4*)(p.norm_w + c), sh = *(const f32x4*)(ada + b * 3072 + c), scl = *(const f32x4*)(ada + b * 3072 + 1024 + c);
            const f32x4 h = v[i] * rstd * nw * (scl + 1.0f) + sh; u32x2 w; w.x = cvt_pk_bf16(h[0], h[1]); w.y = cvt_pk_bf16(h[2], h[3]); *(u32x2*)(H + (size_t)row * D + c) = w; }
    }
    asm volatile("s_waitcnt vmcnt(0)" ::: "memory");
    __syncthreads();
    float* alr = (float*)(p.ws + WS_ALR);
    const bf16_t* w16 = (const bf16_t*)((const unsigned char*)p.out + RB_BT1) + (size_t)(8192 + l15) * D + 8 * g4;
    for (int gi = wv; bid * 8 + 2048 * gi < MTOT; gi += 8) { const int r0 = bid * 8 + 2048 * gi;
        f32x4 acc = (f32x4){0.f, 0.f, 0.f, 0.f};
        const bf16_t* ap = H + (size_t)(r0 + (l15 & 7)) * D + 8 * g4;
#pragma unroll
        for (int kb = 0; kb < 2; ++kb) { bf16x8 fa[16], fb[16];
#pragma unroll
            for (int s = 0; s < 16; ++s) { fa[s] = *(const bf16x8*)(ap + (kb * 16 + s) * 32); fb[s] = *(const bf16x8*)(w16 + (kb * 16 + s) * 32); }
#pragma unroll
            for (int s = 0; s < 16; ++s) acc = MFMA16(fb[s], fa[s], acc); }
        if (l15 < 8) *(f32x4*)(alr + (size_t)(r0 + l15) * 16 + 4 * g4) = acc; }
}
__device__ __forceinline__ void gla_prep(const Params& p, LAS unsigned char* lds, int tokbase, int nchunk, int nvalid, int h, int chunk0, bool tolds, int ldsK, int ldsDV) {
    int tid_ = threadIdx.x; asm volatile("" : "+v"(tid_)); const int tid = tid_, kap = tid & 127; const int c = __builtin_amdgcn_readfirstlane(tid >> 7);
    bf16_t* proj = (bf16_t*)(p.ws + WS_PROJ); const float* alr = (const float*)(p.ws + WS_ALR); float* dch = (float*)(p.ws + WS_DCH);
    if (c < nchunk) {
        float w2[16];
#pragma unroll
        for (int j = 0; j < 16; ++j) w2[j] = p.w_a2[j * 512 + h * 128 + kap];
        const float ba = p.b_a[h * 128 + kap];
        const int tok0 = tokbase + 64 * c; float run = 0.f;
        bf16_t* kp = proj + (size_t)tok0 * PJ + PC_K + h * 128 + kap; bf16_t* qp = proj + (size_t)tok0 * PJ + PC_Q + h * 128 + kap;
        const float* ar0 = alr + (size_t)tok0 * 16;
#pragma unroll 8
        for (int t = 0; t < nvalid; ++t) { const float* ar = ar0 + t * 16; float x = ba;
#pragma unroll
            for (int j = 0; j < 16; ++j) x += ar[j] * w2[j];
            const float la = -(fmaxf(-x, 0.f) + __logf(1.0f + __expf(-fabsf(x)))) * 0.0625f; run += la;
            const float kk = bf2f(kp[(size_t)t * PJ]), qq = bf2f(qp[(size_t)t * PJ]);
            const bf16_t kt = f2bf(kk * __expf(-run)); kp[(size_t)t * PJ] = kt; qp[(size_t)t * PJ] = f2bf(qq * __expf(run));
            if (tolds) *(LAS bf16_t*)(lds + ldsK + (64 * c + t) * 272 + kap * 2) = kt; }
        const float d = __expf(run); dch[((chunk0 + c) * 4 + h) * 128 + kap] = d; if (tolds) *(LAS float*)(lds + ldsDV + (c * 128 + kap) * 4) = d;
    }
}
constexpr int LA_K = 0, LA_V0 = 69632, LA_V1 = 103424, LA_DV = 137216;
constexpr int RS_QK = 272, RS_V = 528, RS_P = 144, RS_S = 272;
__device__ __forceinline__ void gla_segA(const Params& p, LAS unsigned char* lds, int seg, int h) {
    int tid_ = threadIdx.x; asm volatile("" : "+v"(tid_));
    const int tid = tid_, lane = tid & 63, w = tid >> 6, g4 = lane >> 4, l15 = lane & 15;
    const bf16_t* proj = (const bf16_t*)(p.ws + WS_PROJ); const int tokbase = seg * (SEGCH * 64);
    u32x4 vr[4];
#pragma unroll
    for (int i = 0; i < 4; ++i) { const int e = tid + 512 * i, r = e >> 5, c = e & 31; vr[i] = *(const u32x4*)(proj + (size_t)(tokbase + r) * PJ + PC_V + h * 256 + c * 8); }
    gla_prep(p, lds, tokbase, SEGCH, 64, h, seg * SEGCH, true, LA_K, LA_DV);
#pragma unroll
    for (int i = 0; i < 4; ++i) { const int e = tid + 512 * i, r = e >> 5, c = e & 31; *(LAS u32x4*)(lds + LA_V0 + r * RS_V + c * 16) = vr[i]; }
    __syncthreads();
    f32x4 acc[8][2];
#pragma unroll
    for (int kt = 0; kt < 8; ++kt)
#pragma unroll
        for (int j2 = 0; j2 < 2; ++j2) acc[kt][j2] = (f32x4){0.f, 0.f, 0.f, 0.f};
    for (int ch = 0; ch < SEGCH; ++ch) {
        int tok1 = tokbase + (ch + 1) * 64; asm volatile("" : "+v"(tok1));
        const int vb = (ch & 1) ? LA_V1 : LA_V0, vn = (ch & 1) ? LA_V0 : LA_V1;
        if (ch + 1 < SEGCH) {
#pragma unroll
            for (int i = 0; i < 4; ++i) { const int e = tid + 512 * i, r = e >> 5, c = e & 31; vr[i] = *(const u32x4*)(proj + (size_t)(tok1 + r) * PJ + PC_V + h * 256 + c * 8); } }
#pragma unroll
        for (int ks = 0; ks < 2; ++ks) { bf16x8 Bv[2];
#pragma unroll
            for (int j2 = 0; j2 < 2; ++j2) Bv[j2] = tr_frag(lds + vb + 32 * ks * RS_V + (32 * w + 16 * j2) * 2, RS_V, lane);
#pragma unroll
            for (int kt = 0; kt < 8; ++kt) { const bf16x8 Ak = tr_frag(lds + LA_K + (64 * ch + 32 * ks) * RS_QK + 16 * kt * 2, RS_QK, lane);
#pragma unroll
                for (int j2 = 0; j2 < 2; ++j2) acc[kt][j2] = MFMA16(Ak, Bv[j2], acc[kt][j2]); } }
#pragma unroll
        for (int kt = 0; kt < 8; ++kt) { const f32x4 d = *(const LAS f32x4*)(lds + LA_DV + (ch * 128 + 16 * kt + 4 * g4) * 4);
#pragma unroll
            for (int j2 = 0; j2 < 2; ++j2) acc[kt][j2] = acc[kt][j2] * d; }
        if (ch + 1 < SEGCH) {
#pragma unroll
            for (int i = 0; i < 4; ++i) { const int e = tid + 512 * i, r = e >> 5, c = e & 31; *(LAS u32x4*)(lds + vn + r * RS_V + c * 16) = vr[i]; } }
        __syncthreads();
    }
    bf16_t* us = (bf16_t*)((unsigned char*)p.out + RB_USEG) + ((size_t)(seg * 4 + h) * 256) * 128;
#pragma unroll
    for (int kt = 0; kt < 8; ++kt)
#pragma unroll
        for (int j2 = 0; j2 < 2; ++j2) { u32x2 pk; pk.x = cvt_pk_bf16(acc[kt][j2][0], acc[kt][j2][1]); pk.y = cvt_pk_bf16(acc[kt][j2][2], acc[kt][j2][3]);
            *(u32x2*)(us + (size_t)(32 * w + 16 * j2 + l15) * 128 + 16 * kt + 4 * g4) = pk; }
    if (tid < 128) { float d = 1.f;
#pragma unroll
        for (int c = 0; c < 4; ++c) d *= *(const LAS float*)(lds + LA_DV + (c * 128 + tid) * 4);
        ((float*)(p.ws + WS_DSEG))[(seg * 4 + h) * 128 + tid] = d; }
    __syncthreads();
}
constexpr int L_DV = 6144, L_RED = 6656, L_Q = 8704, L_K = 26112, L_V = 43520, L_P = 77312, L_S = 86528;
__device__ __forceinline__ void gla_out(const Params& p, LAS unsigned char* lds, int sample, int idx  , int h, bool nostore) {
    int tid_ = threadIdx.x; asm volatile("" : "+v"(tid_));
    const int tid = tid_, lane = tid & 63, w = tid >> 6, g4 = lane >> 4, l15 = lane & 15;
    bf16_t* proj = (bf16_t*)(p.ws + WS_PROJ); const float* dch = (const float*)(p.ws + WS_DCH);
    const int nchunk = sample ? 1 : SEGCH, nvalid = sample ? SAMP_T : 64, tokbase = sample ? SEQ + idx * SAMP_T : idx * (SEGCH * 64), chunk0 = sample ? 256 + idx : idx * SEGCH;
    f32x4 acc[8][2];
    if (!sample) { const bf16_t* ss = (const bf16_t*)((unsigned char*)p.out + RB_SSTART) + ((size_t)(idx * 4 + h) * 256) * 128;
#pragma unroll
        for (int kt = 0; kt < 8; ++kt)
#pragma unroll
            for (int j2 = 0; j2 < 2; ++j2) { const u32x2 pk = *(const u32x2*)(ss + (size_t)(32 * w + 16 * j2 + l15) * 128 + 16 * kt + 4 * g4);
                acc[kt][j2] = (f32x4){bflo(pk.x), bfhi(pk.x), bflo(pk.y), bfhi(pk.y)}; }
    } else { const float* s0 = p.state_gla + (size_t)(idx * 4 + h) * 128 * 256;
#pragma unroll
        for (int kt = 0; kt < 8; ++kt)
#pragma unroll
            for (int j2 = 0; j2 < 2; ++j2)
#pragma unroll
                for (int r = 0; r < 4; ++r) acc[kt][j2][r] = s0[(size_t)(16 * kt + 4 * g4 + r) * 256 + 32 * w + 16 * j2 + l15];
    }
    if (tid < 128) {
#pragma unroll
        for (int c = 0; c < SEGCH; ++c) if (c < nchunk) *(LAS float*)(lds + (c * 128 + tid) * 4) = dch[((chunk0 + c) * 4 + h) * 128 + tid]; }
    u32x4 rq[2], rk[2], rv[4];
#define GLA_LOAD_TILES(T0) do { \
        _Pragma("unroll") for (int i = 0; i < 2; ++i) { const int e = tid + 512 * i, r = e >> 4, c = e & 15; const bool ok = r < nvalid; const bf16_t* bp = proj + (size_t)((T0) + r) * PJ + h * 128 + c * 8; \
            rq[i] = ok ? __builtin_nontemporal_load((const u32x4*)(bp + PC_Q)) : (u32x4){0u, 0u, 0u, 0u}; rk[i] = ok ? __builtin_nontemporal_load((const u32x4*)(bp + PC_K)) : (u32x4){0u, 0u, 0u, 0u}; } \
        _Pragma("unroll") for (int i = 0; i < 4; ++i) { const int e = tid + 512 * i, r = e >> 5, c = e & 31; \
            rv[i] = (r < nvalid) ? __builtin_nontemporal_load((const u32x4*)(proj + (size_t)((T0) + r) * PJ + PC_V + h * 256 + c * 8)) : (u32x4){0u, 0u, 0u, 0u}; } } while (0)
    GLA_LOAD_TILES(tokbase);
    for (int ch = 0; ch < nchunk; ++ch) {
        int tok0 = tokbase + ch * 64; asm volatile("" : "+v"(tok0));
#pragma unroll
        for (int i = 0; i < 2; ++i) { const int e = tid + 512 * i, r = e >> 4, c = e & 15; *(LAS u32x4*)(lds + L_Q + r * RS_QK + c * 16) = rq[i]; *(LAS u32x4*)(lds + L_K + r * RS_QK + c * 16) = rk[i]; }
#pragma unroll
        for (int i = 0; i < 4; ++i) { const int e = tid + 512 * i, r = e >> 5, c = e & 31; *(LAS u32x4*)(lds + L_V + r * RS_V + c * 16) = rv[i]; }
#pragma unroll
        for (int kt = 0; kt < 8; ++kt)
#pragma unroll
            for (int j2 = 0; j2 < 2; ++j2) { u32x2 pk; pk.x = cvt_pk_bf16(acc[kt][j2][0], acc[kt][j2][1]); pk.y = cvt_pk_bf16(acc[kt][j2][2], acc[kt][j2][3]);
                *(LAS u32x2*)(lds + L_S + (32 * w + 16 * j2 + l15) * RS_S + (16 * kt + 4 * g4) * 2) = pk; }
        __syncthreads();
        if (ch + 1 < nchunk) { const int tok1 = tok0 + 64; GLA_LOAD_TILES(tok1); }
#pragma unroll
        for (int e = 0; e < 2; ++e) { const int tile = 2 * w + e, st = tile >> 2, tt = tile & 3; f32x4 ap = (f32x4){0.f, 0.f, 0.f, 0.f};
            if (st <= tt) {
#pragma unroll
                for (int ks = 0; ks < 4; ++ks) { const bf16x8 A = row_frag(lds + L_K + 16 * st * RS_QK + ks * 64, RS_QK, lane), B = row_frag(lds + L_Q + 16 * tt * RS_QK + ks * 64, RS_QK, lane); ap = MFMA16(A, B, ap); } }
            const int t = 16 * tt + l15, s0 = 16 * st + 4 * g4;
            u32x2 pk; pk.x = cvt_pk_bf16(s0 <= t ? ap[0] : 0.f, s0 + 1 <= t ? ap[1] : 0.f); pk.y = cvt_pk_bf16(s0 + 2 <= t ? ap[2] : 0.f, s0 + 3 <= t ? ap[3] : 0.f);
            *(LAS u32x2*)(lds + L_P + t * RS_P + s0 * 2) = pk; }
        __syncthreads();
        u32x2 rrv[4][2];
#pragma unroll
        for (int tt = 0; tt < 4; ++tt)
#pragma unroll
            for (int j2 = 0; j2 < 2; ++j2) rrv[tt][j2] = (16 * tt + l15 < nvalid) ? *(const u32x2*)(proj + (size_t)(tok0 + 16 * tt + l15) * PJ + PC_R + h * 256 + 32 * w + 16 * j2 + 4 * g4) : (u32x2){0u, 0u};
        f32x4 ao[2][4];
#pragma unroll
        for (int j2 = 0; j2 < 2; ++j2)
#pragma unroll
            for (int tt = 0; tt < 4; ++tt) ao[j2][tt] = (f32x4){0.f, 0.f, 0.f, 0.f};
#pragma unroll
        for (int ks = 0; ks < 2; ++ks) { bf16x8 Av[2];
#pragma unroll
            for (int j2 = 0; j2 < 2; ++j2) Av[j2] = tr_frag(lds + L_V + 32 * ks * RS_V + (32 * w + 16 * j2) * 2, RS_V, lane);
#pragma unroll
            for (int tt = 0; tt < 4; ++tt) { const bf16x8 Bp = row_frag(lds + L_P + 16 * tt * RS_P + ks * 64, RS_P, lane);
#pragma unroll
                for (int j2 = 0; j2 < 2; ++j2) ao[j2][tt] = MFMA16(Av[j2], Bp, ao[j2][tt]); } }
#pragma unroll
        for (int ks = 0; ks < 4; ++ks) { bf16x8 As[2];
#pragma unroll
            for (int j2 = 0; j2 < 2; ++j2) As[j2] = row_frag(lds + L_S + (32 * w + 16 * j2) * RS_S + ks * 64, RS_S, lane);
#pragma unroll
            for (int tt = 0; tt < 4; ++tt) { const bf16x8 Bq = row_frag(lds + L_Q + 16 * tt * RS_QK + ks * 64, RS_QK, lane);
#pragma unroll
                for (int j2 = 0; j2 < 2; ++j2) ao[j2][tt] = MFMA16(As[j2], Bq, ao[j2][tt]); } }
#pragma unroll
        for (int tt = 0; tt < 4; ++tt) { float ss = 0.f;
#pragma unroll
            for (int j2 = 0; j2 < 2; ++j2) ss += (ao[j2][tt][0] * ao[j2][tt][0] + ao[j2][tt][1] * ao[j2][tt][1]) + (ao[j2][tt][2] * ao[j2][tt][2] + ao[j2][tt][3] * ao[j2][tt][3]);
            ss += __shfl_xor(ss, 16); ss += __shfl_xor(ss, 32);
            if (g4 == 0) *(LAS float*)(lds + L_RED + (w * 64 + 16 * tt + l15) * 4) = ss; }
        __syncthreads();
#pragma unroll
        for (int tt = 0; tt < 4; ++tt) { const int t = 16 * tt + l15; float tot = 0.f;
#pragma unroll
            for (int ww = 0; ww < 8; ++ww) tot += *(const LAS float*)(lds + L_RED + (ww * 64 + t) * 4);
            const float rstd = rsqrtf(tot * (1.0f / 256.0f) + EPS);
            if (t < nvalid && !nostore) {
#pragma unroll
                for (int j2 = 0; j2 < 2; ++j2) { const int v0 = 32 * w + 16 * j2 + 4 * g4; bf16_t* rp = proj + (size_t)(tok0 + t) * PJ + PC_R + h * 256 + v0;
                    const u32x2 rr = rrv[tt][j2]; const f32x4 gn = *(const f32x4*)(p.gla_norm_w + v0); const f32x4 o = ao[j2][tt];
                    u32x2 pk; pk.x = cvt_pk_bf16(o[0] * rstd * gn[0] * siluf_(bflo(rr.x)), o[1] * rstd * gn[1] * siluf_(bfhi(rr.x)));
                    pk.y = cvt_pk_bf16(o[2] * rstd * gn[2] * siluf_(bflo(rr.y)), o[3] * rstd * gn[3] * siluf_(bfhi(rr.y)));
                    *(u32x2*)rp = pk; } } }
#pragma unroll
        for (int ks = 0; ks < 2; ++ks) { bf16x8 Bv[2];
#pragma unroll
            for (int j2 = 0; j2 < 2; ++j2) Bv[j2] = tr_frag(lds + L_V + 32 * ks * RS_V + (32 * w + 16 * j2) * 2, RS_V, lane);
#pragma unroll
            for (int kt = 0; kt < 8; ++kt) { const bf16x8 Ak = tr_frag(lds + L_K + 32 * ks * RS_QK + 16 * kt * 2, RS_QK, lane);
#pragma unroll
                for (int j2 = 0; j2 < 2; ++j2) acc[kt][j2] = MFMA16(Ak, Bv[j2], acc[kt][j2]); } }
#pragma unroll
        for (int kt = 0; kt < 8; ++kt) { const f32x4 d = *(const LAS f32x4*)(lds + (ch * 128 + 16 * kt + 4 * g4) * 4);
#pragma unroll
            for (int j2 = 0; j2 < 2; ++j2) acc[kt][j2] = acc[kt][j2] * d; }
        __syncthreads();
    }
#undef GLA_LOAD_TILES
    if (sample && !nostore) { float* so = p.out + OUT_SS + (size_t)(idx * 4 + h) * 128 * 256;
#pragma unroll
        for (int kt = 0; kt < 8; ++kt)
#pragma unroll
            for (int j2 = 0; j2 < 2; ++j2)
#pragma unroll
                for (int r = 0; r < 4; ++r) so[(size_t)(16 * kt + 4 * g4 + r) * 256 + 32 * w + 16 * j2 + l15] = acc[kt][j2][r];
    }
}
constexpr int G_VN = 0, G_WS = 67584, G_ST = 102400, RS_VN = 528, RS_WS = 272;
__device__ __forceinline__ void gmlp_item(const Params& p, LAS unsigned char* lds, int chunk, int g, bool nostore = false, bool build_ws = true) {
    int tid_ = threadIdx.x; asm volatile("" : "+v"(tid_));
    const int tid = tid_, lane = tid & 63, w = tid >> 6, g4 = lane >> 4, l15 = lane & 15;
    bf16_t* proj = (bf16_t*)(p.ws + WS_PROJ); const int tok0 = chunk * 128;
    u32x4 gvr[8]; u32x2 uzr[8][2];
#pragma unroll
    for (int i = 0; i < 8; ++i) { const int e = tid + 512 * i, r = e >> 5, c = e & 31; gvr[i] = *(const u32x4*)(proj + (size_t)(tok0 + r) * PJ + PC_GV + g * 256 + c * 8); }
#pragma unroll
    for (int it = 0; it < 8; ++it)
#pragma unroll
        for (int j2 = 0; j2 < 2; ++j2) uzr[it][j2] = *(const u32x2*)(proj + (size_t)(tok0 + 16 * it + l15) * PJ + PC_UZ + g * 256 + 32 * w + 16 * j2 + 4 * g4);
    if (tid < 128) { const float* gp = (const float*)(p.ws + WS_GVST) + (size_t)(tok0 + tid) * 32; float s = 0.f, q = 0.f;
#pragma unroll
        for (int k = 0; k < 8; ++k) { const f32x4 v = *(const f32x4*)(gp + 4 * k); s += v[0] + v[2]; q += v[1] + v[3]; }
        const float mean = s * (1.0f / 1024.0f), var = fmaxf(q * (1.0f / 1024.0f) - mean * mean, 0.f);
        *(LAS f32x2*)(lds + G_ST + tid * 8) = (f32x2){mean, rsqrtf(var + EPS)}; }
    if (build_ws)
#pragma unroll
    for (int i = 0; i < 8; ++i) { const int e = tid + 512 * i, r = e >> 5, j4 = (e & 31) * 4; f32x4 v = *(const f32x4*)(p.w_s + (size_t)(g * 128 + r) * 128 + j4);
        if (r < 64 && j4 >= 64) v = (f32x4){0.f, 0.f, 0.f, 0.f};
        u32x2 pk; pk.x = cvt_pk_bf16(v[0], v[1]); pk.y = cvt_pk_bf16(v[2], v[3]); *(LAS u32x2*)(lds + G_WS + r * RS_WS + j4 * 2) = pk; }
    __syncthreads();
#pragma unroll
    for (int i = 0; i < 8; ++i) { const int e = tid + 512 * i, r = e >> 5, c = e & 31; const u32x4 a = gvr[i];
        const f32x2 st = *(const LAS f32x2*)(lds + G_ST + r * 8); const float* lw = p.ln_v_w + g * 256 + c * 8; const float* lb = p.ln_v_b + g * 256 + c * 8;
        const f32x4 w0 = *(const f32x4*)lw, w1 = *(const f32x4*)(lw + 4), b0 = *(const f32x4*)lb, b1 = *(const f32x4*)(lb + 4);
        u32x4 o; o.x = cvt_pk_bf16((bflo(a.x) - st[0]) * st[1] * w0[0] + b0[0], (bfhi(a.x) - st[0]) * st[1] * w0[1] + b0[1]);
        o.y = cvt_pk_bf16((bflo(a.y) - st[0]) * st[1] * w0[2] + b0[2], (bfhi(a.y) - st[0]) * st[1] * w0[3] + b0[3]);
        o.z = cvt_pk_bf16((bflo(a.z) - st[0]) * st[1] * w1[0] + b1[0], (bfhi(a.z) - st[0]) * st[1] * w1[1] + b1[1]);
        o.w = cvt_pk_bf16((bflo(a.w) - st[0]) * st[1] * w1[2] + b1[2], (bfhi(a.w) - st[0]) * st[1] * w1[3] + b1[3]);
        *(LAS u32x4*)(lds + G_VN + r * RS_VN + c * 16) = o; }
    __syncthreads();
    f32x4 acc[2][8];
#pragma unroll
    for (int j2 = 0; j2 < 2; ++j2)
#pragma unroll
        for (int it = 0; it < 8; ++it) acc[j2][it] = (f32x4){0.f, 0.f, 0.f, 0.f};
#pragma unroll
    for (int ks = 0; ks < 4; ++ks) { bf16x8 Av[2];
#pragma unroll
        for (int j2 = 0; j2 < 2; ++j2) Av[j2] = tr_frag(lds + G_VN + 32 * ks * RS_VN + (32 * w + 16 * j2) * 2, RS_VN, lane);
#pragma unroll
        for (int it = 0; it < 8; ++it) { if (ks >= 2 && it < 4) continue; const bf16x8 Bw = row_frag(lds + G_WS + 16 * it * RS_WS + ks * 64, RS_WS, lane);
#pragma unroll
            for (int j2 = 0; j2 < 2; ++j2) acc[j2][it] = MFMA16(Av[j2], Bw, acc[j2][it]); } }
#pragma unroll
    for (int it = 0; it < 8; ++it) { const int i = 16 * it + l15; const float bs = p.b_s[g * 128 + i];
#pragma unroll
        for (int j2 = 0; j2 < 2; ++j2) { bf16_t* rp = proj + (size_t)(tok0 + i) * PJ + PC_UZ + g * 256 + 32 * w + 16 * j2 + 4 * g4; const u32x2 uz = uzr[it][j2]; const f32x4 a = acc[j2][it];
            u32x2 pk; pk.x = cvt_pk_bf16(bflo(uz.x) * (a[0] + bs), bfhi(uz.x) * (a[1] + bs)); pk.y = cvt_pk_bf16(bflo(uz.y) * (a[2] + bs), bfhi(uz.y) * (a[3] + bs)); if (!nostore) *(u32x2*)rp = pk; } }
    __syncthreads();
}
__device__ __forceinline__ void gmlp_sample_item(const Params& p, LAS unsigned char* lds, int b, bool nostore = false) {
    int tid_ = threadIdx.x; asm volatile("" : "+v"(tid_));
    const int tid = tid_, lane = tid & 63, w = tid >> 6; bf16_t* proj = (bf16_t*)(p.ws + WS_PROJ); const int tok0 = SEQ + b * SAMP_T;
    LAS float* vn = (LAS float*)lds; LAS float* wsm = (LAS float*)(lds + 65536); LAS float* st = (LAS float*)(lds + 65536 + 4096);
    for (int i = 0; i < 2; ++i) { const int r = 2 * w + i; const bf16_t* rp = proj + (size_t)(tok0 + r) * PJ + PC_GV;
        const u32x4 a = *(const u32x4*)(rp + lane * 8), bb = *(const u32x4*)(rp + 512 + lane * 8);
        float x[16]; x[0] = bflo(a.x); x[1] = bfhi(a.x); x[2] = bflo(a.y); x[3] = bfhi(a.y); x[4] = bflo(a.z); x[5] = bfhi(a.z); x[6] = bflo(a.w); x[7] = bfhi(a.w);
        x[8] = bflo(bb.x); x[9] = bfhi(bb.x); x[10] = bflo(bb.y); x[11] = bfhi(bb.y); x[12] = bflo(bb.z); x[13] = bfhi(bb.z); x[14] = bflo(bb.w); x[15] = bfhi(bb.w);
        float s = 0.f;
#pragma unroll
        for (int k = 0; k < 16; ++k) s += x[k];
        const float mean = wave_sum(s) * (1.0f / 1024.0f); float q = 0.f;
#pragma unroll
        for (int k = 0; k < 16; ++k) { const float d = x[k] - mean; q += d * d; }
        const float rstd = rsqrtf(wave_sum(q) * (1.0f / 1024.0f) + EPS);
        if (lane == 0) { st[r * 2] = mean; st[r * 2 + 1] = rstd; } }
    for (int e = tid; e < 1024; e += 512) { const int g = e >> 8, i = (e >> 4) & 15, j = e & 15; wsm[e] = p.w_s[(size_t)(g * 128 + i) * 128 + j]; }
    __syncthreads();
    float* vs = p.out + OUT_VS + (size_t)b * SAMP_T * 1024;
    for (int i = 0; i < 4; ++i) { const int e = tid + 512 * i, r = e >> 7, c = (e & 127) * 8; const u32x4 a = *(const u32x4*)(proj + (size_t)(tok0 + r) * PJ + PC_GV + c);
        const float mean = st[r * 2], rstd = st[r * 2 + 1]; const f32x4 w0 = *(const f32x4*)(p.ln_v_w + c), w1 = *(const f32x4*)(p.ln_v_w + c + 4), b0 = *(const f32x4*)(p.ln_v_b + c), b1 = *(const f32x4*)(p.ln_v_b + c + 4);
        f32x4 o0, o1; o0[0] = (bflo(a.x) - mean) * rstd * w0[0] + b0[0]; o0[1] = (bfhi(a.x) - mean) * rstd * w0[1] + b0[1]; o0[2] = (bflo(a.y) - mean) * rstd * w0[2] + b0[2]; o0[3] = (bfhi(a.y) - mean) * rstd * w0[3] + b0[3];
        o1[0] = (bflo(a.z) - mean) * rstd * w1[0] + b1[0]; o1[1] = (bfhi(a.z) - mean) * rstd * w1[1] + b1[1]; o1[2] = (bflo(a.w) - mean) * rstd * w1[2] + b1[2]; o1[3] = (bfhi(a.w) - mean) * rstd * w1[3] + b1[3];
        *(LAS f32x4*)(vn + r * 1024 + c) = o0; *(LAS f32x4*)(vn + r * 1024 + c + 4) = o1; *(f32x4*)(vs + r * 1024 + c) = o0; *(f32x4*)(vs + r * 1024 + c + 4) = o1; }
    __syncthreads();
    { const int c = tid * 2, g = c >> 8; f32x2 v[16];
#pragma unroll
      for (int j = 0; j < 16; ++j) v[j] = *(const LAS f32x2*)(vn + j * 1024 + c);
#pragma unroll
      for (int i = 0; i < 16; ++i) { float s0 = p.b_s[g * 128 + i], s1 = s0;
#pragma unroll
          for (int j = 0; j < 16; ++j) { const float wv = wsm[g * 256 + i * 16 + j]; s0 += wv * v[j][0]; s1 += wv * v[j][1]; }
          bf16_t* rp = proj + (size_t)(tok0 + i) * PJ + PC_UZ + c; const unsigned uz = *(const unsigned*)rp; if (!nostore) *(unsigned*)rp = cvt_pk_bf16(bflo(uz) * s0, bfhi(uz) * s1); } }
    __syncthreads();
}
__device__ __forceinline__ void phase4(const Params& p) {
    const unsigned* useg = (const unsigned*)((unsigned char*)p.out + RB_USEG); unsigned* sst = (unsigned*)((unsigned char*)p.out + RB_SSTART); const float* dseg = (const float*)(p.ws + WS_DSEG);
    int tid_ = threadIdx.x; asm volatile("" : "+v"(tid_)); const int tid = tid_; int bid_ = blockIdx.x; asm volatile("" : "+s"(bid_)); const int bid = bid_;
    for (int e2 = bid * 512 + tid; e2 < 65536; e2 += gridDim.x * 512) {
        const int e = e2 * 2, h = e >> 15, v = (e >> 7) & 255, kap = e & 127; float S0 = 0.f, S1 = 0.f;
        for (int s0 = 0; s0 < NSEG; s0 += 32) { unsigned u[32]; f32x2 dd[32];
#pragma unroll
            for (int s = 0; s < 32; ++s) { u[s] = __builtin_nontemporal_load(useg + (size_t)(s0 + s) * 65536 + e2); dd[s] = *(const f32x2*)(dseg + ((s0 + s) * 4 + h) * 128 + kap); }
#pragma unroll
            for (int s = 0; s < 32; ++s) { sst[(size_t)(s0 + s) * 65536 + e2] = cvt_pk_bf16(S0, S1); S0 = dd[s][0] * S0 + bflo(u[s]); S1 = dd[s][1] * S1 + bfhi(u[s]); } }
        p.out[OUT_SP + (size_t)(h * 128 + kap) * 256 + v] = S0; p.out[OUT_SP + (size_t)(h * 128 + kap + 1) * 256 + v] = S1; }
}
__device__ __forceinline__ void phase8(const Params& p, bool nostore = false) {
    int tid_ = threadIdx.x; asm volatile("" : "+v"(tid_)); const int tid = tid_; int bid_ = blockIdx.x; asm volatile("" : "+s"(bid_)); const int bid = bid_;
    const int lane = tid & 63, wv = tid >> 6;
    for (int row = SEQ + bid * 8 + wv; row < MTOT; row += gridDim.x * 8) { float* yr = p.out + (size_t)row * D;
        f32x4 v[4]; float ss = 0.f;
#pragma unroll
        for (int i = 0; i < 4; ++i) { v[i] = *(const f32x4*)(yr + i * 256 + lane * 4); ss += (v[i][0] * v[i][0] + v[i][1] * v[i][1]) + (v[i][2] * v[i][2] + v[i][3] * v[i][3]); }
        const float rstd = rsqrtf(wave_sum(ss) * (1.0f / D) + EPS);
#pragma unroll
        for (int i = 0; i < 4; ++i) { const int c = i * 256 + lane * 4; const f32x4 fw = *(const f32x4*)(p.final_norm_w + c); if (!nostore) *(f32x4*)(yr + c) = v[i] * rstd * fw; } }
}

__global__ __launch_bounds__(512, 2) void mega(Params p0) {
    extern __shared__ __attribute__((aligned(16))) unsigned char shm[];
    LAS unsigned char* lds = (LAS unsigned char*)shm;
    const bool multi = (p0.ph_hi - p0.ph_lo) > 1;
    if (multi) { volatile LAS unsigned* st = (volatile LAS unsigned*)(lds + LDS_BAR);
        if (threadIdx.x == 0) { st[0] = 0u; st[1] = 0u; }
        __syncthreads();
        (void)xcd_barrier_post((unsigned*)(p0.ws + WS_CTL), st); }
#ifdef PROBE_PH
    constexpr int PDUP = PROBE_PH >= 30 ? 3 : (PROBE_PH >= 20 ? 2 : PROBE_PH);
    const int nph = p0.ph_hi + 1;
#else
    const int nph = p0.ph_hi;
#endif
    for (int pi = p0.ph_lo; pi < nph; ++pi) {
#if defined(__HIP_DEVICE_COMPILE__)
        const __attribute__((address_space(4))) Params* kp = (const __attribute__((address_space(4))) Params*)__builtin_amdgcn_kernarg_segment_ptr();
        asm volatile("" : "+s"(kp));
        const Params p = *kp;
#else
        const Params p = p0;
#endif
        int bid_ = blockIdx.x; asm volatile("" : "+s"(bid_)); const int bid = bid_;
#ifdef PROBE_PH
        const int ph = pi > PDUP ? pi - 1 : pi; const bool first = (pi == PDUP); const bool nostore = first && (p.ph_hi < 100);
#else
        const int ph = pi; const bool nostore = false;
#endif
      {
        if (ph == 0) phase0(p, lds);
        else if (ph == 1) phase1(p);
        else if (ph == 2) { pg8::Order S; S.init(SEQ / 256, 32, gridDim.x, bid); Ptr1 P{(const char*)p.out + RB_H, (const char*)p.out + RB_BT1};
            Epi1 E{(bf16_t*)(p.ws + WS_PROJ), (float*)(p.ws + WS_GVST)};
#ifdef PROBE_PH
            if (!(first && PROBE_PH == 20)) pg8::gemm_phase<Epi1, Ptr1, pg8::Order>(lds, S, P, E, D, D, D);
            if (!(first && PROBE_PH == 21)) sample_gemm1(p, lds, bid);
#else
            pg8::gemm_phase<Epi1, Ptr1, pg8::Order>(lds, S, P, E, D, D, D); sample_gemm1(p, lds, bid);
#endif
            }
        else if (ph == 3) {
            const int pm = (bid & 7) * 8 + (bid >> 5), hg = (bid >> 3) & 3;
            gla_segA(p, lds, pm, hg);
            gmlp_item(p, lds, 2 * pm, hg, nostore, true);
            gmlp_item(p, lds, 2 * pm + 1, hg, nostore, false);
            if (bid >= 16 && bid < 80) { const int it = bid - 16; gla_prep(p, lds, SEQ + (it >> 2) * SAMP_T, 1, SAMP_T, it & 3, 256 + (it >> 2), false, 0, 0); __syncthreads(); } }
        else if (ph == 4) { phase4(p); if (bid >= 128 && bid < 192) gla_out(p, lds, 1, (bid - 128) >> 2, (bid - 128) & 3, nostore);
            else if (bid >= 192 && bid < 208) gmlp_sample_item(p, lds, bid - 192, nostore); }
        else if (ph == 5) {
            gla_out(p, lds, 0, (bid & 7) * 8 + (bid >> 5), (bid >> 3) & 3, nostore); }
        else if (ph == 6) { pg8::Order2 S; S.c = bid; Ptr2 P{(const char*)(p.ws + WS_PROJ), (const char*)(p.ws + WS_BTA), (const char*)(p.ws + WS_BTB)};
            Epi2 E{(bf16_t*)(p.ws + WS_PROJ), p.b_gate, nostore}; pg8::gemm_phase<Epi2, Ptr2, pg8::Order2>(lds, S, P, E, D, PJ, D); sample_gemm2(p, bid, nostore); }
        else if (ph == 7) { pg8::Order S; S.init(SEQ / 256, 4, gridDim.x, bid); Ptr3 P{(const char*)(p.ws + WS_PROJ), (const char*)(p.ws + WS_BTO)};
            Epi3 E{p.x_prompt, (const float*)(p.ws + WS_ADA), p.final_norm_w, p.out, (float*)(p.ws + WS_XB), (unsigned*)(p.ws + WS_PCNT)}; pg8::gemm_phase<Epi3, Ptr3, pg8::Order>(lds, S, P, E, D, PJ, D); sample_gemm3(p, bid); }
        else if (ph == 8) phase8(p, nostore);
      }
        if (multi && pi + 1 < nph) { XcdBarrier xb; xb.bar = (unsigned*)(p.ws + WS_CTL); xb.x = xb_xcc_id(); xb.st = (volatile LAS unsigned*)(lds + LDS_BAR); xcd_barrier(xb); }
    }
}

#ifndef MK_LAUNCHES
#define MK_LAUNCHES 1
#endif
extern "C" void kernel_launch(void* const* d_in, const int* in_sizes, int n_in, void* d_out, int out_size, void* d_ws, size_t ws_size, hipStream_t stream) {
    static int ready = 0;
    if (ready == 0) {
        if (n_in != 21 || ws_size < WS_END) { fprintf(stderr, "kernel_launch: need 21 inputs and >= %zu bytes of workspace (got %d, %zu)\n", (size_t)WS_END, n_in, ws_size); ready = -1; return; }
        if (hipFuncSetAttribute((const void*)mega, hipFuncAttributeMaxDynamicSharedMemorySize, LDS_BYTES) != hipSuccess) { fprintf(stderr, "kernel_launch: hipFuncSetAttribute failed\n"); ready = -1; return; }
        int per_cu = 0; (void)hipOccupancyMaxActiveBlocksPerMultiprocessor(&per_cu, (const void*)mega, 512, LDS_BYTES); (void)hipGetLastError();
        if (per_cu < 1) fprintf(stderr, "kernel_launch: occupancy query reports %d blocks per CU\n", per_cu);
        ready = 1;
    }
    if (ready < 0) return;
    (void)hipMemsetAsync((char*)d_ws + WS_CTL, 0, 32768, stream);
    Params p{};
    const float** pp = (const float**)&p;
    for (int i = 0; i < 21; ++i) pp[i] = (const float*)d_in[i];
    p.out = (float*)d_out; p.ws = (unsigned char*)d_ws;
    const int nl = MK_LAUNCHES;
    for (int li = 0; li < nl; ++li) {
        p.ph_lo = (nl == 1) ? 0 : li; p.ph_hi = (nl == 1) ? 9 : li + 1;
        void* args[] = {&p};
        hipError_t e;
        if (nl == 1) e = hipLaunchCooperativeKernel((const void*)mega, dim3(256), dim3(512), args, LDS_BYTES, stream);
        else { hipLaunchKernelGGL(mega, dim3(256), dim3(512), LDS_BYTES, stream, p); e = hipPeekAtLastError(); }
        if (e != hipSuccess) { fprintf(stderr, "kernel_launch: launch %d failed: %s\n", li, hipGetErrorString(e)); break; }
    }
}
```

```cpp
#include <hip/hip_runtime.h>
#include <cstdio>

#define LAS __attribute__((address_space(3)))
typedef unsigned short bf16_t;
typedef short bf16x8 __attribute__((ext_vector_type(8)));
typedef short s16x4 __attribute__((ext_vector_type(4)));
typedef float f32x4 __attribute__((ext_vector_type(4)));
typedef float f32x2 __attribute__((ext_vector_type(2)));
typedef unsigned u32x4 __attribute__((ext_vector_type(4)));
typedef unsigned u32x2 __attribute__((ext_vector_type(2)));

constexpr int D = 1024, SEQ = 16384, NSAMP = 16, SAMP_T = 16, MTOT = SEQ + NSAMP * SAMP_T;
constexpr int WIN_LD = 8208;
constexpr int PJ = 7168;
constexpr int PC_Q = 0, PC_K = 512, PC_V = 1024, PC_R = 2048, PC_UZ = 3072, PC_GV = 4096, PC_GA = 5120;
constexpr int N1 = 8256;
constexpr int NSEG = 64, SEGCH = 4;
constexpr float EPS = 1e-6f;
constexpr size_t WS_CTL = 0, WS_PCNT = 16384, WS_ADA = 32768, WS_ALR = WS_ADA + 17 * 3072 * 4, WS_DSEG = WS_ALR + (size_t)MTOT * 16 * 4,
                 WS_ROWSS = WS_DSEG + NSEG * 4 * 128 * 4, WS_BTA = WS_ROWSS + (size_t)MTOT * 16 * 4, WS_BTB = WS_BTA + 2097152,
                 WS_BTO = WS_BTB + 2097152, WS_PROJ = WS_BTO + 4194304, WS_GVST = WS_PROJ + (size_t)MTOT * PJ * 2, WS_DCH = WS_GVST + (size_t)SEQ * 16 * 8, WS_XB = WS_DCH + (size_t)272 * 4 * 128 * 4, WS_END = WS_XB + (size_t)64 * 256 * 4 * 4;
constexpr size_t RB_H = 0, RB_BT1 = (size_t)MTOT * D * 2, RB_USEG = 0, RB_SSTART = 16777216;
constexpr size_t OUT_YS = (size_t)SEQ * D, OUT_SP = OUT_YS + 256 * D, OUT_SS = OUT_SP + 4 * 128 * 256, OUT_VS = OUT_SS + 16 * 4 * 128 * 256;
constexpr int LDS_BAR = 156160, LDS_BYTES = 156672;

struct Params {
    const float* x_prompt; const float* x_sample; const float* state_gla; const float* c_prompt; const float* c_sample;
    const float* norm_w; const float* w_ada; const float* b_ada; const float* w_in; const float* w_a2; const float* b_a;
    const float* gla_norm_w; const float* ln_v_w; const float* ln_v_b; const float* w_s; const float* b_s; const float* b_gate;
    const float* w_proj_a; const float* w_proj_b; const float* w_out; const float* final_norm_w;
    float* out; unsigned char* ws; int ph_lo; int ph_hi;
};

__device__ __forceinline__ unsigned cvt_pk_bf16(float lo, float hi) { unsigned r; asm volatile("v_cvt_pk_bf16_f32 %0, %1, %2" : "=v"(r) : "v"(lo), "v"(hi)); return r; }
__device__ __forceinline__ bf16_t f2bf(float f) { return (bf16_t)(cvt_pk_bf16(f, 0.f) & 0xffffu); }
__device__ __forceinline__ float bf2f(bf16_t b) { return __uint_as_float(((unsigned)b) << 16); }
__device__ __forceinline__ float bflo(unsigned w) { return __uint_as_float(w << 16); }
__device__ __forceinline__ float bfhi(unsigned w) { return __uint_as_float(w & 0xffff0000u); }
__device__ __forceinline__ float sigmoidf_(float x) { return __builtin_amdgcn_rcpf(1.0f + __expf(-x)); }
__device__ __forceinline__ float siluf_(float x) { return x * __builtin_amdgcn_rcpf(1.0f + __expf(-x)); }
__device__ __forceinline__ float wave_sum(float v) {
#pragma unroll
    for (int o = 32; o > 0; o >>= 1) v += __shfl_xor(v, o);
    return v;
}
__device__ __forceinline__ bf16x8 row_frag(const LAS unsigned char* base, int rs, int lane) { return *(const LAS bf16x8*)(base + rs * (lane & 15) + 16 * (lane >> 4)); }
__device__ __forceinline__ bf16x8 tr_frag(const LAS unsigned char* base, int rs, int lane) {
    const int g = lane >> 4, q = (lane & 15) >> 2, pp = lane & 3;
    const LAS unsigned char* a = base + rs * (8 * g + q) + 8 * pp;
    const s16x4 lo = __builtin_amdgcn_ds_read_tr16_b64_v4i16((LAS s16x4*)a);
    const s16x4 hi = __builtin_amdgcn_ds_read_tr16_b64_v4i16((LAS s16x4*)(a + 4 * rs));
    bf16x8 r; r[0] = lo[0]; r[1] = lo[1]; r[2] = lo[2]; r[3] = lo[3]; r[4] = hi[0]; r[5] = hi[1]; r[6] = hi[2]; r[7] = hi[3]; return r;
}
#define MFMA16(a, b, c) __builtin_amdgcn_mfma_f32_16x16x32_bf16(a, b, c, 0, 0, 0)

#define XB_TMO      128
#define XB_XCNT(j)  (256  + 64 * (j))
#define XB_XSUB(j)  (1280 + 64 * (j))
#define XB_XGEN(j)  (2304 + 64 * (j))
#define XB_TOP      3328
#define XB_TOPGEN   3392
#define XCD_BAR_WORDS 3456
#define XB_SPIN_CAP (1u << 22)
__device__ __forceinline__ unsigned xb_ld(unsigned* p)              { return __hip_atomic_load(p, __ATOMIC_RELAXED, __HIP_MEMORY_SCOPE_AGENT); }
__device__ __forceinline__ unsigned xb_add(unsigned* p, unsigned v) { return __hip_atomic_fetch_add(p, v, __ATOMIC_RELAXED, __HIP_MEMORY_SCOPE_AGENT); }
__device__ __forceinline__ unsigned xb_xcc_id() { return (unsigned)__builtin_amdgcn_s_getreg((3 << 11) | 20) & 0xFu; }
#define XB_SPIN(cond, bar) do { unsigned _sp = 0; while (cond) { __builtin_amdgcn_s_sleep(1); \
    if ((++_sp & 255u) == 0u) { if (xb_ld(&(bar)[XB_TMO])) break; if (_sp > XB_SPIN_CAP) { atomicAdd(&(bar)[XB_TMO], 1u); break; } } } } while (0)
struct XcdBarrier { unsigned* bar; unsigned x; volatile LAS unsigned* st; };
__device__ __forceinline__ XcdBarrier xcd_barrier_post(unsigned* bar, volatile LAS unsigned* st) {
    XcdBarrier b; b.bar = bar; b.x = xb_xcc_id(); b.st = st;
    if (threadIdx.x == 0) (void)xb_add(&bar[XB_XCNT(b.x)], 1u);
    return b;
}
__device__ __forceinline__ void xcd_barrier_complete(unsigned* bar, unsigned x, unsigned& nloc, unsigned& nx) {
    const unsigned G = gridDim.x * gridDim.y * gridDim.z;
    unsigned sum, cnt, mine, sp = 0u;
    for (;;) {
        sum = 0u; cnt = 0u; mine = 0u;
#pragma unroll
        for (unsigned j = 0; j < 16; ++j) { const unsigned c = xb_ld(&bar[XB_XCNT(j)]); sum += c; cnt += (c > 0u) ? 1u : 0u; mine = (j == x) ? c : mine; }
        if (sum == G) break;
        __builtin_amdgcn_s_sleep(1);
        if ((++sp & 255u) == 0u) { if (xb_ld(&bar[XB_TMO])) break; if (sp > XB_SPIN_CAP) { atomicAdd(&bar[XB_TMO], 1u); break; } }
    }
    nloc = mine > 0u ? mine : 1u; nx = cnt > 0u ? cnt : 1u;
}
__device__ __forceinline__ void xcd_barrier(const XcdBarrier& b) {
    asm volatile("s_waitcnt vmcnt(0)" ::: "memory");
    __syncthreads();
    if (threadIdx.x == 0) {
        unsigned* bar = b.bar;
        __builtin_amdgcn_s_waitcnt(0);
        unsigned nloc = b.st[0], nx = b.st[1];
        if (nloc == 0u) { xcd_barrier_complete(bar, b.x, nloc, nx); b.st[0] = nloc; b.st[1] = nx; }
        const unsigned old = xb_add(&bar[XB_XSUB(b.x)], 1u);
        const unsigned gen = old / nloc;
        if (old + 1u == (gen + 1u) * nloc) {
            __builtin_amdgcn_fence(__ATOMIC_RELEASE, "agent");
            asm volatile("s_waitcnt vmcnt(0)" ::: "memory");
            const unsigned og = xb_add(&bar[XB_TOP], 1u);
            const unsigned tg = og / nx;
            if (og + 1u == (tg + 1u) * nx) xb_add(&bar[XB_TOPGEN], 1u);
            else XB_SPIN(xb_ld(&bar[XB_TOPGEN]) == tg, bar);
            __builtin_amdgcn_fence(__ATOMIC_ACQUIRE, "agent");
            xb_add(&bar[XB_XGEN(b.x)], 1u);
            asm volatile("s_waitcnt vmcnt(0)" ::: "memory");
        } else {
            XB_SPIN(xb_ld(&bar[XB_XGEN(b.x)]) == gen, bar);
            __builtin_amdgcn_fence(__ATOMIC_ACQUIRE, "agent");
            asm volatile("s_waitcnt vmcnt(0)" ::: "memory");
        }
    }
    __syncthreads();
}

namespace pg8 {
constexpr int BM = 256, BK = 64, HALF = 128, HTB = HALF * BK * 2, NXCD = 8, WGM = 8;
__device__ __forceinline__ int lds_byte(int r, int c) { const int st = (r >> 4) * 2 + (c >> 5), rr = r & 15, cc = c & 31, ob = rr * 64 + cc * 2; return st * 1024 + (ob ^ (((ob >> 9) & 1) << 5)); }
__device__ __forceinline__ void stage_rc(int b, int& R, int& C) { const int st = b / 1024, sb = b % 1024, swz = sb ^ (((sb >> 9) & 1) << 5); R = (st >> 1) * 16 + swz / 64; C = (st & 1) * 32 + (swz % 64) / 2; }
__device__ __forceinline__ int perm32(int rho) { const int n = rho >> 4, i = rho & 15; return 8 * (i >> 2) + 4 * n + (i & 3); }
struct Unit { int pm, pn; };
struct Order {
    int nM, nN, nwg, G, c;
    __device__ void init(int nM_, int nN_, int G_, int c_) { nM = nM_; nN = nN_; nwg = nM * nN; G = G_; c = c_; }
    __device__ bool next(int i, Unit& u) const {
        const long L = (long)i * G + c; if (L >= nwg) return false;
        int wgid = (int)L; { const int q = nwg / NXCD, r = nwg % NXCD, xcd = wgid % NXCD, off = wgid / NXCD; wgid = (xcd < r ? xcd * (q + 1) : r * (q + 1) + (xcd - r) * q) + off; }
        const int nig = WGM * nN, gid = wgid / nig, fm = gid * WGM, gsz = (nM - fm) < WGM ? (nM - fm) : WGM;
        u.pm = fm + ((wgid % nig) % gsz); u.pn = (wgid % nig) / gsz; return true;
    }
};
struct Order2 {
    int c;
    __device__ bool next(int i, Unit& u) const { if (i >= 2) return false; const int x = c & 7, q = c >> 3; u.pm = x * 8 + (q >> 2); u.pn = (q & 3) + 4 * i; return true; }
};
template <class Epi, class Ptr, class Ord>
__device__ __forceinline__ void gemm_phase(LAS unsigned char* lds, const Ord& S, const Ptr& P, const Epi& E, int K, int lda, int ldb) {
    int tid_ = threadIdx.x; asm volatile("" : "+v"(tid_));
    const int tid = tid_, wid = __builtin_amdgcn_readfirstlane(tid >> 6), lane = tid & 63, wr = wid >> 2, wc = wid & 3, fr = lane & 15, fq = lane >> 4;
    const int nt = K / BK;
    unsigned voffA[2], voffB[2];
#pragma unroll
    for (int i = 0; i < 2; ++i) { int R, C; stage_rc(tid * 16 + i * 8192, R, C); const int Rb = Epi::PERM ? ((R & ~31) + perm32(R & 31)) : R;
        voffA[i] = (unsigned)(R * lda + C) * 2u; voffB[i] = (unsigned)(Rb * ldb + C) * 2u; }
    const size_t kstep = (size_t)(BK * 2);
    const size_t hstepA = (size_t)HALF * lda * 2, hstepB = (size_t)HALF * ldb * 2;
    const unsigned ldsw = (unsigned)wid * 1024u;
    const int aoff = lds_byte(wr * 64 + fr, fq * 8), boff = lds_byte(wc * 32 + fr, fq * 8);
#define PG8_SA(b, h) (((b) * 2 + (h)) * HTB)
#define PG8_SB(b, h) ((4 + (b) * 2 + (h)) * HTB)
#define PG8_STAGE(bufoff, gbase, voff) do { _Pragma("unroll") for (int _i = 0; _i < 2; ++_i) \
        __builtin_amdgcn_global_load_lds((const unsigned*)((const char*)(gbase) + (voff)[_i]), (LAS unsigned*)(lds + (bufoff) + ldsw + _i * 8192), 16, 0, 0); } while (0)
#define PG8_LDA(dst, b, h) do { _Pragma("unroll") for (int m = 0; m < 4; ++m) _Pragma("unroll") for (int k = 0; k < 2; ++k) dst[m][k] = *(const LAS bf16x8*)(lds + PG8_SA(b, h) + aoff + m * 2048 + k * 1024); } while (0)
#define PG8_LDB(dst, b, h) do { _Pragma("unroll") for (int n = 0; n < 2; ++n) _Pragma("unroll") for (int k = 0; k < 2; ++k) dst[n][k] = *(const LAS bf16x8*)(lds + PG8_SB(b, h) + boff + n * 2048 + k * 1024); } while (0)
#define PG8_MMA(ai, bj, At, Bt) do { __builtin_amdgcn_s_setprio(1); _Pragma("unroll") for (int m = 0; m < 4; ++m) _Pragma("unroll") for (int n = 0; n < 2; ++n) _Pragma("unroll") for (int k = 0; k < 2; ++k) \
        acc[ai][bj][m][n] = __builtin_amdgcn_mfma_f32_16x16x32_bf16(Bt[n][k], At[m][k], acc[ai][bj][m][n], 0, 0, 0); __builtin_amdgcn_s_setprio(0); } while (0)
#define PG8_WAIT_V(n) asm volatile("s_waitcnt vmcnt(" #n ")" ::: "memory")
#define PG8_WAIT_L(n) asm volatile("s_waitcnt lgkmcnt(" #n ")" ::: "memory")
#define PG8_BAR __builtin_amdgcn_s_barrier()
#define PG8_SCHED __builtin_amdgcn_sched_barrier(0)
    Unit cur, nxt; int ui = 0;
    if (!S.next(0, cur)) return;
    f32x4 acc[2][2][4][2];
#pragma unroll
    for (int a = 0; a < 2; ++a)
#pragma unroll
        for (int b = 0; b < 2; ++b)
#pragma unroll
            for (int m = 0; m < 4; ++m)
#pragma unroll
                for (int n = 0; n < 2; ++n) acc[a][b][m][n] = (f32x4){0.f, 0.f, 0.f, 0.f};
    bf16x8 At[4][2], B0[2][2], B1[2][2];
    const char* cA = P.aptr(cur); const char* cB = P.bptr(cur);
    PG8_STAGE(PG8_SB(0, 0), cB, voffB); PG8_STAGE(PG8_SA(0, 0), cA, voffA); PG8_STAGE(PG8_SB(0, 1), cB + hstepB, voffB); PG8_STAGE(PG8_SA(0, 1), cA + hstepA, voffA);
    if (wr == 1) PG8_BAR;
    PG8_WAIT_V(4); PG8_BAR;
    PG8_STAGE(PG8_SB(1, 0), cB + kstep, voffB); PG8_STAGE(PG8_SA(1, 0), cA + kstep, voffA); PG8_STAGE(PG8_SB(1, 1), cB + hstepB + kstep, voffB);
    PG8_WAIT_V(6); PG8_BAR;
    for (;;) {
        const bool has_next = S.next(ui + 1, nxt);
        const char* nA = has_next ? P.aptr(nxt) : cA; const char* nB = has_next ? P.bptr(nxt) : cB;
        for (int t = 0; t < nt; t += 2) {
            const bool last = (t == nt - 2);
            const char* a1 = cA + (size_t)(t + 1) * kstep;
            const char* a2 = last ? nA : cA + (size_t)(t + 2) * kstep; const char* b2 = last ? nB : cB + (size_t)(t + 2) * kstep;
            const char* a3 = a2 + kstep; const char* b3 = b2 + kstep;
            PG8_LDB(B0, 0, 0); PG8_SCHED; PG8_LDA(At, 0, 0); PG8_STAGE(PG8_SA(1, 1), a1 + hstepA, voffA);
            PG8_WAIT_L(8); PG8_BAR; PG8_WAIT_L(0); PG8_MMA(0, 0, At, B0); PG8_BAR; PG8_SCHED;
            PG8_LDB(B1, 0, 1); PG8_STAGE(PG8_SB(0, 0), b2, voffB);
            PG8_BAR; PG8_WAIT_L(0); PG8_MMA(0, 1, At, B1); PG8_BAR;
            PG8_LDA(At, 0, 1); PG8_STAGE(PG8_SA(0, 0), a2, voffA);
            PG8_BAR; PG8_WAIT_L(0); PG8_MMA(1, 0, At, B0); PG8_BAR; PG8_SCHED;
            PG8_STAGE(PG8_SB(0, 1), b2 + hstepB, voffB);
            PG8_WAIT_V(6); PG8_BAR; PG8_MMA(1, 1, At, B1); PG8_BAR;
            PG8_LDB(B0, 1, 0); PG8_SCHED; PG8_LDA(At, 1, 0); PG8_STAGE(PG8_SA(0, 1), a2 + hstepA, voffA);
            PG8_WAIT_L(8); PG8_BAR; PG8_WAIT_L(0); PG8_MMA(0, 0, At, B0); PG8_BAR; PG8_SCHED;
            PG8_LDB(B1, 1, 1); PG8_STAGE(PG8_SB(1, 0), b3, voffB);
            PG8_BAR; PG8_WAIT_L(0); PG8_MMA(0, 1, At, B1); PG8_BAR;
            PG8_LDA(At, 1, 1); PG8_STAGE(PG8_SA(1, 0), a3, voffA);
            PG8_BAR; PG8_WAIT_L(0); PG8_MMA(1, 0, At, B0); PG8_BAR; PG8_SCHED;
            PG8_STAGE(PG8_SB(1, 1), b3 + hstepB, voffB);
            PG8_WAIT_V(6); PG8_BAR; PG8_MMA(1, 1, At, B1); PG8_BAR;
        }
        bool keep = false;
        if constexpr (!Epi::AFTER_DRAIN) keep = E(acc, cur, wr, wc, fr, fq);
        if (!has_next) break;
        if (!keep) {
#pragma unroll
        for (int a = 0; a < 2; ++a)
#pragma unroll
            for (int b = 0; b < 2; ++b)
#pragma unroll
                for (int m = 0; m < 4; ++m)
#pragma unroll
                    for (int n = 0; n < 2; ++n) acc[a][b][m][n] = (f32x4){0.f, 0.f, 0.f, 0.f};
        }
        cur = nxt; cA = nA; cB = nB; ++ui;
    }
    PG8_WAIT_V(0);
    if (wr == 0) PG8_BAR;
    PG8_BAR;
    if constexpr (Epi::AFTER_DRAIN) E.fused(acc, cur, wr, wc, fr, fq, lds, wid, lane);
#undef PG8_SA
#undef PG8_SB
#undef PG8_STAGE
#undef PG8_LDA
#undef PG8_LDB
#undef PG8_MMA
#undef PG8_WAIT_V
#undef PG8_WAIT_L
#undef PG8_BAR
#undef PG8_SCHED
}
}
using pg8::Unit;

struct Ptr1 { const char* A; const char* B; __device__ const char* aptr(const Unit& u) const { return A + (size_t)u.pm * 256 * D * 2; } __device__ const char* bptr(const Unit& u) const { return B + (size_t)u.pn * 256 * D * 2; } };
struct Epi1 {
    static constexpr bool PERM = true, AFTER_DRAIN = false;
    bf16_t* proj; float* gvst;
    __device__ __forceinline__ bool operator()(f32x4 (&acc)[2][2][4][2], const Unit& u, int wr, int wc, int fr, int fq) const {
        asm volatile("" : "+v"(fr), "+v"(fq));
        const int row0 = u.pm * 256 + wr * 64 + fr;
        if (u.pn >= 12 && u.pn < 20) {
            const int col = PC_UZ + (u.pn - 12) * 128 + wc * 32 + 8 * fq;
#pragma unroll
            for (int ai = 0; ai < 2; ++ai)
#pragma unroll
                for (int m = 0; m < 4; ++m) { bf16_t* rp = proj + (size_t)(row0 + ai * 128 + m * 16) * PJ + col;
                    const f32x4 u0 = acc[ai][0][m][0], u1 = acc[ai][0][m][1], z0 = acc[ai][1][m][0], z1 = acc[ai][1][m][1];
                    u32x4 w; w.x = cvt_pk_bf16(u0[0] * siluf_(z0[0]), u0[1] * siluf_(z0[1])); w.y = cvt_pk_bf16(u0[2] * siluf_(z0[2]), u0[3] * siluf_(z0[3]));
                    w.z = cvt_pk_bf16(u1[0] * siluf_(z1[0]), u1[1] * siluf_(z1[1])); w.w = cvt_pk_bf16(u1[2] * siluf_(z1[2]), u1[3] * siluf_(z1[3]));
                    __builtin_nontemporal_store(w, (u32x4*)rp); }
            return false;
        }
        const int col = (u.pn < 12 ? u.pn * 256 : PC_GV + (u.pn - 20) * 256) + wc * 32 + 8 * fq;
        const bool isgv = u.pn >= 20 && u.pn < 24;
#pragma unroll
        for (int ai = 0; ai < 2; ++ai)
#pragma unroll
            for (int m = 0; m < 4; ++m) { const int row = row0 + ai * 128 + m * 16; bf16_t* rp = proj + (size_t)row * PJ + col; float s = 0.f, q = 0.f;
#pragma unroll
                for (int bj = 0; bj < 2; ++bj) { const f32x4 v0 = acc[ai][bj][m][0], v1 = acc[ai][bj][m][1];
                    u32x4 w; w.x = cvt_pk_bf16(v0[0], v0[1]); w.y = cvt_pk_bf16(v0[2], v0[3]); w.z = cvt_pk_bf16(v1[0], v1[1]); w.w = cvt_pk_bf16(v1[2], v1[3]);
                    __builtin_nontemporal_store(w, (u32x4*)(rp + bj * 128));
                    s += (v0[0] + v0[1]) + (v0[2] + v0[3]) + (v1[0] + v1[1]) + (v1[2] + v1[3]);
                    q += (v0[0] * v0[0] + v0[1] * v0[1]) + (v0[2] * v0[2] + v0[3] * v0[3]) + (v1[0] * v1[0] + v1[1] * v1[1]) + (v1[2] * v1[2] + v1[3] * v1[3]); }
                if (isgv) { s += __shfl_xor(s, 16); s += __shfl_xor(s, 32); q += __shfl_xor(q, 16); q += __shfl_xor(q, 32);
                    if (fq == 0) *(f32x2*)(gvst + ((size_t)row * 16 + (u.pn - 20) * 4 + wc) * 2) = (f32x2){s, q}; } }
        return false;
    }
};
struct Ptr2 { const char* proj; const char* BA; const char* BB;
    __device__ const char* aptr(const Unit& u) const { return proj + ((size_t)u.pm * 256 * PJ + (u.pn < 4 ? PC_R : PC_UZ)) * 2; }
    __device__ const char* bptr(const Unit& u) const { return (u.pn < 4 ? BA : BB) + (size_t)(u.pn & 3) * 256 * D * 2; } };
struct Epi2 {
    static constexpr bool PERM = true, AFTER_DRAIN = false;
    bf16_t* proj; const float* b_gate; bool nostore;
    __device__ __forceinline__ bool operator()(f32x4 (&acc)[2][2][4][2], const Unit& u, int wr, int wc, int fr, int fq) const {
        asm volatile("" : "+v"(fr), "+v"(fq));
        const int row0 = u.pm * 256 + wr * 64 + fr, col = (u.pn & 3) * 256 + wc * 32 + 8 * fq; const bool first = u.pn < 4;
        bf16_t* base = proj + (size_t)row0 * PJ + PC_GA + col;
        if (first) {
#pragma unroll
            for (int bj = 0; bj < 2; ++bj) { const float* ba = b_gate + col + bj * 128; const f32x4 bA0 = *(const f32x4*)ba, bA1 = *(const f32x4*)(ba + 4), bB0 = *(const f32x4*)(ba + 1024), bB1 = *(const f32x4*)(ba + 1028);
#pragma unroll
                for (int ai = 0; ai < 2; ++ai) { u32x4 ga[4], gb[4];
#pragma unroll
                    for (int m = 0; m < 4; ++m) { const bf16_t* rp = base + (size_t)(ai * 128 + m * 16) * PJ + bj * 128; ga[m] = *(const u32x4*)rp; gb[m] = *(const u32x4*)(rp + 1024); }
                    __builtin_amdgcn_sched_barrier(0);
#pragma unroll
                    for (int m = 0; m < 4; ++m) { float ea[8], eb[8];
                        ea[0] = __expf(-(bflo(ga[m].x) + bA0[0])); ea[1] = __expf(-(bfhi(ga[m].x) + bA0[1])); ea[2] = __expf(-(bflo(ga[m].y) + bA0[2])); ea[3] = __expf(-(bfhi(ga[m].y) + bA0[3]));
                        ea[4] = __expf(-(bflo(ga[m].z) + bA1[0])); ea[5] = __expf(-(bfhi(ga[m].z) + bA1[1])); ea[6] = __expf(-(bflo(ga[m].w) + bA1[2])); ea[7] = __expf(-(bfhi(ga[m].w) + bA1[3]));
                        eb[0] = __expf(-(bflo(gb[m].x) + bB0[0])); eb[1] = __expf(-(bfhi(gb[m].x) + bB0[1])); eb[2] = __expf(-(bflo(gb[m].y) + bB0[2])); eb[3] = __expf(-(bfhi(gb[m].y) + bB0[3]));
                        eb[4] = __expf(-(bflo(gb[m].z) + bB1[0])); eb[5] = __expf(-(bfhi(gb[m].z) + bB1[1])); eb[6] = __expf(-(bflo(gb[m].w) + bB1[2])); eb[7] = __expf(-(bfhi(gb[m].w) + bB1[3]));
#pragma unroll
                        for (int j = 0; j < 4; ++j) { acc[ai][bj][m][0][j] *= (1.0f + eb[j]) * __builtin_amdgcn_rcpf(1.0f + ea[j]); acc[ai][bj][m][1][j] *= (1.0f + eb[4 + j]) * __builtin_amdgcn_rcpf(1.0f + ea[4 + j]); } } } }
            return true;
        }
#pragma unroll
        for (int bj = 0; bj < 2; ++bj) { const float* ba = b_gate + col + bj * 128; const f32x4 bB0 = *(const f32x4*)(ba + 1024), bB1 = *(const f32x4*)(ba + 1028);
#pragma unroll
            for (int ai = 0; ai < 2; ++ai) { u32x4 gb[4];
#pragma unroll
                for (int m = 0; m < 4; ++m) gb[m] = *(const u32x4*)(base + (size_t)(ai * 128 + m * 16) * PJ + bj * 128 + 1024);
                __builtin_amdgcn_sched_barrier(0);
#pragma unroll
                for (int m = 0; m < 4; ++m) { float sb[8];
                    sb[0] = sigmoidf_(bflo(gb[m].x) + bB0[0]); sb[1] = sigmoidf_(bfhi(gb[m].x) + bB0[1]); sb[2] = sigmoidf_(bflo(gb[m].y) + bB0[2]); sb[3] = sigmoidf_(bfhi(gb[m].y) + bB0[3]);
                    sb[4] = sigmoidf_(bflo(gb[m].z) + bB1[0]); sb[5] = sigmoidf_(bfhi(gb[m].z) + bB1[1]); sb[6] = sigmoidf_(bflo(gb[m].w) + bB1[2]); sb[7] = sigmoidf_(bfhi(gb[m].w) + bB1[3]);
                    const f32x4 v0 = acc[ai][bj][m][0], v1 = acc[ai][bj][m][1];
                    u32x4 w; w.x = cvt_pk_bf16(v0[0] * sb[0], v0[1] * sb[1]); w.y = cvt_pk_bf16(v0[2] * sb[2], v0[3] * sb[3]); w.z = cvt_pk_bf16(v1[0] * sb[4], v1[1] * sb[5]); w.w = cvt_pk_bf16(v1[2] * sb[6], v1[3] * sb[7]);
                    if (!nostore) *(u32x4*)(base + (size_t)(ai * 128 + m * 16) * PJ + bj * 128) = w; } } }
        return false;
    }
};
struct Ptr3 { const char* proj; const char* BO;
    __device__ const char* aptr(const Unit& u) const { return proj + ((size_t)u.pm * 256 * PJ + PC_GA) * 2; }
    __device__ const char* bptr(const Unit& u) const { return BO + (size_t)u.pn * 256 * D * 2; } };
struct Epi3 {
    static constexpr bool PERM = false, AFTER_DRAIN = true;
    const float* xp; const float* ada; const float* fw; float* out; float* xbuf; unsigned* cnt;
    __device__ __forceinline__ bool operator()(f32x4 (&acc)[2][2][4][2], const Unit& u, int wr, int wc, int fr, int fq) const { return false; }
    __device__ __forceinline__ void fused(f32x4 (&acc)[2][2][4][2], const Unit& u, int wr, int wc, int fr, int fq, LAS unsigned char* lds, int wid, int lane) const {
        asm volatile("" : "+v"(fr), "+v"(fq));
        LAS float* P = (LAS float*)lds; LAS float* S = (LAS float*)(lds + 4096);
        const int row0 = u.pm * 256 + wr * 64 + fr, col0 = u.pn * 256 + wc * 32 + 4 * fq;
        f32x4 gt[4];
#pragma unroll
        for (int q = 0; q < 4; ++q) gt[q] = *(const f32x4*)(ada + 2048 + col0 + (q >> 1) * 128 + (q & 1) * 16);
#pragma unroll
        for (int ai = 0; ai < 2; ++ai) { f32x4 xv[4][4];
#pragma unroll
            for (int m = 0; m < 4; ++m)
#pragma unroll
                for (int q = 0; q < 4; ++q) xv[m][q] = __builtin_nontemporal_load((const f32x4*)(xp + (size_t)(row0 + ai * 128 + m * 16) * D + col0 + (q >> 1) * 128 + (q & 1) * 16));
            __builtin_amdgcn_sched_barrier(0);
#pragma unroll
            for (int m = 0; m < 4; ++m) { const int lrow = ai * 128 + wr * 64 + m * 16 + fr; float ss = 0.f;
#pragma unroll
                for (int q = 0; q < 4; ++q) { const f32x4 r = xv[m][q] + gt[q] * acc[ai][q >> 1][m][q & 1]; acc[ai][q >> 1][m][q & 1] = r; ss += (r[0] * r[0] + r[1] * r[1]) + (r[2] * r[2] + r[3] * r[3]); }
                ss += __shfl_xor(ss, 16); ss += __shfl_xor(ss, 32);
                if (fq == 0) P[lrow * 4 + wc] = ss; } }
        __syncthreads();
        const int prow = wid * 32 + (lane & 31);
        if (lane < 32) { const f32x4 pp = *(const LAS f32x4*)(P + prow * 4);
            __hip_atomic_store(xbuf + ((size_t)u.pm * 256 + prow) * 4 + u.pn, (pp[0] + pp[1]) + (pp[2] + pp[3]), __ATOMIC_RELAXED, __HIP_MEMORY_SCOPE_AGENT); }
        asm volatile("s_waitcnt vmcnt(0)" ::: "memory");
        if (lane == 0) __hip_atomic_fetch_add(cnt + 64 * u.pm, 1u, __ATOMIC_RELAXED, __HIP_MEMORY_SCOPE_AGENT);
        if (wid == 0) { unsigned sp = 0u;
            while ((unsigned)__builtin_amdgcn_readfirstlane(__hip_atomic_load(cnt + 64 * u.pm, __ATOMIC_RELAXED, __HIP_MEMORY_SCOPE_AGENT)) < 32u) { __builtin_amdgcn_s_sleep(2); if (++sp > (1u << 22)) break; }
            __builtin_amdgcn_fence(__ATOMIC_ACQUIRE, "agent"); }
        asm volatile("s_waitcnt vmcnt(0) lgkmcnt(0)" ::: "memory"); __syncthreads();
        if (lane < 32) { const float* sl = xbuf + ((size_t)u.pm * 256 + prow) * 4; float t = 0.f;
#pragma unroll
            for (int q = 0; q < 4; ++q) t += __hip_atomic_load(sl + q, __ATOMIC_RELAXED, __HIP_MEMORY_SCOPE_AGENT);
            S[prow] = rsqrtf(t * (1.0f / D) + EPS); }
        __syncthreads();
        f32x4 fv[4];
#pragma unroll
        for (int q = 0; q < 4; ++q) fv[q] = *(const f32x4*)(fw + col0 + (q >> 1) * 128 + (q & 1) * 16);
#pragma unroll
        for (int ai = 0; ai < 2; ++ai)
#pragma unroll
            for (int m = 0; m < 4; ++m) { const int row = row0 + ai * 128 + m * 16, lrow = ai * 128 + wr * 64 + m * 16 + fr; const float rs = S[lrow]; float* orow = out + (size_t)row * D + col0;
#pragma unroll
                for (int q = 0; q < 4; ++q) __builtin_nontemporal_store(acc[ai][q >> 1][m][q & 1] * rs * fv[q], (f32x4*)(orow + (q >> 1) * 128 + (q & 1) * 16)); }
    }
};
template <int AM, int BN>
__device__ __forceinline__ void wave_gemm(const bf16_t* const (&Ar)[AM], int lda, const bf16_t* const (&Br)[BN], int ldb, int K, int lane, f32x4 (&acc)[AM][BN]) {
    const bf16_t* a[AM]; const bf16_t* b[BN];
#pragma unroll
    for (int i = 0; i < AM; ++i) a[i] = Ar[i] + (size_t)(lane & 15) * lda + 8 * (lane >> 4);
#pragma unroll
    for (int i = 0; i < BN; ++i) b[i] = Br[i] + (size_t)(lane & 15) * ldb + 8 * (lane >> 4);
    constexpr int KB = (AM + BN) >= 4 ? 8 : 16;
    for (int k0 = 0; k0 < K; k0 += 32 * KB) { bf16x8 fa[KB][AM], fb[KB][BN];
#pragma unroll
        for (int s = 0; s < KB; ++s) {
#pragma unroll
            for (int i = 0; i < AM; ++i) fa[s][i] = *(const bf16x8*)(a[i] + k0 + 32 * s);
#pragma unroll
            for (int i = 0; i < BN; ++i) fb[s][i] = *(const bf16x8*)(b[i] + k0 + 32 * s); }
        __builtin_amdgcn_sched_barrier(0);
#pragma unroll
        for (int s = 0; s < KB; ++s)
#pragma unroll
            for (int i = 0; i < AM; ++i)
#pragma unroll
                for (int j = 0; j < BN; ++j) acc[i][j] = MFMA16(fb[s][j], fa[s][i], acc[i][j]); }
}
__device__ __forceinline__ void sample_gemm1(const Params& p, LAS unsigned char* lds, int bid) {
    int tid_ = threadIdx.x; asm volatile("" : "+v"(tid_)); const int tid = tid_, lane = tid & 63, w = tid >> 6, g4 = lane >> 4, l15 = lane & 15;
    const bf16_t* H = (const bf16_t*)((const unsigned char*)p.out + RB_H); const bf16_t* bt1 = (const bf16_t*)((const unsigned char*)p.out + RB_BT1); bf16_t* proj = (bf16_t*)(p.ws + WS_PROJ);
    constexpr int RS = 528, LB = 256 * RS;
    int b0, b1, ocol; const bool uz = bid >= 96 && bid < 160;
    if (bid < 96) { b0 = 32 * bid; b1 = b0 + 16; ocol = 32 * bid; }
    else if (uz) { const int j = bid - 96; b0 = 3072 + (j >> 3) * 256 + (j & 7) * 16; b1 = b0 + 128; ocol = PC_UZ + 16 * j; }
    else { b0 = 5120 + 32 * (bid - 160); b1 = b0 + 16; ocol = PC_GV + 32 * (bid - 160); }
    u32x4 ra[16], rb[2];
    const int pr = tid >> 5, pc = tid & 31;
    const bf16_t* ag = H + (size_t)(SEQ + pr) * D + pc * 8;
    const bf16_t* bg0 = bt1 + (size_t)(b0 + pr) * D + pc * 8; const bf16_t* bg1 = bt1 + (size_t)(b1 + pr) * D + pc * 8;
#pragma unroll
    for (int i = 0; i < 16; ++i) ra[i] = *(const u32x4*)(ag + (size_t)i * 16 * D);
    rb[0] = *(const u32x4*)bg0; rb[1] = *(const u32x4*)bg1;
    f32x4 acc[2][2];
#pragma unroll
    for (int i = 0; i < 2; ++i)
#pragma unroll
        for (int j = 0; j < 2; ++j) acc[i][j] = (f32x4){0.f, 0.f, 0.f, 0.f};
    for (int kc = 0; kc < 4; ++kc) {
#pragma unroll
        for (int i = 0; i < 16; ++i) *(LAS u32x4*)(lds + (pr + 16 * i) * RS + pc * 16) = ra[i];
        *(LAS u32x4*)(lds + LB + pr * RS + pc * 16) = rb[0]; *(LAS u32x4*)(lds + LB + (16 + pr) * RS + pc * 16) = rb[1];
        __syncthreads();
        if (kc + 1 < 4) { int ko = (kc + 1) * 256; asm volatile("" : "+v"(ko));
#pragma unroll
            for (int i = 0; i < 16; ++i) ra[i] = *(const u32x4*)(ag + (size_t)i * 16 * D + ko);
            rb[0] = *(const u32x4*)(bg0 + ko); rb[1] = *(const u32x4*)(bg1 + ko); }
#pragma unroll
        for (int ks = 0; ks < 8; ++ks) { bf16x8 fa[2], fb[2];
#pragma unroll
            for (int i = 0; i < 2; ++i) { fa[i] = row_frag(lds + (32 * w + 16 * i) * RS + ks * 64, RS, lane); fb[i] = row_frag(lds + LB + 16 * i * RS + ks * 64, RS, lane); }
#pragma unroll
            for (int i = 0; i < 2; ++i)
#pragma unroll
                for (int j = 0; j < 2; ++j) acc[i][j] = MFMA16(fb[j], fa[i], acc[i][j]); }
        __syncthreads();
    }
    const int r0 = SEQ + 32 * w;
#pragma unroll
    for (int i = 0; i < 2; ++i) { bf16_t* rp = proj + (size_t)(r0 + 16 * i + l15) * PJ + ocol + 4 * g4;
        if (uz) { const f32x4 u = acc[i][0], z = acc[i][1]; u32x2 pk; pk.x = cvt_pk_bf16(u[0] * siluf_(z[0]), u[1] * siluf_(z[1])); pk.y = cvt_pk_bf16(u[2] * siluf_(z[2]), u[3] * siluf_(z[3])); *(u32x2*)rp = pk; }
        else {
#pragma unroll
            for (int j = 0; j < 2; ++j) { u32x2 pk; pk.x = cvt_pk_bf16(acc[i][j][0], acc[i][j][1]); pk.y = cvt_pk_bf16(acc[i][j][2], acc[i][j][3]); *(u32x2*)(rp + 16 * j) = pk; } } }
}
__device__ __forceinline__ void sample_gemm2(const Params& p, int bid, bool nostore) {
    int tid_ = threadIdx.x; asm volatile("" : "+v"(tid_)); const int lane = tid_ & 63, w = tid_ >> 6, g4 = lane >> 4, l15 = lane & 15;
    if (w >= 4) return;
    bf16_t* proj = (bf16_t*)(p.ws + WS_PROJ); const bf16_t* bta = (const bf16_t*)(p.ws + WS_BTA); const bf16_t* btb = (const bf16_t*)(p.ws + WS_BTB);
    const int tile = bid * 4 + w, rt = tile >> 6, ct = tile & 63, r0 = SEQ + 16 * rt, c0 = 16 * ct;
    f32x4 aa[1][1], ab[1][1]; aa[0][0] = (f32x4){0.f, 0.f, 0.f, 0.f}; ab[0][0] = aa[0][0];
    { const bf16_t* const Ar[1] = {proj + (size_t)r0 * PJ + PC_R}; const bf16_t* const Br[1] = {bta + (size_t)c0 * D}; wave_gemm<1, 1>(Ar, PJ, Br, D, D, lane, aa); }
    { const bf16_t* const Ar[1] = {proj + (size_t)r0 * PJ + PC_UZ}; const bf16_t* const Br[1] = {btb + (size_t)c0 * D}; wave_gemm<1, 1>(Ar, PJ, Br, D, D, lane, ab); }
    bf16_t* rp = proj + (size_t)(r0 + l15) * PJ + PC_GA + c0 + 4 * g4; const u32x2 ga = *(const u32x2*)rp, gb = *(const u32x2*)(rp + 1024);
    const f32x4 bA = *(const f32x4*)(p.b_gate + c0 + 4 * g4), bB = *(const f32x4*)(p.b_gate + 1024 + c0 + 4 * g4);
    float o[4];
    o[0] = sigmoidf_(bflo(ga.x) + bA[0]) * aa[0][0][0] + sigmoidf_(bflo(gb.x) + bB[0]) * ab[0][0][0]; o[1] = sigmoidf_(bfhi(ga.x) + bA[1]) * aa[0][0][1] + sigmoidf_(bfhi(gb.x) + bB[1]) * ab[0][0][1];
    o[2] = sigmoidf_(bflo(ga.y) + bA[2]) * aa[0][0][2] + sigmoidf_(bflo(gb.y) + bB[2]) * ab[0][0][2]; o[3] = sigmoidf_(bfhi(ga.y) + bA[3]) * aa[0][0][3] + sigmoidf_(bfhi(gb.y) + bB[3]) * ab[0][0][3];
    u32x2 pk; pk.x = cvt_pk_bf16(o[0], o[1]); pk.y = cvt_pk_bf16(o[2], o[3]); if (!nostore) *(u32x2*)rp = pk;
}
__device__ __forceinline__ void sample_gemm3(const Params& p, int bid) {
    int tid_ = threadIdx.x; asm volatile("" : "+v"(tid_)); const int lane = tid_ & 63, w = tid_ >> 6, g4 = lane >> 4, l15 = lane & 15;
    if (w >= 4) return;
    const bf16_t* proj = (const bf16_t*)(p.ws + WS_PROJ); const bf16_t* bto = (const bf16_t*)(p.ws + WS_BTO); const float* ada = (const float*)(p.ws + WS_ADA);
    const int tile = bid * 4 + w, rt = tile >> 6, ct = tile & 63, c0 = 16 * ct + 4 * g4, rs = 16 * rt + l15;
    f32x4 acc[1][1]; acc[0][0] = (f32x4){0.f, 0.f, 0.f, 0.f};
    { const bf16_t* const Ar[1] = {proj + (size_t)(SEQ + 16 * rt) * PJ + PC_GA}; const bf16_t* const Br[1] = {bto + (size_t)16 * ct * D}; wave_gemm<1, 1>(Ar, PJ, Br, D, D, lane, acc); }
    const f32x4 xv = *(const f32x4*)(p.x_sample + (size_t)rs * D + c0), gt = *(const f32x4*)(ada + (1 + rt) * 3072 + 2048 + c0);
    *(f32x4*)(p.out + OUT_YS + (size_t)rs * D + c0) = xv + gt * acc[0][0];
}

__device__ __forceinline__ void transpose_tile(LAS unsigned char* lds, const float* src, int ldsrc, int scol0, int nvalid, float scale, bf16_t* dst, int ldd, int n0, int k0) {
    int tid_ = threadIdx.x; asm volatile("" : "+v"(tid_)); const int tid = tid_;
    f32x4 v[8];
#pragma unroll
    for (int i = 0; i < 8; ++i) { const int e = tid + 512 * i, k = e >> 4, n4 = (e & 15) * 4; f32x4 t = (f32x4){0.f, 0.f, 0.f, 0.f};
        if (n4 < nvalid) t = __builtin_nontemporal_load((const f32x4*)(src + (size_t)(k0 + k) * ldsrc + scol0 + n4));
        v[i] = t; }
#pragma unroll
    for (int i = 0; i < 8; ++i) { const int e = tid + 512 * i, k = e >> 4, n4 = (e & 15) * 4, m = (e & 15) & 7;
        const f32x4 t = v[i];
        *(LAS bf16_t*)(lds + (n4 + 0) * 528 + (((k >> 3) ^ m) << 4) + (k & 7) * 2) = f2bf(t[0] * scale);
        *(LAS bf16_t*)(lds + (n4 + 1) * 528 + (((k >> 3) ^ m) << 4) + (k & 7) * 2) = f2bf(t[1] * scale);
        *(LAS bf16_t*)(lds + (n4 + 2) * 528 + (((k >> 3) ^ m) << 4) + (k & 7) * 2) = f2bf(t[2] * scale);
        *(LAS bf16_t*)(lds + (n4 + 3) * 528 + (((k >> 3) ^ m) << 4) + (k & 7) * 2) = f2bf(t[3] * scale); }
    __syncthreads();
#pragma unroll
    for (int i = 0; i < 4; ++i) { const int e = tid + 512 * i, n = e >> 5, kc = e & 31; const u32x4 w = *(const LAS u32x4*)(lds + n * 528 + ((kc ^ ((n >> 2) & 7)) << 4));
        *(u32x4*)(dst + (size_t)(n0 + n) * ldd + k0 + kc * 8) = w; }
    __syncthreads();
}
__device__ __forceinline__ void ada_item(const Params& p, LAS unsigned char* lds, int slab) {
    int tid_ = threadIdx.x; asm volatile("" : "+v"(tid_)); const int tid = tid_; float* ada = (float*)(p.ws + WS_ADA);
    LAS float* sc = (LAS float*)lds;
    LAS float* red = (LAS float*)(lds + 17 * 1024 * 4);
    for (int i = tid; i < 17 * 1024; i += 512) { const int b = i >> 10, k = i & 1023; const float c = b == 0 ? p.c_prompt[k] : p.c_sample[(b - 1) * 1024 + k]; sc[i] = siluf_(c); }
    __syncthreads();
    const int nl = tid & 31, kg = tid >> 5, n = slab * 32 + nl;
    float a[17];
#pragma unroll
    for (int b = 0; b < 17; ++b) a[b] = 0.f;
    for (int k16 = 0; k16 < 4; ++k16) { float w[16]; const float* wp = p.w_ada + (size_t)(kg * 64 + k16 * 16) * 3072 + n;
#pragma unroll
        for (int i = 0; i < 16; ++i) w[i] = wp[(size_t)i * 3072];
        __builtin_amdgcn_sched_barrier(0);
#pragma unroll
        for (int k4 = 0; k4 < 4; ++k4) { const int k = kg * 64 + k16 * 16 + k4 * 4;
#pragma unroll
            for (int b = 0; b < 17; ++b) { const f32x4 s = *(const LAS f32x4*)(sc + b * 1024 + k); a[b] += s[0] * w[k4 * 4] + s[1] * w[k4 * 4 + 1] + s[2] * w[k4 * 4 + 2] + s[3] * w[k4 * 4 + 3]; } } }
#pragma unroll
    for (int b = 0; b < 17; ++b) red[(kg * 17 + b) * 32 + nl] = a[b];
    __syncthreads();
    for (int i = tid; i < 17 * 32; i += 512) { const int b = i >> 5, c = i & 31; float s = p.b_ada[slab * 32 + c];
#pragma unroll
        for (int g = 0; g < 16; ++g) s += red[(g * 17 + b) * 32 + c];
        ada[b * 3072 + slab * 32 + c] = s; }
    __syncthreads();
}
__device__ __forceinline__ void phase0(const Params& p, LAS unsigned char* lds) {
    bf16_t* bt1 = (bf16_t*)((unsigned char*)p.out + RB_BT1); bf16_t* bta = (bf16_t*)(p.ws + WS_BTA); bf16_t* btb = (bf16_t*)(p.ws + WS_BTB); bf16_t* bto = (bf16_t*)(p.ws + WS_BTO);
    constexpr int N_ADA = 96, N_T1 = (N1 / 64) * 4, N_TS = 64;
    int bid_ = blockIdx.x; asm volatile("" : "+s"(bid_)); const int bid = bid_;
    for (int it = bid; it < N_ADA + N_T1 + 3 * N_TS; it += gridDim.x) {
        if (it < N_ADA) { ada_item(p, lds, it); continue; }
        int j = it - N_ADA;
        if (j < N_T1) { const int nt = j >> 2, kt = j & 3, n0 = nt * 64; int sc0, nv = 64;
            if (n0 < 3072) sc0 = n0;
            else if (n0 < 5120) { const int t = (n0 - 3072) >> 8, w = (n0 - 3072) & 255; sc0 = w < 128 ? 3088 + t * 128 + w : 5136 + t * 128 + (w - 128); }
            else if (n0 < 6144) sc0 = 4112 + (n0 - 5120);
            else if (n0 < 7168) sc0 = 6160 + (n0 - 6144);
            else if (n0 < 8192) sc0 = 7184 + (n0 - 7168);
            else { sc0 = 3072; nv = 16; }
            transpose_tile(lds, p.w_in, WIN_LD, sc0, nv, n0 < 512 ? 0.08838834764831845f : 1.0f, bt1, D, n0, kt * 256); continue; }
        j -= N_T1;
        const int which = j >> 6, nt = (j & 63) >> 2, kt = j & 3;
        if (which == 0) transpose_tile(lds, p.w_proj_a, D, nt * 64, 64, 1.0f, bta, D, nt * 64, kt * 256);
        else if (which == 1) transpose_tile(lds, p.w_proj_b, D, nt * 64, 64, 1.0f, btb, D, nt * 64, kt * 256);
        else transpose_tile(lds, p.w_out, D, nt * 64, 64, 1.0f, bto, D, nt * 64, kt * 256);
    }
}
__device__ __forceinline__ void phase1(const Params& p) {
    int tid_ = threadIdx.x; asm volatile("" : "+v"(tid_)); const int tid = tid_; int bid_ = blockIdx.x; asm volatile("" : "+s"(bid_)); const int bid = bid_;
    const int lane = tid & 63, wv = tid >> 6, l15 = lane & 15, g4 = lane >> 4; const float* ada = (const float*)(p.ws + WS_ADA); bf16_t* H = (bf16_t*)((unsigned char*)p.out + RB_H);
#pragma unroll 2
    for (int row = bid * 8 + wv; row < MTOT; row += gridDim.x * 8) {
        const float* xr = row < SEQ ? p.x_prompt + (size_t)row * D : p.x_sample + (size_t)(row - SEQ) * D; const int b = row < SEQ ? 0 : 1 + ((row - SEQ) >> 4);
        f32x4 v[4]; float ss = 0.f;
#pragma unroll
        for (int i = 0; i < 4; ++i) { v[i] = __builtin_nontemporal_load((const f32x4*)(xr + i * 256 + lane * 4)); ss += (v[i][0] * v[i][0] + v[i][1] * v[i][1]) + (v[i][2] * v[i][2] + v[i][3] * v[i][3]); }
        ss = wave_sum(ss); const float rstd = rsqrtf(ss * (1.0f / D) + EPS);
#pragma unroll
        for (int i = 0; i < 4; ++i) { const int c = i * 256 + lane * 4; const f32x4 nw = *(const f32x4*)(p.norm_w + c), sh = *(const f32x4*)(ada + b * 3072 + c), scl = *(const f32x4*)(ada + b * 3072 + 1024 + c);
            const f32x4 h = v[i] * rstd * nw * (scl + 1.0f) + sh; u32x2 w; w.x = cvt_pk_bf16(h[0], h[1]); w.y = cvt_pk_bf16(h[2], h[3]); *(u32x2*)(H + (size_t)row * D + c) = w; }
    }
    asm volatile("s_waitcnt vmcnt(0)" ::: "memory");
    __syncthreads();
    float* alr = (float*)(p.ws + WS_ALR);
    const bf16_t* w16 = (const bf16_t*)((const unsigned char*)p.out + RB_BT1) + (size_t)(8192 + l15) * D + 8 * g4;
    for (int gi = wv; bid * 8 + 2048 * gi < MTOT; gi += 8) { const int r0 = bid * 8 + 2048 * gi;
        f32x4 acc = (f32x4){0.f, 0.f, 0.f, 0.f};
        const bf16_t* ap = H + (size_t)(r0 + (l15 & 7)) * D + 8 * g4;
#pragma unroll
        for (int kb = 0; kb < 2; ++kb) { bf16x8 fa[16], fb[16];
#pragma unroll
            for (int s = 0; s < 16; ++s) { fa[s] = *(const bf16x8*)(ap + (kb * 16 + s) * 32); fb[s] = *(const bf16x8*)(w16 + (kb * 16 + s) * 32); }
#pragma unroll
            for (int s = 0; s < 16; ++s) acc = MFMA16(fb[s], fa[s], acc); }
        if (l15 < 8) *(f32x4*)(alr + (size_t)(r0 + l15) * 16 + 4 * g4) = acc; }
}
__device__ __forceinline__ void gla_prep(const Params& p, LAS unsigned char* lds, int tokbase, int nchunk, int nvalid, int h, int chunk0, bool tolds, int ldsK, int ldsDV) {
    int tid_ = threadIdx.x; asm volatile("" : "+v"(tid_)); const int tid = tid_, kap = tid & 127; const int c = __builtin_amdgcn_readfirstlane(tid >> 7);
    bf16_t* proj = (bf16_t*)(p.ws + WS_PROJ); const float* alr = (const float*)(p.ws + WS_ALR); float* dch = (float*)(p.ws + WS_DCH);
    if (c < nchunk) {
        float w2[16];
#pragma unroll
        for (int j = 0; j < 16; ++j) w2[j] = p.w_a2[j * 512 + h * 128 + kap];
        const float ba = p.b_a[h * 128 + kap];
        const int tok0 = tokbase + 64 * c; float run = 0.f;
        bf16_t* kp = proj + (size_t)tok0 * PJ + PC_K + h * 128 + kap; bf16_t* qp = proj + (size_t)tok0 * PJ + PC_Q + h * 128 + kap;
        const float* ar0 = alr + (size_t)tok0 * 16;
#pragma unroll 8
        for (int t = 0; t < nvalid; ++t) { const float* ar = ar0 + t * 16; float x = ba;
#pragma unroll
            for (int j = 0; j < 16; ++j) x += ar[j] * w2[j];
            const float la = -(fmaxf(-x, 0.f) + __logf(1.0f + __expf(-fabsf(x)))) * 0.0625f; run += la;
            const float kk = bf2f(kp[(size_t)t * PJ]), qq = bf2f(qp[(size_t)t * PJ]);
            const bf16_t kt = f2bf(kk * __expf(-run)); kp[(size_t)t * PJ] = kt; qp[(size_t)t * PJ] = f2bf(qq * __expf(run));
            if (tolds) *(LAS bf16_t*)(lds + ldsK + (64 * c + t) * 272 + kap * 2) = kt; }
        const float d = __expf(run); dch[((chunk0 + c) * 4 + h) * 128 + kap] = d; if (tolds) *(LAS float*)(lds + ldsDV + (c * 128 + kap) * 4) = d;
    }
}
constexpr int LA_K = 0, LA_V0 = 69632, LA_V1 = 103424, LA_DV = 137216;
constexpr int RS_QK = 272, RS_V = 528, RS_P = 144, RS_S = 272;
__device__ __forceinline__ void gla_segA(const Params& p, LAS unsigned char* lds, int seg, int h) {
    int tid_ = threadIdx.x; asm volatile("" : "+v"(tid_));
    const int tid = tid_, lane = tid & 63, w = tid >> 6, g4 = lane >> 4, l15 = lane & 15;
    const bf16_t* proj = (const bf16_t*)(p.ws + WS_PROJ); const int tokbase = seg * (SEGCH * 64);
    u32x4 vr[4];
#pragma unroll
    for (int i = 0; i < 4; ++i) { const int e = tid + 512 * i, r = e >> 5, c = e & 31; vr[i] = *(const u32x4*)(proj + (size_t)(tokbase + r) * PJ + PC_V + h * 256 + c * 8); }
    gla_prep(p, lds, tokbase, SEGCH, 64, h, seg * SEGCH, true, LA_K, LA_DV);
#pragma unroll
    for (int i = 0; i < 4; ++i) { const int e = tid + 512 * i, r = e >> 5, c = e & 31; *(LAS u32x4*)(lds + LA_V0 + r * RS_V + c * 16) = vr[i]; }
    __syncthreads();
    f32x4 acc[8][2];
#pragma unroll
    for (int kt = 0; kt < 8; ++kt)
#pragma unroll
        for (int j2 = 0; j2 < 2; ++j2) acc[kt][j2] = (f32x4){0.f, 0.f, 0.f, 0.f};
    for (int ch = 0; ch < SEGCH; ++ch) {
        int tok1 = tokbase + (ch + 1) * 64; asm volatile("" : "+v"(tok1));
        const int vb = (ch & 1) ? LA_V1 : LA_V0, vn = (ch & 1) ? LA_V0 : LA_V1;
        if (ch + 1 < SEGCH) {
#pragma unroll
            for (int i = 0; i < 4; ++i) { const int e = tid + 512 * i, r = e >> 5, c = e & 31; vr[i] = *(const u32x4*)(proj + (size_t)(tok1 + r) * PJ + PC_V + h * 256 + c * 8); } }
#pragma unroll
        for (int ks = 0; ks < 2; ++ks) { bf16x8 Bv[2];
#pragma unroll
            for (int j2 = 0; j2 < 2; ++j2) Bv[j2] = tr_frag(lds + vb + 32 * ks * RS_V + (32 * w + 16 * j2) * 2, RS_V, lane);
#pragma unroll
            for (int kt = 0; kt < 8; ++kt) { const bf16x8 Ak = tr_frag(lds + LA_K + (64 * ch + 32 * ks) * RS_QK + 16 * kt * 2, RS_QK, lane);
#pragma unroll
                for (int j2 = 0; j2 < 2; ++j2) acc[kt][j2] = MFMA16(Ak, Bv[j2], acc[kt][j2]); } }
#pragma unroll
        for (int kt = 0; kt < 8; ++kt) { const f32x4 d = *(const LAS f32x4*)(lds + LA_DV + (ch * 128 + 16 * kt + 4 * g4) * 4);
#pragma unroll
            for (int j2 = 0; j2 < 2; ++j2) acc[kt][j2] = acc[kt][j2] * d; }
        if (ch + 1 < SEGCH) {
#pragma unroll
            for (int i = 0; i < 4; ++i) { const int e = tid + 512 * i, r = e >> 5, c = e & 31; *(LAS u32x4*)(lds + vn + r * RS_V + c * 16) = vr[i]; } }
        __syncthreads();
    }
    bf16_t* us = (bf16_t*)((unsigned char*)p.out + RB_USEG) + ((size_t)(seg * 4 + h) * 256) * 128;
#pragma unroll
    for (int kt = 0; kt < 8; ++kt)
#pragma unroll
        for (int j2 = 0; j2 < 2; ++j2) { u32x2 pk; pk.x = cvt_pk_bf16(acc[kt][j2][0], acc[kt][j2][1]); pk.y = cvt_pk_bf16(acc[kt][j2][2], acc[kt][j2][3]);
            *(u32x2*)(us + (size_t)(32 * w + 16 * j2 + l15) * 128 + 16 * kt + 4 * g4) = pk; }
    if (tid < 128) { float d = 1.f;
#pragma unroll
        for (int c = 0; c < 4; ++c) d *= *(const LAS float*)(lds + LA_DV + (c * 128 + tid) * 4);
        ((float*)(p.ws + WS_DSEG))[(seg * 4 + h) * 128 + tid] = d; }
    __syncthreads();
}
constexpr int L_DV = 6144, L_RED = 6656, L_Q = 8704, L_K = 26112, L_V = 43520, L_P = 77312, L_S = 86528;
__device__ __forceinline__ void gla_out(const Params& p, LAS unsigned char* lds, int sample, int idx  , int h, bool nostore) {
    int tid_ = threadIdx.x; asm volatile("" : "+v"(tid_));
    const int tid = tid_, lane = tid & 63, w = tid >> 6, g4 = lane >> 4, l15 = lane & 15;
    bf16_t* proj = (bf16_t*)(p.ws + WS_PROJ); const float* dch = (const float*)(p.ws + WS_DCH);
    const int nchunk = sample ? 1 : SEGCH, nvalid = sample ? SAMP_T : 64, tokbase = sample ? SEQ + idx * SAMP_T : idx * (SEGCH * 64), chunk0 = sample ? 256 + idx : idx * SEGCH;
    f32x4 acc[8][2];
    if (!sample) { const bf16_t* ss = (const bf16_t*)((unsigned char*)p.out + RB_SSTART) + ((size_t)(idx * 4 + h) * 256) * 128;
#pragma unroll
        for (int kt = 0; kt < 8; ++kt)
#pragma unroll
            for (int j2 = 0; j2 < 2; ++j2) { const u32x2 pk = *(const u32x2*)(ss + (size_t)(32 * w + 16 * j2 + l15) * 128 + 16 * kt + 4 * g4);
                acc[kt][j2] = (f32x4){bflo(pk.x), bfhi(pk.x), bflo(pk.y), bfhi(pk.y)}; }
    } else { const float* s0 = p.state_gla + (size_t)(idx * 4 + h) * 128 * 256;
#pragma unroll
        for (int kt = 0; kt < 8; ++kt)
#pragma unroll
            for (int j2 = 0; j2 < 2; ++j2)
#pragma unroll
                for (int r = 0; r < 4; ++r) acc[kt][j2][r] = s0[(size_t)(16 * kt + 4 * g4 + r) * 256 + 32 * w + 16 * j2 + l15];
    }
    if (tid < 128) {
#pragma unroll
        for (int c = 0; c < SEGCH; ++c) if (c < nchunk) *(LAS float*)(lds + (c * 128 + tid) * 4) = dch[((chunk0 + c) * 4 + h) * 128 + tid]; }
    u32x4 rq[2], rk[2], rv[4];
#define GLA_LOAD_TILES(T0) do { \
        _Pragma("unroll") for (int i = 0; i < 2; ++i) { const int e = tid + 512 * i, r = e >> 4, c = e & 15; const bool ok = r < nvalid; const bf16_t* bp = proj + (size_t)((T0) + r) * PJ + h * 128 + c * 8; \
            rq[i] = ok ? __builtin_nontemporal_load((const u32x4*)(bp + PC_Q)) : (u32x4){0u, 0u, 0u, 0u}; rk[i] = ok ? __builtin_nontemporal_load((const u32x4*)(bp + PC_K)) : (u32x4){0u, 0u, 0u, 0u}; } \
        _Pragma("unroll") for (int i = 0; i < 4; ++i) { const int e = tid + 512 * i, r = e >> 5, c = e & 31; \
            rv[i] = (r < nvalid) ? __builtin_nontemporal_load((const u32x4*)(proj + (size_t)((T0) + r) * PJ + PC_V + h * 256 + c * 8)) : (u32x4){0u, 0u, 0u, 0u}; } } while (0)
    GLA_LOAD_TILES(tokbase);
    for (int ch = 0; ch < nchunk; ++ch) {
        int tok0 = tokbase + ch * 64; asm volatile("" : "+v"(tok0));
#pragma unroll
        for (int i = 0; i < 2; ++i) { const int e = tid + 512 * i, r = e >> 4, c = e & 15; *(LAS u32x4*)(lds + L_Q + r * RS_QK + c * 16) = rq[i]; *(LAS u32x4*)(lds + L_K + r * RS_QK + c * 16) = rk[i]; }
#pragma unroll
        for (int i = 0; i < 4; ++i) { const int e = tid + 512 * i, r = e >> 5, c = e & 31; *(LAS u32x4*)(lds + L_V + r * RS_V + c * 16) = rv[i]; }
#pragma unroll
        for (int kt = 0; kt < 8; ++kt)
#pragma unroll
            for (int j2 = 0; j2 < 2; ++j2) { u32x2 pk; pk.x = cvt_pk_bf16(acc[kt][j2][0], acc[kt][j2][1]); pk.y = cvt_pk_bf16(acc[kt][j2][2], acc[kt][j2][3]);
                *(LAS u32x2*)(lds + L_S + (32 * w + 16 * j2 + l15) * RS_S + (16 * kt + 4 * g4) * 2) = pk; }
        __syncthreads();
        if (ch + 1 < nchunk) { const int tok1 = tok0 + 64; GLA_LOAD_TILES(tok1); }
#pragma unroll
        for (int e = 0; e < 2; ++e) { const int tile = 2 * w + e, st = tile >> 2, tt = tile & 3; f32x4 ap = (f32x4){0.f, 0.f, 0.f, 0.f};
            if (st <= tt) {
#pragma unroll
                for (int ks = 0; ks < 4; ++ks) { const bf16x8 A = row_frag(lds + L_K + 16 * st * RS_QK + ks * 64, RS_QK, lane), B = row_frag(lds + L_Q + 16 * tt * RS_QK + ks * 64, RS_QK, lane); ap = MFMA16(A, B, ap); } }
            const int t = 16 * tt + l15, s0 = 16 * st + 4 * g4;
            u32x2 pk; pk.x = cvt_pk_bf16(s0 <= t ? ap[0] : 0.f, s0 + 1 <= t ? ap[1] : 0.f); pk.y = cvt_pk_bf16(s0 + 2 <= t ? ap[2] : 0.f, s0 + 3 <= t ? ap[3] : 0.f);
            *(LAS u32x2*)(lds + L_P + t * RS_P + s0 * 2) = pk; }
        __syncthreads();
        u32x2 rrv[4][2];
#pragma unroll
        for (int tt = 0; tt < 4; ++tt)
#pragma unroll
            for (int j2 = 0; j2 < 2; ++j2) rrv[tt][j2] = (16 * tt + l15 < nvalid) ? *(const u32x2*)(proj + (size_t)(tok0 + 16 * tt + l15) * PJ + PC_R + h * 256 + 32 * w + 16 * j2 + 4 * g4) : (u32x2){0u, 0u};
        f32x4 ao[2][4];
#pragma unroll
        for (int j2 = 0; j2 < 2; ++j2)
#pragma unroll
            for (int tt = 0; tt < 4; ++tt) ao[j2][tt] = (f32x4){0.f, 0.f, 0.f, 0.f};
#pragma unroll
        for (int ks = 0; ks < 2; ++ks) { bf16x8 Av[2];
#pragma unroll
            for (int j2 = 0; j2 < 2; ++j2) Av[j2] = tr_frag(lds + L_V + 32 * ks * RS_V + (32 * w + 16 * j2) * 2, RS_V, lane);
#pragma unroll
            for (int tt = 0; tt < 4; ++tt) { const bf16x8 Bp = row_frag(lds + L_P + 16 * tt * RS_P + ks * 64, RS_P, lane);
#pragma unroll
                for (int j2 = 0; j2 < 2; ++j2) ao[j2][tt] = MFMA16(Av[j2], Bp, ao[j2][tt]); } }
#pragma unroll
        for (int ks = 0; ks < 4; ++ks) { bf16x8 As[2];
#pragma unroll
            for (int j2 = 0; j2 < 2; ++j2) As[j2] = row_frag(lds + L_S + (32 * w + 16 * j2) * RS_S + ks * 64, RS_S, lane);
#pragma unroll
            for (int tt = 0; tt < 4; ++tt) { const bf16x8 Bq = row_frag(lds + L_Q + 16 * tt * RS_QK + ks * 64, RS_QK, lane);
#pragma unroll
                for (int j2 = 0; j2 < 2; ++j2) ao[j2][tt] = MFMA16(As[j2], Bq, ao[j2][tt]); } }
#pragma unroll
        for (int tt = 0; tt < 4; ++tt) { float ss = 0.f;
#pragma unroll
            for (int j2 = 0; j2 < 2; ++j2) ss += (ao[j2][tt][0] * ao[j2][tt][0] + ao[j2][tt][1] * ao[j2][tt][1]) + (ao[j2][tt][2] * ao[j2][tt][2] + ao[j2][tt][3] * ao[j2][tt][3]);
            ss += __shfl_xor(ss, 16); ss += __shfl_xor(ss, 32);
            if (g4 == 0) *(LAS float*)(lds + L_RED + (w * 64 + 16 * tt + l15) * 4) = ss; }
        __syncthreads();
#pragma unroll
        for (int tt = 0; tt < 4; ++tt) { const int t = 16 * tt + l15; float tot = 0.f;
#pragma unroll
            for (int ww = 0; ww < 8; ++ww) tot += *(const LAS float*)(lds + L_RED + (ww * 64 + t) * 4);
            const float rstd = rsqrtf(tot * (1.0f / 256.0f) + EPS);
            if (t < nvalid && !nostore) {
#pragma unroll
                for (int j2 = 0; j2 < 2; ++j2) { const int v0 = 32 * w + 16 * j2 + 4 * g4; bf16_t* rp = proj + (size_t)(tok0 + t) * PJ + PC_R + h * 256 + v0;
                    const u32x2 rr = rrv[tt][j2]; const f32x4 gn = *(const f32x4*)(p.gla_norm_w + v0); const f32x4 o = ao[j2][tt];
                    u32x2 pk; pk.x = cvt_pk_bf16(o[0] * rstd * gn[0] * siluf_(bflo(rr.x)), o[1] * rstd * gn[1] * siluf_(bfhi(rr.x)));
                    pk.y = cvt_pk_bf16(o[2] * rstd * gn[2] * siluf_(bflo(rr.y)), o[3] * rstd * gn[3] * siluf_(bfhi(rr.y)));
                    *(u32x2*)rp = pk; } } }
#pragma unroll
        for (int ks = 0; ks < 2; ++ks) { bf16x8 Bv[2];
#pragma unroll
            for (int j2 = 0; j2 < 2; ++j2) Bv[j2] = tr_frag(lds + L_V + 32 * ks * RS_V + (32 * w + 16 * j2) * 2, RS_V, lane);
#pragma unroll
            for (int kt = 0; kt < 8; ++kt) { const bf16x8 Ak = tr_frag(lds + L_K + 32 * ks * RS_QK + 16 * kt * 2, RS_QK, lane);
#pragma unroll
                for (int j2 = 0; j2 < 2; ++j2) acc[kt][j2] = MFMA16(Ak, Bv[j2], acc[kt][j2]); } }
#pragma unroll
        for (int kt = 0; kt < 8; ++kt) { const f32x4 d = *(const LAS f32x4*)(lds + (ch * 128 + 16 * kt + 4 * g4) * 4);
#pragma unroll
            for (int j2 = 0; j2 < 2; ++j2) acc[kt][j2] = acc[kt][j2] * d; }
        __syncthreads();
    }
#undef GLA_LOAD_TILES
    if (sample && !nostore) { float* so = p.out + OUT_SS + (size_t)(idx * 4 + h) * 128 * 256;
#pragma unroll
        for (int kt = 0; kt < 8; ++kt)
#pragma unroll
            for (int j2 = 0; j2 < 2; ++j2)
#pragma unroll
                for (int r = 0; r < 4; ++r) so[(size_t)(16 * kt + 4 * g4 + r) * 256 + 32 * w + 16 * j2 + l15] = acc[kt][j2][r];
    }
}
constexpr int G_VN = 0, G_WS = 67584, G_ST = 102400, RS_VN = 528, RS_WS = 272;
__device__ __forceinline__ void gmlp_item(const Params& p, LAS unsigned char* lds, int chunk, int g, bool nostore = false, bool build_ws = true) {
    int tid_ = threadIdx.x; asm volatile("" : "+v"(tid_));
    const int tid = tid_, lane = tid & 63, w = tid >> 6, g4 = lane >> 4, l15 = lane & 15;
    bf16_t* proj = (bf16_t*)(p.ws + WS_PROJ); const int tok0 = chunk * 128;
    u32x4 gvr[8]; u32x2 uzr[8][2];
#pragma unroll
    for (int i = 0; i < 8; ++i) { const int e = tid + 512 * i, r = e >> 5, c = e & 31; gvr[i] = *(const u32x4*)(proj + (size_t)(tok0 + r) * PJ + PC_GV + g * 256 + c * 8); }
#pragma unroll
    for (int it = 0; it < 8; ++it)
#pragma unroll
        for (int j2 = 0; j2 < 2; ++j2) uzr[it][j2] = *(const u32x2*)(proj + (size_t)(tok0 + 16 * it + l15) * PJ + PC_UZ + g * 256 + 32 * w + 16 * j2 + 4 * g4);
    if (tid < 128) { const float* gp = (const float*)(p.ws + WS_GVST) + (size_t)(tok0 + tid) * 32; float s = 0.f, q = 0.f;
#pragma unroll
        for (int k = 0; k < 8; ++k) { const f32x4 v = *(const f32x4*)(gp + 4 * k); s += v[0] + v[2]; q += v[1] + v[3]; }
        const float mean = s * (1.0f / 1024.0f), var = fmaxf(q * (1.0f / 1024.0f) - mean * mean, 0.f);
        *(LAS f32x2*)(lds + G_ST + tid * 8) = (f32x2){mean, rsqrtf(var + EPS)}; }
    if (build_ws)
#pragma unroll
    for (int i = 0; i < 8; ++i) { const int e = tid + 512 * i, r = e >> 5, j4 = (e & 31) * 4; f32x4 v = *(const f32x4*)(p.w_s + (size_t)(g * 128 + r) * 128 + j4);
        if (r < 64 && j4 >= 64) v = (f32x4){0.f, 0.f, 0.f, 0.f};
        u32x2 pk; pk.x = cvt_pk_bf16(v[0], v[1]); pk.y = cvt_pk_bf16(v[2], v[3]); *(LAS u32x2*)(lds + G_WS + r * RS_WS + j4 * 2) = pk; }
    __syncthreads();
#pragma unroll
    for (int i = 0; i < 8; ++i) { const int e = tid + 512 * i, r = e >> 5, c = e & 31; const u32x4 a = gvr[i];
        const f32x2 st = *(const LAS f32x2*)(lds + G_ST + r * 8); const float* lw = p.ln_v_w + g * 256 + c * 8; const float* lb = p.ln_v_b + g * 256 + c * 8;
        const f32x4 w0 = *(const f32x4*)lw, w1 = *(const f32x4*)(lw + 4), b0 = *(const f32x4*)lb, b1 = *(const f32x4*)(lb + 4);
        u32x4 o; o.x = cvt_pk_bf16((bflo(a.x) - st[0]) * st[1] * w0[0] + b0[0], (bfhi(a.x) - st[0]) * st[1] * w0[1] + b0[1]);
        o.y = cvt_pk_bf16((bflo(a.y) - st[0]) * st[1] * w0[2] + b0[2], (bfhi(a.y) - st[0]) * st[1] * w0[3] + b0[3]);
        o.z = cvt_pk_bf16((bflo(a.z) - st[0]) * st[1] * w1[0] + b1[0], (bfhi(a.z) - st[0]) * st[1] * w1[1] + b1[1]);
        o.w = cvt_pk_bf16((bflo(a.w) - st[0]) * st[1] * w1[2] + b1[2], (bfhi(a.w) - st[0]) * st[1] * w1[3] + b1[3]);
        *(LAS u32x4*)(lds + G_VN + r * RS_VN + c * 16) = o; }
    __syncthreads();
    f32x4 acc[2][8];
#pragma unroll
    for (int j2 = 0; j2 < 2; ++j2)
#pragma unroll
        for (int it = 0; it < 8; ++it) acc[j2][it] = (f32x4){0.f, 0.f, 0.f, 0.f};
#pragma unroll
    for (int ks = 0; ks < 4; ++ks) { bf16x8 Av[2];
#pragma unroll
        for (int j2 = 0; j2 < 2; ++j2) Av[j2] = tr_frag(lds + G_VN + 32 * ks * RS_VN + (32 * w + 16 * j2) * 2, RS_VN, lane);
#pragma unroll
        for (int it = 0; it < 8; ++it) { if (ks >= 2 && it < 4) continue; const bf16x8 Bw = row_frag(lds + G_WS + 16 * it * RS_WS + ks * 64, RS_WS, lane);
#pragma unroll
            for (int j2 = 0; j2 < 2; ++j2) acc[j2][it] = MFMA16(Av[j2], Bw, acc[j2][it]); } }
#pragma unroll
    for (int it = 0; it < 8; ++it) { const int i = 16 * it + l15; const float bs = p.b_s[g * 128 + i];
#pragma unroll
        for (int j2 = 0; j2 < 2; ++j2) { bf16_t* rp = proj + (size_t)(tok0 + i) * PJ + PC_UZ + g * 256 + 32 * w + 16 * j2 + 4 * g4; const u32x2 uz = uzr[it][j2]; const f32x4 a = acc[j2][it];
            u32x2 pk; pk.x = cvt_pk_bf16(bflo(uz.x) * (a[0] + bs), bfhi(uz.x) * (a[1] + bs)); pk.y = cvt_pk_bf16(bflo(uz.y) * (a[2] + bs), bfhi(uz.y) * (a[3] + bs)); if (!nostore) *(u32x2*)rp = pk; } }
    __syncthreads();
}
__device__ __forceinline__ void gmlp_sample_item(const Params& p, LAS unsigned char* lds, int b, bool nostore = false) {
    int tid_ = threadIdx.x; asm volatile("" : "+v"(tid_));
    const int tid = tid_, lane = tid & 63, w = tid >> 6; bf16_t* proj = (bf16_t*)(p.ws + WS_PROJ); const int tok0 = SEQ + b * SAMP_T;
    LAS float* vn = (LAS float*)lds; LAS float* wsm = (LAS float*)(lds + 65536); LAS float* st = (LAS float*)(lds + 65536 + 4096);
    for (int i = 0; i < 2; ++i) { const int r = 2 * w + i; const bf16_t* rp = proj + (size_t)(tok0 + r) * PJ + PC_GV;
        const u32x4 a = *(const u32x4*)(rp + lane * 8), bb = *(const u32x4*)(rp + 512 + lane * 8);
        float x[16]; x[0] = bflo(a.x); x[1] = bfhi(a.x); x[2] = bflo(a.y); x[3] = bfhi(a.y); x[4] = bflo(a.z); x[5] = bfhi(a.z); x[6] = bflo(a.w); x[7] = bfhi(a.w);
        x[8] = bflo(bb.x); x[9] = bfhi(bb.x); x[10] = bflo(bb.y); x[11] = bfhi(bb.y); x[12] = bflo(bb.z); x[13] = bfhi(bb.z); x[14] = bflo(bb.w); x[15] = bfhi(bb.w);
        float s = 0.f;
#pragma unroll
        for (int k = 0; k < 16; ++k) s += x[k];
        const float mean = wave_sum(s) * (1.0f / 1024.0f); float q = 0.f;
#pragma unroll
        for (int k = 0; k < 16; ++k) { const float d = x[k] - mean; q += d * d; }
        const float rstd = rsqrtf(wave_sum(q) * (1.0f / 1024.0f) + EPS);
        if (lane == 0) { st[r * 2] = mean; st[r * 2 + 1] = rstd; } }
    for (int e = tid; e < 1024; e += 512) { const int g = e >> 8, i = (e >> 4) & 15, j = e & 15; wsm[e] = p.w_s[(size_t)(g * 128 + i) * 128 + j]; }
    __syncthreads();
    float* vs = p.out + OUT_VS + (size_t)b * SAMP_T * 1024;
    for (int i = 0; i < 4; ++i) { const int e = tid + 512 * i, r = e >> 7, c = (e & 127) * 8; const u32x4 a = *(const u32x4*)(proj + (size_t)(tok0 + r) * PJ + PC_GV + c);
        const float mean = st[r * 2], rstd = st[r * 2 + 1]; const f32x4 w0 = *(const f32x4*)(p.ln_v_w + c), w1 = *(const f32x4*)(p.ln_v_w + c + 4), b0 = *(const f32x4*)(p.ln_v_b + c), b1 = *(const f32x4*)(p.ln_v_b + c + 4);
        f32x4 o0, o1; o0[0] = (bflo(a.x) - mean) * rstd * w0[0] + b0[0]; o0[1] = (bfhi(a.x) - mean) * rstd * w0[1] + b0[1]; o0[2] = (bflo(a.y) - mean) * rstd * w0[2] + b0[2]; o0[3] = (bfhi(a.y) - mean) * rstd * w0[3] + b0[3];
        o1[0] = (bflo(a.z) - mean) * rstd * w1[0] + b1[0]; o1[1] = (bfhi(a.z) - mean) * rstd * w1[1] + b1[1]; o1[2] = (bflo(a.w) - mean) * rstd * w1[2] + b1[2]; o1[3] = (bfhi(a.w) - mean) * rstd * w1[3] + b1[3];
        *(LAS f32x4*)(vn + r * 1024 + c) = o0; *(LAS f32x4*)(vn + r * 1024 + c + 4) = o1; *(f32x4*)(vs + r * 1024 + c) = o0; *(f32x4*)(vs + r * 1024 + c + 4) = o1; }
    __syncthreads();
    { const int c = tid * 2, g = c >> 8; f32x2 v[16];
#pragma unroll
      for (int j = 0; j < 16; ++j) v[j] = *(const LAS f32x2*)(vn + j * 1024 + c);
#pragma unroll
      for (int i = 0; i < 16; ++i) { float s0 = p.b_s[g * 128 + i], s1 = s0;
#pragma unroll
          for (int j = 0; j < 16; ++j) { const float wv = wsm[g * 256 + i * 16 + j]; s0 += wv * v[j][0]; s1 += wv * v[j][1]; }
          bf16_t* rp = proj + (size_t)(tok0 + i) * PJ + PC_UZ + c; const unsigned uz = *(const unsigned*)rp; if (!nostore) *(unsigned*)rp = cvt_pk_bf16(bflo(uz) * s0, bfhi(uz) * s1); } }
    __syncthreads();
}
__device__ __forceinline__ void phase4(const Params& p) {
    const unsigned* useg = (const unsigned*)((unsigned char*)p.out + RB_USEG); unsigned* sst = (unsigned*)((unsigned char*)p.out + RB_SSTART); const float* dseg = (const float*)(p.ws + WS_DSEG);
    int tid_ = threadIdx.x; asm volatile("" : "+v"(tid_)); const int tid = tid_; int bid_ = blockIdx.x; asm volatile("" : "+s"(bid_)); const int bid = bid_;
    for (int e2 = bid * 512 + tid; e2 < 65536; e2 += gridDim.x * 512) {
        const int e = e2 * 2, h = e >> 15, v = (e >> 7) & 255, kap = e & 127; float S0 = 0.f, S1 = 0.f;
        for (int s0 = 0; s0 < NSEG; s0 += 32) { unsigned u[32]; f32x2 dd[32];
#pragma unroll
            for (int s = 0; s < 32; ++s) { u[s] = __builtin_nontemporal_load(useg + (size_t)(s0 + s) * 65536 + e2); dd[s] = *(const f32x2*)(dseg + ((s0 + s) * 4 + h) * 128 + kap); }
#pragma unroll
            for (int s = 0; s < 32; ++s) { sst[(size_t)(s0 + s) * 65536 + e2] = cvt_pk_bf16(S0, S1); S0 = dd[s][0] * S0 + bflo(u[s]); S1 = dd[s][1] * S1 + bfhi(u[s]); } }
        p.out[OUT_SP + (size_t)(h * 128 + kap) * 256 + v] = S0; p.out[OUT_SP + (size_t)(h * 128 + kap + 1) * 256 + v] = S1; }
}
__device__ __forceinline__ void phase8(const Params& p, bool nostore = false) {
    int tid_ = threadIdx.x; asm volatile("" : "+v"(tid_)); const int tid = tid_; int bid_ = blockIdx.x; asm volatile("" : "+s"(bid_)); const int bid = bid_;
    const int lane = tid & 63, wv = tid >> 6;
    for (int row = SEQ + bid * 8 + wv; row < MTOT; row += gridDim.x * 8) { float* yr = p.out + (size_t)row * D;
        f32x4 v[4]; float ss = 0.f;
#pragma unroll
        for (int i = 0; i < 4; ++i) { v[i] = *(const f32x4*)(yr + i * 256 + lane * 4); ss += (v[i][0] * v[i][0] + v[i][1] * v[i][1]) + (v[i][2] * v[i][2] + v[i][3] * v[i][3]); }
        const float rstd = rsqrtf(wave_sum(ss) * (1.0f / D) + EPS);
#pragma unroll
        for (int i = 0; i < 4; ++i) { const int c = i * 256 + lane * 4; const f32x4 fw = *(const f32x4*)(p.final_norm_w + c); if (!nostore) *(f32x4*)(yr + c) = v[i] * rstd * fw; } }
}

__global__ __launch_bounds__(512, 2) void mega(Params p0) {
    extern __shared__ __attribute__((aligned(16))) unsigned char shm[];
    LAS unsigned char* lds = (LAS unsigned char*)shm;
    const bool multi = (p0.ph_hi - p0.ph_lo) > 1;
    if (multi) { volatile LAS unsigned* st = (volatile LAS unsigned*)(lds + LDS_BAR);
        if (threadIdx.x == 0) { st[0] = 0u; st[1] = 0u; }
        __syncthreads();
        (void)xcd_barrier_post((unsigned*)(p0.ws + WS_CTL), st); }
#ifdef PROBE_PH
    constexpr int PDUP = PROBE_PH >= 30 ? 3 : (PROBE_PH >= 20 ? 2 : PROBE_PH);
    const int nph = p0.ph_hi + 1;
#else
    const int nph = p0.ph_hi;
#endif
    for (int pi = p0.ph_lo; pi < nph; ++pi) {
#if defined(__HIP_DEVICE_COMPILE__)
        const __attribute__((address_space(4))) Params* kp = (const __attribute__((address_space(4))) Params*)__builtin_amdgcn_kernarg_segment_ptr();
        asm volatile("" : "+s"(kp));
        const Params p = *kp;
#else
        const Params p = p0;
#endif
        int bid_ = blockIdx.x; asm volatile("" : "+s"(bid_)); const int bid = bid_;
#ifdef PROBE_PH
        const int ph = pi > PDUP ? pi - 1 : pi; const bool first = (pi == PDUP); const bool nostore = first && (p.ph_hi < 100);
#else
        const int ph = pi; const bool nostore = false;
#endif
      {
        if (ph == 0) phase0(p, lds);
        else if (ph == 1) phase1(p);
        else if (ph == 2) { pg8::Order S; S.init(SEQ / 256, 32, gridDim.x, bid); Ptr1 P{(const char*)p.out + RB_H, (const char*)p.out + RB_BT1};
            Epi1 E{(bf16_t*)(p.ws + WS_PROJ), (float*)(p.ws + WS_GVST)};
#ifdef PROBE_PH
            if (!(first && PROBE_PH == 20)) pg8::gemm_phase<Epi1, Ptr1, pg8::Order>(lds, S, P, E, D, D, D);
            if (!(first && PROBE_PH == 21)) sample_gemm1(p, lds, bid);
#else
            pg8::gemm_phase<Epi1, Ptr1, pg8::Order>(lds, S, P, E, D, D, D); sample_gemm1(p, lds, bid);
#endif
            }
        else if (ph == 3) {
            const int pm = (bid & 7) * 8 + (bid >> 5), hg = (bid >> 3) & 3;
            gla_segA(p, lds, pm, hg);
            gmlp_item(p, lds, 2 * pm, hg, nostore, true);
            gmlp_item(p, lds, 2 * pm + 1, hg, nostore, false);
            if (bid >= 16 && bid < 80) { const int it = bid - 16; gla_prep(p, lds, SEQ + (it >> 2) * SAMP_T, 1, SAMP_T, it & 3, 256 + (it >> 2), false, 0, 0); __syncthreads(); } }
        else if (ph == 4) { phase4(p); if (bid >= 128 && bid < 192) gla_out(p, lds, 1, (bid - 128) >> 2, (bid - 128) & 3, nostore);
            else if (bid >= 192 && bid < 208) gmlp_sample_item(p, lds, bid - 192, nostore); }
        else if (ph == 5) {
            gla_out(p, lds, 0, (bid & 7) * 8 + (bid >> 5), (bid >> 3) & 3, nostore); }
        else if (ph == 6) { pg8::Order2 S; S.c = bid; Ptr2 P{(const char*)(p.ws + WS_PROJ), (const char*)(p.ws + WS_BTA), (const char*)(p.ws + WS_BTB)};
            Epi2 E{(bf16_t*)(p.ws + WS_PROJ), p.b_gate, nostore}; if (bid & 1) sample_gemm2(p, bid, nostore); pg8::gemm_phase<Epi2, Ptr2, pg8::Order2>(lds, S, P, E, D, PJ, D); if (!(bid & 1)) sample_gemm2(p, bid, nostore); }
        else if (ph == 7) { pg8::Order S; S.init(SEQ / 256, 4, gridDim.x, bid); Ptr3 P{(const char*)(p.ws + WS_PROJ), (const char*)(p.ws + WS_BTO)};
            Epi3 E{p.x_prompt, (const float*)(p.ws + WS_ADA), p.final_norm_w, p.out, (float*)(p.ws + WS_XB), (unsigned*)(p.ws + WS_PCNT)}; if (bid & 1) sample_gemm3(p, bid); pg8::gemm_phase<Epi3, Ptr3, pg8::Order>(lds, S, P, E, D, PJ, D); if (!(bid & 1)) sample_gemm3(p, bid); }
        else if (ph == 8) phase8(p, nostore);
      }
        if (multi && pi + 1 < nph) { XcdBarrier xb; xb.bar = (unsigned*)(p.ws + WS_CTL); xb.x = xb_xcc_id(); xb.st = (volatile LAS unsigned*)(lds + LDS_BAR); xcd_barrier(xb); }
    }
}

#ifndef MK_LAUNCHES
#define MK_LAUNCHES 1
#endif
extern "C" void kernel_launch(void* const* d_in, const int* in_sizes, int n_in, void* d_out, int out_size, void* d_ws, size_t ws_size, hipStream_t stream) {
    static int ready = 0;
    if (ready == 0) {
        if (n_in != 21 || ws_size < WS_END) { fprintf(stderr, "kernel_launch: need 21 inputs and >= %zu bytes of workspace (got %d, %zu)\n", (size_t)WS_END, n_in, ws_size); ready = -1; return; }
        if (hipFuncSetAttribute((const void*)mega, hipFuncAttributeMaxDynamicSharedMemorySize, LDS_BYTES) != hipSuccess) { fprintf(stderr, "kernel_launch: hipFuncSetAttribute failed\n"); ready = -1; return; }
        int per_cu = 0; (void)hipOccupancyMaxActiveBlocksPerMultiprocessor(&per_cu, (const void*)mega, 512, LDS_BYTES); (void)hipGetLastError();
        if (per_cu < 1) fprintf(stderr, "kernel_launch: occupancy query reports %d blocks per CU\n", per_cu);
        ready = 1;
    }
    if (ready < 0) return;
    (void)hipMemsetAsync((char*)d_ws + WS_CTL, 0, 32768, stream);
    Params p{};
    const float** pp = (const float**)&p;
    for (int i = 0; i < 21; ++i) pp[i] = (const float*)d_in[i];
    p.out = (float*)d_out; p.ws = (unsigned char*)d_ws;
    const int nl = MK_LAUNCHES;
    for (int li = 0; li < nl; ++li) {
        p.ph_lo = (nl == 1) ? 0 : li; p.ph_hi = (nl == 1) ? 9 : li + 1;
        void* args[] = {&p};
        hipError_t e;
        if (nl == 1) e = hipLaunchCooperativeKernel((const void*)mega, dim3(256), dim3(512), args, LDS_BYTES, stream);
        else { hipLaunchKernelGGL(mega, dim3(256), dim3(512), LDS_BYTES, stream, p); e = hipPeekAtLastError(); }
        if (e != hipSuccess) { fprintf(stderr, "kernel_launch: launch %d failed: %s\n", li, hipGetErrorString(e)); break; }
    }
}
```

```cpp
#include <hip/hip_runtime.h>
#include <cstdio>

#define LAS __attribute__((address_space(3)))
typedef unsigned short bf16_t;
typedef short bf16x8 __attribute__((ext_vector_type(8)));
typedef short s16x4 __attribute__((ext_vector_type(4)));
typedef float f32x4 __attribute__((ext_vector_type(4)));
typedef float f32x2 __attribute__((ext_vector_type(2)));
typedef unsigned u32x4 __attribute__((ext_vector_type(4)));
typedef unsigned u32x2 __attribute__((ext_vector_type(2)));

constexpr int D = 1024, SEQ = 16384, NSAMP = 16, SAMP_T = 16, MTOT = SEQ + NSAMP * SAMP_T;
constexpr int WIN_LD = 8208;
constexpr int PJ = 7168;
constexpr int PC_Q = 0, PC_K = 512, PC_V = 1024, PC_R = 2048, PC_UZ = 3072, PC_GV = 4096, PC_GA = 5120;
constexpr int N1 = 8256;
constexpr int NSEG = 64, SEGCH = 4;
constexpr float EPS = 1e-6f;
constexpr size_t WS_CTL = 0, WS_PCNT = 16384, WS_ADA = 32768, WS_ALR = WS_ADA + 17 * 3072 * 4, WS_DSEG = WS_ALR + (size_t)MTOT * 16 * 4,
                 WS_ROWSS = WS_DSEG + NSEG * 4 * 128 * 4, WS_BTA = WS_ROWSS + (size_t)MTOT * 16 * 4, WS_BTB = WS_BTA + 2097152,
                 WS_BTO = WS_BTB + 2097152, WS_PROJ = WS_BTO + 4194304, WS_GVST = WS_PROJ + (size_t)MTOT * PJ * 2, WS_DCH = WS_GVST + (size_t)SEQ * 16 * 8, WS_XB = WS_DCH + (size_t)272 * 4 * 128 * 4, WS_END = WS_XB + (size_t)64 * 256 * 4 * 4;
constexpr size_t RB_H = 0, RB_BT1 = (size_t)MTOT * D * 2, RB_USEG = 0, RB_SSTART = 16777216;
constexpr size_t OUT_YS = (size_t)SEQ * D, OUT_SP = OUT_YS + 256 * D, OUT_SS = OUT_SP + 4 * 128 * 256, OUT_VS = OUT_SS + 16 * 4 * 128 * 256;
constexpr int LDS_BAR = 156160, LDS_BYTES = 156672;

struct Params {
    const float* x_prompt; const float* x_sample; const float* state_gla; const float* c_prompt; const float* c_sample;
    const float* norm_w; const float* w_ada; const float* b_ada; const float* w_in; const float* w_a2; const float* b_a;
    const float* gla_norm_w; const float* ln_v_w; const float* ln_v_b; const float* w_s; const float* b_s; const float* b_gate;
    const float* w_proj_a; const float* w_proj_b; const float* w_out; const float* final_norm_w;
    float* out; unsigned char* ws; int ph_lo; int ph_hi;
};

__device__ __forceinline__ unsigned cvt_pk_bf16(float lo, float hi) { unsigned r; asm volatile("v_cvt_pk_bf16_f32 %0, %1, %2" : "=v"(r) : "v"(lo), "v"(hi)); return r; }
__device__ __forceinline__ bf16_t f2bf(float f) { return (bf16_t)(cvt_pk_bf16(f, 0.f) & 0xffffu); }
__device__ __forceinline__ float bf2f(bf16_t b) { return __uint_as_float(((unsigned)b) << 16); }
__device__ __forceinline__ float bflo(unsigned w) { return __uint_as_float(w << 16); }
__device__ __forceinline__ float bfhi(unsigned w) { return __uint_as_float(w & 0xffff0000u); }
__device__ __forceinline__ float sigmoidf_(float x) { return __builtin_amdgcn_rcpf(1.0f + __expf(-x)); }
__device__ __forceinline__ float siluf_(float x) { return x * __builtin_amdgcn_rcpf(1.0f + __expf(-x)); }
__device__ __forceinline__ float wave_sum(float v) {
#pragma unroll
    for (int o = 32; o > 0; o >>= 1) v += __shfl_xor(v, o);
    return v;
}
__device__ __forceinline__ bf16x8 row_frag(const LAS unsigned char* base, int rs, int lane) { return *(const LAS bf16x8*)(base + rs * (lane & 15) + 16 * (lane >> 4)); }
__device__ __forceinline__ bf16x8 tr_frag(const LAS unsigned char* base, int rs, int lane) {
    const int g = lane >> 4, q = (lane & 15) >> 2, pp = lane & 3;
    const LAS unsigned char* a = base + rs * (8 * g + q) + 8 * pp;
    const s16x4 lo = __builtin_amdgcn_ds_read_tr16_b64_v4i16((LAS s16x4*)a);
    const s16x4 hi = __builtin_amdgcn_ds_read_tr16_b64_v4i16((LAS s16x4*)(a + 4 * rs));
    bf16x8 r; r[0] = lo[0]; r[1] = lo[1]; r[2] = lo[2]; r[3] = lo[3]; r[4] = hi[0]; r[5] = hi[1]; r[6] = hi[2]; r[7] = hi[3]; return r;
}
#define MFMA16(a, b, c) __builtin_amdgcn_mfma_f32_16x16x32_bf16(a, b, c, 0, 0, 0)

#define XB_TMO      128
#define XB_XCNT(j)  (256  + 64 * (j))
#define XB_XSUB(j)  (1280 + 64 * (j))
#define XB_XGEN(j)  (2304 + 64 * (j))
#define XB_TOP      3328
#define XB_TOPGEN   3392
#define XCD_BAR_WORDS 3456
#define XB_SPIN_CAP (1u << 22)
__device__ __forceinline__ unsigned xb_ld(unsigned* p)              { return __hip_atomic_load(p, __ATOMIC_RELAXED, __HIP_MEMORY_SCOPE_AGENT); }
__device__ __forceinline__ unsigned xb_add(unsigned* p, unsigned v) { return __hip_atomic_fetch_add(p, v, __ATOMIC_RELAXED, __HIP_MEMORY_SCOPE_AGENT); }
__device__ __forceinline__ unsigned xb_xcc_id() { return (unsigned)__builtin_amdgcn_s_getreg((3 << 11) | 20) & 0xFu; }
#define XB_SPIN(cond, bar) do { unsigned _sp = 0; while (cond) { __builtin_amdgcn_s_sleep(1); \
    if ((++_sp & 255u) == 0u) { if (xb_ld(&(bar)[XB_TMO])) break; if (_sp > XB_SPIN_CAP) { atomicAdd(&(bar)[XB_TMO], 1u); break; } } } } while (0)
struct XcdBarrier { unsigned* bar; unsigned x; volatile LAS unsigned* st; };
__device__ __forceinline__ XcdBarrier xcd_barrier_post(unsigned* bar, volatile LAS unsigned* st) {
    XcdBarrier b; b.bar = bar; b.x = xb_xcc_id(); b.st = st;
    if (threadIdx.x == 0) (void)xb_add(&bar[XB_XCNT(b.x)], 1u);
    return b;
}
__device__ __forceinline__ void xcd_barrier_complete(unsigned* bar, unsigned x, unsigned& nloc, unsigned& nx) {
    const unsigned G = gridDim.x * gridDim.y * gridDim.z;
    unsigned sum, cnt, mine, sp = 0u;
    for (;;) {
        sum = 0u; cnt = 0u; mine = 0u;
#pragma unroll
        for (unsigned j = 0; j < 16; ++j) { const unsigned c = xb_ld(&bar[XB_XCNT(j)]); sum += c; cnt += (c > 0u) ? 1u : 0u; mine = (j == x) ? c : mine; }
        if (sum == G) break;
        __builtin_amdgcn_s_sleep(1);
        if ((++sp & 255u) == 0u) { if (xb_ld(&bar[XB_TMO])) break; if (sp > XB_SPIN_CAP) { atomicAdd(&bar[XB_TMO], 1u); break; } }
    }
    nloc = mine > 0u ? mine : 1u; nx = cnt > 0u ? cnt : 1u;
}
__device__ __forceinline__ void xcd_barrier(const XcdBarrier& b) {
    asm volatile("s_waitcnt vmcnt(0)" ::: "memory");
    __syncthreads();
    if (threadIdx.x == 0) {
        unsigned* bar = b.bar;
        __builtin_amdgcn_s_waitcnt(0);
        unsigned nloc = b.st[0], nx = b.st[1];
        if (nloc == 0u) { xcd_barrier_complete(bar, b.x, nloc, nx); b.st[0] = nloc; b.st[1] = nx; }
        const unsigned old = xb_add(&bar[XB_XSUB(b.x)], 1u);
        const unsigned gen = old / nloc;
        if (old + 1u == (gen + 1u) * nloc) {
            __builtin_amdgcn_fence(__ATOMIC_RELEASE, "agent");
            asm volatile("s_waitcnt vmcnt(0)" ::: "memory");
            const unsigned og = xb_add(&bar[XB_TOP], 1u);
            const unsigned tg = og / nx;
            if (og + 1u == (tg + 1u) * nx) xb_add(&bar[XB_TOPGEN], 1u);
            else XB_SPIN(xb_ld(&bar[XB_TOPGEN]) == tg, bar);
            __builtin_amdgcn_fence(__ATOMIC_ACQUIRE, "agent");
            xb_add(&bar[XB_XGEN(b.x)], 1u);
            asm volatile("s_waitcnt vmcnt(0)" ::: "memory");
        } else {
            XB_SPIN(xb_ld(&bar[XB_XGEN(b.x)]) == gen, bar);
            __builtin_amdgcn_fence(__ATOMIC_ACQUIRE, "agent");
            asm volatile("s_waitcnt vmcnt(0)" ::: "memory");
        }
    }
    __syncthreads();
}

namespace pg8 {
constexpr int BM = 256, BK = 64, HALF = 128, HTB = HALF * BK * 2, NXCD = 8, WGM = 8;
__device__ __forceinline__ int lds_byte(int r, int c) { const int st = (r >> 4) * 2 + (c >> 5), rr = r & 15, cc = c & 31, ob = rr * 64 + cc * 2; return st * 1024 + (ob ^ (((ob >> 9) & 1) << 5)); }
__device__ __forceinline__ void stage_rc(int b, int& R, int& C) { const int st = b / 1024, sb = b % 1024, swz = sb ^ (((sb >> 9) & 1) << 5); R = (st >> 1) * 16 + swz / 64; C = (st & 1) * 32 + (swz % 64) / 2; }
__device__ __forceinline__ int perm32(int rho) { const int n = rho >> 4, i = rho & 15; return 8 * (i >> 2) + 4 * n + (i & 3); }
struct Unit { int pm, pn; };
struct Order {
    int nM, nN, nwg, G, c;
    __device__ void init(int nM_, int nN_, int G_, int c_) { nM = nM_; nN = nN_; nwg = nM * nN; G = G_; c = c_; }
    __device__ bool next(int i, Unit& u) const {
        const long L = (long)i * G + c; if (L >= nwg) return false;
        int wgid = (int)L; { const int q = nwg / NXCD, r = nwg % NXCD, xcd = wgid % NXCD, off = wgid / NXCD; wgid = (xcd < r ? xcd * (q + 1) : r * (q + 1) + (xcd - r) * q) + off; }
        const int nig = WGM * nN, gid = wgid / nig, fm = gid * WGM, gsz = (nM - fm) < WGM ? (nM - fm) : WGM;
        u.pm = fm + ((wgid % nig) % gsz); u.pn = (wgid % nig) / gsz; return true;
    }
};
struct Order2 {
    int c;
    __device__ bool next(int i, Unit& u) const { if (i >= 2) return false; const int x = c & 7, q = c >> 3; u.pm = x * 8 + (q >> 2); u.pn = (q & 3) + 4 * i; return true; }
};
template <class Epi, class Ptr, class Ord>
__device__ __forceinline__ void gemm_phase(LAS unsigned char* lds, const Ord& S, const Ptr& P, const Epi& E, int K, int lda, int ldb) {
    int tid_ = threadIdx.x; asm volatile("" : "+v"(tid_));
    const int tid = tid_, wid = __builtin_amdgcn_readfirstlane(tid >> 6), lane = tid & 63, wr = wid >> 2, wc = wid & 3, fr = lane & 15, fq = lane >> 4;
    const int nt = K / BK;
    unsigned voffA[2], voffB[2];
#pragma unroll
    for (int i = 0; i < 2; ++i) { int R, C; stage_rc(tid * 16 + i * 8192, R, C); const int Rb = Epi::PERM ? ((R & ~31) + perm32(R & 31)) : R;
        voffA[i] = (unsigned)(R * lda + C) * 2u; voffB[i] = (unsigned)(Rb * ldb + C) * 2u; }
    const size_t kstep = (size_t)(BK * 2);
    const size_t hstepA = (size_t)HALF * lda * 2, hstepB = (size_t)HALF * ldb * 2;
    const unsigned ldsw = (unsigned)wid * 1024u;
    const int aoff = lds_byte(wr * 64 + fr, fq * 8), boff = lds_byte(wc * 32 + fr, fq * 8);
#define PG8_SA(b, h) (((b) * 2 + (h)) * HTB)
#define PG8_SB(b, h) ((4 + (b) * 2 + (h)) * HTB)
#define PG8_STAGE(bufoff, gbase, voff) do { _Pragma("unroll") for (int _i = 0; _i < 2; ++_i) \
        __builtin_amdgcn_global_load_lds((const unsigned*)((const char*)(gbase) + (voff)[_i]), (LAS unsigned*)(lds + (bufoff) + ldsw + _i * 8192), 16, 0, 0); } while (0)
#define PG8_LDA(dst, b, h) do { _Pragma("unroll") for (int m = 0; m < 4; ++m) _Pragma("unroll") for (int k = 0; k < 2; ++k) dst[m][k] = *(const LAS bf16x8*)(lds + PG8_SA(b, h) + aoff + m * 2048 + k * 1024); } while (0)
#define PG8_LDB(dst, b, h) do { _Pragma("unroll") for (int n = 0; n < 2; ++n) _Pragma("unroll") for (int k = 0; k < 2; ++k) dst[n][k] = *(const LAS bf16x8*)(lds + PG8_SB(b, h) + boff + n * 2048 + k * 1024); } while (0)
#define PG8_MMA(ai, bj, At, Bt) do { __builtin_amdgcn_s_setprio(1); _Pragma("unroll") for (int m = 0; m < 4; ++m) _Pragma("unroll") for (int n = 0; n < 2; ++n) _Pragma("unroll") for (int k = 0; k < 2; ++k) \
        acc[ai][bj][m][n] = __builtin_amdgcn_mfma_f32_16x16x32_bf16(Bt[n][k], At[m][k], acc[ai][bj][m][n], 0, 0, 0); __builtin_amdgcn_s_setprio(0); } while (0)
#define PG8_WAIT_V(n) asm volatile("s_waitcnt vmcnt(" #n ")" ::: "memory")
#define PG8_WAIT_L(n) asm volatile("s_waitcnt lgkmcnt(" #n ")" ::: "memory")
#define PG8_BAR __builtin_amdgcn_s_barrier()
#define PG8_SCHED __builtin_amdgcn_sched_barrier(0)
    Unit cur, nxt; int ui = 0;
    if (!S.next(0, cur)) return;
    f32x4 acc[2][2][4][2];
#pragma unroll
    for (int a = 0; a < 2; ++a)
#pragma unroll
        for (int b = 0; b < 2; ++b)
#pragma unroll
            for (int m = 0; m < 4; ++m)
#pragma unroll
                for (int n = 0; n < 2; ++n) acc[a][b][m][n] = (f32x4){0.f, 0.f, 0.f, 0.f};
    bf16x8 At[4][2], B0[2][2], B1[2][2];
    const char* cA = P.aptr(cur); const char* cB = P.bptr(cur);
    PG8_STAGE(PG8_SB(0, 0), cB, voffB); PG8_STAGE(PG8_SA(0, 0), cA, voffA); PG8_STAGE(PG8_SB(0, 1), cB + hstepB, voffB); PG8_STAGE(PG8_SA(0, 1), cA + hstepA, voffA);
    if (wr == 1) PG8_BAR;
    PG8_WAIT_V(4); PG8_BAR;
    PG8_STAGE(PG8_SB(1, 0), cB + kstep, voffB); PG8_STAGE(PG8_SA(1, 0), cA + kstep, voffA); PG8_STAGE(PG8_SB(1, 1), cB + hstepB + kstep, voffB);
    PG8_WAIT_V(6); PG8_BAR;
    for (;;) {
        const bool has_next = S.next(ui + 1, nxt);
        const char* nA = has_next ? P.aptr(nxt) : cA; const char* nB = has_next ? P.bptr(nxt) : cB;
        for (int t = 0; t < nt; t += 2) {
            const bool last = (t == nt - 2);
            const char* a1 = cA + (size_t)(t + 1) * kstep;
            const char* a2 = last ? nA : cA + (size_t)(t + 2) * kstep; const char* b2 = last ? nB : cB + (size_t)(t + 2) * kstep;
            const char* a3 = a2 + kstep; const char* b3 = b2 + kstep;
            PG8_LDB(B0, 0, 0); PG8_SCHED; PG8_LDA(At, 0, 0); PG8_STAGE(PG8_SA(1, 1), a1 + hstepA, voffA);
            PG8_WAIT_L(8); PG8_BAR; PG8_WAIT_L(0); PG8_MMA(0, 0, At, B0); PG8_BAR; PG8_SCHED;
            PG8_LDB(B1, 0, 1); PG8_STAGE(PG8_SB(0, 0), b2, voffB);
            PG8_BAR; PG8_WAIT_L(0); PG8_MMA(0, 1, At, B1); PG8_BAR;
            PG8_LDA(At, 0, 1); PG8_STAGE(PG8_SA(0, 0), a2, voffA);
            PG8_BAR; PG8_WAIT_L(0); PG8_MMA(1, 0, At, B0); PG8_BAR; PG8_SCHED;
            PG8_STAGE(PG8_SB(0, 1), b2 + hstepB, voffB);
            PG8_WAIT_V(6); PG8_BAR; PG8_MMA(1, 1, At, B1); PG8_BAR;
            PG8_LDB(B0, 1, 0); PG8_SCHED; PG8_LDA(At, 1, 0); PG8_STAGE(PG8_SA(0, 1), a2 + hstepA, voffA);
            PG8_WAIT_L(8); PG8_BAR; PG8_WAIT_L(0); PG8_MMA(0, 0, At, B0); PG8_BAR; PG8_SCHED;
            PG8_LDB(B1, 1, 1); PG8_STAGE(PG8_SB(1, 0), b3, voffB);
            PG8_BAR; PG8_WAIT_L(0); PG8_MMA(0, 1, At, B1); PG8_BAR;
            PG8_LDA(At, 1, 1); PG8_STAGE(PG8_SA(1, 0), a3, voffA);
            PG8_BAR; PG8_WAIT_L(0); PG8_MMA(1, 0, At, B0); PG8_BAR; PG8_SCHED;
            PG8_STAGE(PG8_SB(1, 1), b3 + hstepB, voffB);
            PG8_WAIT_V(6); PG8_BAR; PG8_MMA(1, 1, At, B1); PG8_BAR;
        }
        bool keep = false;
        if constexpr (!Epi::AFTER_DRAIN) keep = E(acc, cur, wr, wc, fr, fq);
        if (!has_next) break;
        if (!keep) {
#pragma unroll
        for (int a = 0; a < 2; ++a)
#pragma unroll
            for (int b = 0; b < 2; ++b)
#pragma unroll
                for (int m = 0; m < 4; ++m)
#pragma unroll
                    for (int n = 0; n < 2; ++n) acc[a][b][m][n] = (f32x4){0.f, 0.f, 0.f, 0.f};
        }
        cur = nxt; cA = nA; cB = nB; ++ui;
    }
    PG8_WAIT_V(0);
    if (wr == 0) PG8_BAR;
    PG8_BAR;
    if constexpr (Epi::AFTER_DRAIN) E.fused(acc, cur, wr, wc, fr, fq, lds, wid, lane);
#undef PG8_SA
#undef PG8_SB
#undef PG8_STAGE
#undef PG8_LDA
#undef PG8_LDB
#undef PG8_MMA
#undef PG8_WAIT_V
#undef PG8_WAIT_L
#undef PG8_BAR
#undef PG8_SCHED
}
}
using pg8::Unit;

struct Ptr1 { const char* A; const char* B; __device__ const char* aptr(const Unit& u) const { return A + (size_t)u.pm * 256 * D * 2; } __device__ const char* bptr(const Unit& u) const { return B + (size_t)u.pn * 256 * D * 2; } };
struct Epi1 {
    static constexpr bool PERM = true, AFTER_DRAIN = false;
    bf16_t* proj; float* gvst;
    __device__ __forceinline__ bool operator()(f32x4 (&acc)[2][2][4][2], const Unit& u, int wr, int wc, int fr, int fq) const {
        asm volatile("" : "+v"(fr), "+v"(fq));
        const int row0 = u.pm * 256 + wr * 64 + fr;
        if (u.pn >= 12 && u.pn < 20) {
            const int col = PC_UZ + (u.pn - 12) * 128 + wc * 32 + 8 * fq;
#pragma unroll
            for (int ai = 0; ai < 2; ++ai)
#pragma unroll
                for (int m = 0; m < 4; ++m) { bf16_t* rp = proj + (size_t)(row0 + ai * 128 + m * 16) * PJ + col;
                    const f32x4 u0 = acc[ai][0][m][0], u1 = acc[ai][0][m][1], z0 = acc[ai][1][m][0], z1 = acc[ai][1][m][1];
                    u32x4 w; w.x = cvt_pk_bf16(u0[0] * siluf_(z0[0]), u0[1] * siluf_(z0[1])); w.y = cvt_pk_bf16(u0[2] * siluf_(z0[2]), u0[3] * siluf_(z0[3]));
                    w.z = cvt_pk_bf16(u1[0] * siluf_(z1[0]), u1[1] * siluf_(z1[1])); w.w = cvt_pk_bf16(u1[2] * siluf_(z1[2]), u1[3] * siluf_(z1[3]));
                    __builtin_nontemporal_store(w, (u32x4*)rp); }
            return false;
        }
        const int col = (u.pn < 12 ? u.pn * 256 : PC_GV + (u.pn - 20) * 256) + wc * 32 + 8 * fq;
        const bool isgv = u.pn >= 20 && u.pn < 24;
#pragma unroll
        for (int ai = 0; ai < 2; ++ai)
#pragma unroll
            for (int m = 0; m < 4; ++m) { const int row = row0 + ai * 128 + m * 16; bf16_t* rp = proj + (size_t)row * PJ + col; float s = 0.f, q = 0.f;
#pragma unroll
                for (int bj = 0; bj < 2; ++bj) { const f32x4 v0 = acc[ai][bj][m][0], v1 = acc[ai][bj][m][1];
                    u32x4 w; w.x = cvt_pk_bf16(v0[0], v0[1]); w.y = cvt_pk_bf16(v0[2], v0[3]); w.z = cvt_pk_bf16(v1[0], v1[1]); w.w = cvt_pk_bf16(v1[2], v1[3]);
                    __builtin_nontemporal_store(w, (u32x4*)(rp + bj * 128));
                    s += (v0[0] + v0[1]) + (v0[2] + v0[3]) + (v1[0] + v1[1]) + (v1[2] + v1[3]);
                    q += (v0[0] * v0[0] + v0[1] * v0[1]) + (v0[2] * v0[2] + v0[3] * v0[3]) + (v1[0] * v1[0] + v1[1] * v1[1]) + (v1[2] * v1[2] + v1[3] * v1[3]); }
                if (isgv) { s += __shfl_xor(s, 16); s += __shfl_xor(s, 32); q += __shfl_xor(q, 16); q += __shfl_xor(q, 32);
                    if (fq == 0) *(f32x2*)(gvst + ((size_t)row * 16 + (u.pn - 20) * 4 + wc) * 2) = (f32x2){s, q}; } }
        return false;
    }
};
struct Ptr2 { const char* proj; const char* BA; const char* BB;
    __device__ const char* aptr(const Unit& u) const { return proj + ((size_t)u.pm * 256 * PJ + (u.pn < 4 ? PC_R : PC_UZ)) * 2; }
    __device__ const char* bptr(const Unit& u) const { return (u.pn < 4 ? BA : BB) + (size_t)(u.pn & 3) * 256 * D * 2; } };
struct Epi2 {
    static constexpr bool PERM = true, AFTER_DRAIN = false;
    bf16_t* proj; const float* b_gate; bool nostore;
    __device__ __forceinline__ bool operator()(f32x4 (&acc)[2][2][4][2], const Unit& u, int wr, int wc, int fr, int fq) const {
        asm volatile("" : "+v"(fr), "+v"(fq));
        const int row0 = u.pm * 256 + wr * 64 + fr, col = (u.pn & 3) * 256 + wc * 32 + 8 * fq; const bool first = u.pn < 4;
        bf16_t* base = proj + (size_t)row0 * PJ + PC_GA + col;
        if (first) {
#pragma unroll
            for (int bj = 0; bj < 2; ++bj) { const float* ba = b_gate + col + bj * 128; const f32x4 bA0 = *(const f32x4*)ba, bA1 = *(const f32x4*)(ba + 4), bB0 = *(const f32x4*)(ba + 1024), bB1 = *(const f32x4*)(ba + 1028);
#pragma unroll
                for (int ai = 0; ai < 2; ++ai) { u32x4 ga[4], gb[4];
#pragma unroll
                    for (int m = 0; m < 4; ++m) { const bf16_t* rp = base + (size_t)(ai * 128 + m * 16) * PJ + bj * 128; ga[m] = *(const u32x4*)rp; gb[m] = *(const u32x4*)(rp + 1024); }
                    __builtin_amdgcn_sched_barrier(0);
#pragma unroll
                    for (int m = 0; m < 4; ++m) { float ea[8], eb[8];
                        ea[0] = __expf(-(bflo(ga[m].x) + bA0[0])); ea[1] = __expf(-(bfhi(ga[m].x) + bA0[1])); ea[2] = __expf(-(bflo(ga[m].y) + bA0[2])); ea[3] = __expf(-(bfhi(ga[m].y) + bA0[3]));
                        ea[4] = __expf(-(bflo(ga[m].z) + bA1[0])); ea[5] = __expf(-(bfhi(ga[m].z) + bA1[1])); ea[6] = __expf(-(bflo(ga[m].w) + bA1[2])); ea[7] = __expf(-(bfhi(ga[m].w) + bA1[3]));
                        eb[0] = __expf(-(bflo(gb[m].x) + bB0[0])); eb[1] = __expf(-(bfhi(gb[m].x) + bB0[1])); eb[2] = __expf(-(bflo(gb[m].y) + bB0[2])); eb[3] = __expf(-(bfhi(gb[m].y) + bB0[3]));
                        eb[4] = __expf(-(bflo(gb[m].z) + bB1[0])); eb[5] = __expf(-(bfhi(gb[m].z) + bB1[1])); eb[6] = __expf(-(bflo(gb[m].w) + bB1[2])); eb[7] = __expf(-(bfhi(gb[m].w) + bB1[3]));
#pragma unroll
                        for (int j = 0; j < 4; ++j) { acc[ai][bj][m][0][j] *= (1.0f + eb[j]) * __builtin_amdgcn_rcpf(1.0f + ea[j]); acc[ai][bj][m][1][j] *= (1.0f + eb[4 + j]) * __builtin_amdgcn_rcpf(1.0f + ea[4 + j]); } } } }
            return true;
        }
#pragma unroll
        for (int bj = 0; bj < 2; ++bj) { const float* ba = b_gate + col + bj * 128; const f32x4 bB0 = *(const f32x4*)(ba + 1024), bB1 = *(const f32x4*)(ba + 1028);
#pragma unroll
            for (int ai = 0; ai < 2; ++ai) { u32x4 gb[4];
#pragma unroll
                for (int m = 0; m < 4; ++m) gb[m] = *(const u32x4*)(base + (size_t)(ai * 128 + m * 16) * PJ + bj * 128 + 1024);
                __builtin_amdgcn_sched_barrier(0);
#pragma unroll
                for (int m = 0; m < 4; ++m) { float sb[8];
                    sb[0] = sigmoidf_(bflo(gb[m].x) + bB0[0]); sb[1] = sigmoidf_(bfhi(gb[m].x) + bB0[1]); sb[2] = sigmoidf_(bflo(gb[m].y) + bB0[2]); sb[3] = sigmoidf_(bfhi(gb[m].y) + bB0[3]);
                    sb[4] = sigmoidf_(bflo(gb[m].z) + bB1[0]); sb[5] = sigmoidf_(bfhi(gb[m].z) + bB1[1]); sb[6] = sigmoidf_(bflo(gb[m].w) + bB1[2]); sb[7] = sigmoidf_(bfhi(gb[m].w) + bB1[3]);
                    const f32x4 v0 = acc[ai][bj][m][0], v1 = acc[ai][bj][m][1];
                    u32x4 w; w.x = cvt_pk_bf16(v0[0] * sb[0], v0[1] * sb[1]); w.y = cvt_pk_bf16(v0[2] * sb[2], v0[3] * sb[3]); w.z = cvt_pk_bf16(v1[0] * sb[4], v1[1] * sb[5]); w.w = cvt_pk_bf16(v1[2] * sb[6], v1[3] * sb[7]);
                    if (!nostore) *(u32x4*)(base + (size_t)(ai * 128 + m * 16) * PJ + bj * 128) = w; } } }
        return false;
    }
};
struct Ptr3 { const char* proj; const char* BO;
    __device__ const char* aptr(const Unit& u) const { return proj + ((size_t)u.pm * 256 * PJ + PC_GA) * 2; }
    __device__ const char* bptr(const Unit& u) const { return BO + (size_t)u.pn * 256 * D * 2; } };
struct Epi3 {
    static constexpr bool PERM = false, AFTER_DRAIN = true;
    const float* xp; const float* ada; const float* fw; float* out; float* xbuf; unsigned* cnt;
    __device__ __forceinline__ bool operator()(f32x4 (&acc)[2][2][4][2], const Unit& u, int wr, int wc, int fr, int fq) const { return false; }
    __device__ __forceinline__ void fused(f32x4 (&acc)[2][2][4][2], const Unit& u, int wr, int wc, int fr, int fq, LAS unsigned char* lds, int wid, int lane) const {
        asm volatile("" : "+v"(fr), "+v"(fq));
        LAS float* P = (LAS float*)lds; LAS float* S = (LAS float*)(lds + 4096);
        const int row0 = u.pm * 256 + wr * 64 + fr, col0 = u.pn * 256 + wc * 32 + 4 * fq;
        f32x4 gt[4];
#pragma unroll
        for (int q = 0; q < 4; ++q) gt[q] = *(const f32x4*)(ada + 2048 + col0 + (q >> 1) * 128 + (q & 1) * 16);
#pragma unroll
        for (int ai = 0; ai < 2; ++ai) { f32x4 xv[4][4];
#pragma unroll
            for (int m = 0; m < 4; ++m)
#pragma unroll
                for (int q = 0; q < 4; ++q) xv[m][q] = __builtin_nontemporal_load((const f32x4*)(xp + (size_t)(row0 + ai * 128 + m * 16) * D + col0 + (q >> 1) * 128 + (q & 1) * 16));
            __builtin_amdgcn_sched_barrier(0);
#pragma unroll
            for (int m = 0; m < 4; ++m) { const int lrow = ai * 128 + wr * 64 + m * 16 + fr; float ss = 0.f;
#pragma unroll
                for (int q = 0; q < 4; ++q) { const f32x4 r = xv[m][q] + gt[q] * acc[ai][q >> 1][m][q & 1]; acc[ai][q >> 1][m][q & 1] = r; ss += (r[0] * r[0] + r[1] * r[1]) + (r[2] * r[2] + r[3] * r[3]); }
                ss += __shfl_xor(ss, 16); ss += __shfl_xor(ss, 32);
                if (fq == 0) P[lrow * 4 + wc] = ss; } }
        __syncthreads();
        const int prow = wid * 32 + (lane & 31);
        if (lane < 32) { const f32x4 pp = *(const LAS f32x4*)(P + prow * 4);
            __hip_atomic_store(xbuf + ((size_t)u.pm * 256 + prow) * 4 + u.pn, (pp[0] + pp[1]) + (pp[2] + pp[3]), __ATOMIC_RELAXED, __HIP_MEMORY_SCOPE_AGENT); }
        asm volatile("s_waitcnt vmcnt(0)" ::: "memory");
        if (lane == 0) __hip_atomic_fetch_add(cnt + 64 * u.pm, 1u, __ATOMIC_RELAXED, __HIP_MEMORY_SCOPE_AGENT);
        if (wid == 0) { unsigned sp = 0u;
            while ((unsigned)__builtin_amdgcn_readfirstlane(__hip_atomic_load(cnt + 64 * u.pm, __ATOMIC_RELAXED, __HIP_MEMORY_SCOPE_AGENT)) < 32u) { __builtin_amdgcn_s_sleep(2); if (++sp > (1u << 22)) break; }
            __builtin_amdgcn_fence(__ATOMIC_ACQUIRE, "agent"); }
        asm volatile("s_waitcnt vmcnt(0) lgkmcnt(0)" ::: "memory"); __syncthreads();
        if (lane < 32) { const float* sl = xbuf + ((size_t)u.pm * 256 + prow) * 4; float t = 0.f;
#pragma unroll
            for (int q = 0; q < 4; ++q) t += __hip_atomic_load(sl + q, __ATOMIC_RELAXED, __HIP_MEMORY_SCOPE_AGENT);
            S[prow] = rsqrtf(t * (1.0f / D) + EPS); }
        __syncthreads();
        f32x4 fv[4];
#pragma unroll
        for (int q = 0; q < 4; ++q) fv[q] = *(const f32x4*)(fw + col0 + (q >> 1) * 128 + (q & 1) * 16);
#pragma unroll
        for (int ai = 0; ai < 2; ++ai)
#pragma unroll
            for (int m = 0; m < 4; ++m) { const int row = row0 + ai * 128 + m * 16, lrow = ai * 128 + wr * 64 + m * 16 + fr; const float rs = S[lrow]; float* orow = out + (size_t)row * D + col0;
#pragma unroll
                for (int q = 0; q < 4; ++q) __builtin_nontemporal_store(acc[ai][q >> 1][m][q & 1] * rs * fv[q], (f32x4*)(orow + (q >> 1) * 128 + (q & 1) * 16)); }
    }
};
template <int AM, int BN>
__device__ __forceinline__ void wave_gemm(const bf16_t* const (&Ar)[AM], int lda, const bf16_t* const (&Br)[BN], int ldb, int K, int lane, f32x4 (&acc)[AM][BN]) {
    const bf16_t* a[AM]; const bf16_t* b[BN];
#pragma unroll
    for (int i = 0; i < AM; ++i) a[i] = Ar[i] + (size_t)(lane & 15) * lda + 8 * (lane >> 4);
#pragma unroll
    for (int i = 0; i < BN; ++i) b[i] = Br[i] + (size_t)(lane & 15) * ldb + 8 * (lane >> 4);
    constexpr int KB = (AM + BN) >= 4 ? 8 : 16;
    for (int k0 = 0; k0 < K; k0 += 32 * KB) { bf16x8 fa[KB][AM], fb[KB][BN];
#pragma unroll
        for (int s = 0; s < KB; ++s) {
#pragma unroll
            for (int i = 0; i < AM; ++i) fa[s][i] = *(const bf16x8*)(a[i] + k0 + 32 * s);
#pragma unroll
            for (int i = 0; i < BN; ++i) fb[s][i] = *(const bf16x8*)(b[i] + k0 + 32 * s); }
        __builtin_amdgcn_sched_barrier(0);
#pragma unroll
        for (int s = 0; s < KB; ++s)
#pragma unroll
            for (int i = 0; i < AM; ++i)
#pragma unroll
                for (int j = 0; j < BN; ++j) acc[i][j] = MFMA16(fb[s][j], fa[s][i], acc[i][j]); }
}
__device__ __forceinline__ void sample_gemm1(const Params& p, LAS unsigned char* lds, int bid) {
    int tid_ = threadIdx.x; asm volatile("" : "+v"(tid_)); const int tid = tid_, lane = tid & 63, w = tid >> 6, g4 = lane >> 4, l15 = lane & 15;
    const bf16_t* H = (const bf16_t*)((const unsigned char*)p.out + RB_H); const bf16_t* bt1 = (const bf16_t*)((const unsigned char*)p.out + RB_BT1); bf16_t* proj = (bf16_t*)(p.ws + WS_PROJ);
    constexpr int RS = 528, LB = 256 * RS;
    int b0, b1, ocol; const bool uz = bid >= 96 && bid < 160;
    if (bid < 96) { b0 = 32 * bid; b1 = b0 + 16; ocol = 32 * bid; }
    else if (uz) { const int j = bid - 96; b0 = 3072 + (j >> 3) * 256 + (j & 7) * 16; b1 = b0 + 128; ocol = PC_UZ + 16 * j; }
    else { b0 = 5120 + 32 * (bid - 160); b1 = b0 + 16; ocol = PC_GV + 32 * (bid - 160); }
    u32x4 ra[16], rb[2];
    const int pr = tid >> 5, pc = tid & 31;
    const bf16_t* ag = H + (size_t)(SEQ + pr) * D + pc * 8;
    const bf16_t* bg0 = bt1 + (size_t)(b0 + pr) * D + pc * 8; const bf16_t* bg1 = bt1 + (size_t)(b1 + pr) * D + pc * 8;
#pragma unroll
    for (int i = 0; i < 16; ++i) ra[i] = *(const u32x4*)(ag + (size_t)i * 16 * D);
    rb[0] = *(const u32x4*)bg0; rb[1] = *(const u32x4*)bg1;
    f32x4 acc[2][2];
#pragma unroll
    for (int i = 0; i < 2; ++i)
#pragma unroll
        for (int j = 0; j < 2; ++j) acc[i][j] = (f32x4){0.f, 0.f, 0.f, 0.f};
    for (int kc = 0; kc < 4; ++kc) {
#pragma unroll
        for (int i = 0; i < 16; ++i) *(LAS u32x4*)(lds + (pr + 16 * i) * RS + pc * 16) = ra[i];
        *(LAS u32x4*)(lds + LB + pr * RS + pc * 16) = rb[0]; *(LAS u32x4*)(lds + LB + (16 + pr) * RS + pc * 16) = rb[1];
        __syncthreads();
        if (kc + 1 < 4) { int ko = (kc + 1) * 256; asm volatile("" : "+v"(ko));
#pragma unroll
            for (int i = 0; i < 16; ++i) ra[i] = *(const u32x4*)(ag + (size_t)i * 16 * D + ko);
            rb[0] = *(const u32x4*)(bg0 + ko); rb[1] = *(const u32x4*)(bg1 + ko); }
#pragma unroll
        for (int ks = 0; ks < 8; ++ks) { bf16x8 fa[2], fb[2];
#pragma unroll
            for (int i = 0; i < 2; ++i) { fa[i] = row_frag(lds + (32 * w + 16 * i) * RS + ks * 64, RS, lane); fb[i] = row_frag(lds + LB + 16 * i * RS + ks * 64, RS, lane); }
#pragma unroll
            for (int i = 0; i < 2; ++i)
#pragma unroll
                for (int j = 0; j < 2; ++j) acc[i][j] = MFMA16(fb[j], fa[i], acc[i][j]); }
        __syncthreads();
    }
    const int r0 = SEQ + 32 * w;
#pragma unroll
    for (int i = 0; i < 2; ++i) { bf16_t* rp = proj + (size_t)(r0 + 16 * i + l15) * PJ + ocol + 4 * g4;
        if (uz) { const f32x4 u = acc[i][0], z = acc[i][1]; u32x2 pk; pk.x = cvt_pk_bf16(u[0] * siluf_(z[0]), u[1] * siluf_(z[1])); pk.y = cvt_pk_bf16(u[2] * siluf_(z[2]), u[3] * siluf_(z[3])); *(u32x2*)rp = pk; }
        else {
#pragma unroll
            for (int j = 0; j < 2; ++j) { u32x2 pk; pk.x = cvt_pk_bf16(acc[i][j][0], acc[i][j][1]); pk.y = cvt_pk_bf16(acc[i][j][2], acc[i][j][3]); *(u32x2*)(rp + 16 * j) = pk; } } }
}
__device__ __forceinline__ void sample_gemm2(const Params& p, int bid, bool nostore) {
    int tid_ = threadIdx.x; asm volatile("" : "+v"(tid_)); const int lane = tid_ & 63, w = tid_ >> 6, g4 = lane >> 4, l15 = lane & 15;
    if (w >= 4) return;
    bf16_t* proj = (bf16_t*)(p.ws + WS_PROJ); const bf16_t* bta = (const bf16_t*)(p.ws + WS_BTA); const bf16_t* btb = (const bf16_t*)(p.ws + WS_BTB);
    const int tile = bid * 4 + w, rt = tile >> 6, ct = tile & 63, r0 = SEQ + 16 * rt, c0 = 16 * ct;
    f32x4 aa[1][1], ab[1][1]; aa[0][0] = (f32x4){0.f, 0.f, 0.f, 0.f}; ab[0][0] = aa[0][0];
    { const bf16_t* const Ar[1] = {proj + (size_t)r0 * PJ + PC_R}; const bf16_t* const Br[1] = {bta + (size_t)c0 * D}; wave_gemm<1, 1>(Ar, PJ, Br, D, D, lane, aa); }
    { const bf16_t* const Ar[1] = {proj + (size_t)r0 * PJ + PC_UZ}; const bf16_t* const Br[1] = {btb + (size_t)c0 * D}; wave_gemm<1, 1>(Ar, PJ, Br, D, D, lane, ab); }
    bf16_t* rp = proj + (size_t)(r0 + l15) * PJ + PC_GA + c0 + 4 * g4; const u32x2 ga = *(const u32x2*)rp, gb = *(const u32x2*)(rp + 1024);
    const f32x4 bA = *(const f32x4*)(p.b_gate + c0 + 4 * g4), bB = *(const f32x4*)(p.b_gate + 1024 + c0 + 4 * g4);
    float o[4];
    o[0] = sigmoidf_(bflo(ga.x) + bA[0]) * aa[0][0][0] + sigmoidf_(bflo(gb.x) + bB[0]) * ab[0][0][0]; o[1] = sigmoidf_(bfhi(ga.x) + bA[1]) * aa[0][0][1] + sigmoidf_(bfhi(gb.x) + bB[1]) * ab[0][0][1];
    o[2] = sigmoidf_(bflo(ga.y) + bA[2]) * aa[0][0][2] + sigmoidf_(bflo(gb.y) + bB[2]) * ab[0][0][2]; o[3] = sigmoidf_(bfhi(ga.y) + bA[3]) * aa[0][0][3] + sigmoidf_(bfhi(gb.y) + bB[3]) * ab[0][0][3];
    u32x2 pk; pk.x = cvt_pk_bf16(o[0], o[1]); pk.y = cvt_pk_bf16(o[2], o[3]); if (!nostore) *(u32x2*)rp = pk;
}
__device__ __forceinline__ void sample_gemm3(const Params& p, int bid) {
    int tid_ = threadIdx.x; asm volatile("" : "+v"(tid_)); const int lane = tid_ & 63, w = tid_ >> 6, g4 = lane >> 4, l15 = lane & 15;
    if (w >= 4) return;
    const bf16_t* proj = (const bf16_t*)(p.ws + WS_PROJ); const bf16_t* bto = (const bf16_t*)(p.ws + WS_BTO); const float* ada = (const float*)(p.ws + WS_ADA);
    const int tile = bid * 4 + w, rt = tile >> 6, ct = tile & 63, c0 = 16 * ct + 4 * g4, rs = 16 * rt + l15;
    f32x4 acc[1][1]; acc[0][0] = (f32x4){0.f, 0.f, 0.f, 0.f};
    { const bf16_t* const Ar[1] = {proj + (size_t)(SEQ + 16 * rt) * PJ + PC_GA}; const bf16_t* const Br[1] = {bto + (size_t)16 * ct * D}; wave_gemm<1, 1>(Ar, PJ, Br, D, D, lane, acc); }
    const f32x4 xv = *(const f32x4*)(p.x_sample + (size_t)rs * D + c0), gt = *(const f32x4*)(ada + (1 + rt) * 3072 + 2048 + c0);
    *(f32x4*)(p.out + OUT_YS + (size_t)rs * D + c0) = xv + gt * acc[0][0];
}

__device__ __forceinline__ void transpose_tile(LAS unsigned char* lds, const float* src, int ldsrc, int scol0, int nvalid, float scale, bf16_t* dst, int ldd, int n0, int k0) {
    int tid_ = threadIdx.x; asm volatile("" : "+v"(tid_)); const int tid = tid_;
    f32x4 v[8];
#pragma unroll
    for (int i = 0; i < 8; ++i) { const int e = tid + 512 * i, k = e >> 4, n4 = (e & 15) * 4; f32x4 t = (f32x4){0.f, 0.f, 0.f, 0.f};
        if (n4 < nvalid) t = __builtin_nontemporal_load((const f32x4*)(src + (size_t)(k0 + k) * ldsrc + scol0 + n4));
        v[i] = t; }
#pragma unroll
    for (int i = 0; i < 8; ++i) { const int e = tid + 512 * i, k = e >> 4, n4 = (e & 15) * 4, m = (e & 15) & 7;
        const f32x4 t = v[i];
        *(LAS bf16_t*)(lds + (n4 + 0) * 528 + (((k >> 3) ^ m) << 4) + (k & 7) * 2) = f2bf(t[0] * scale);
        *(LAS bf16_t*)(lds + (n4 + 1) * 528 + (((k >> 3) ^ m) << 4) + (k & 7) * 2) = f2bf(t[1] * scale);
        *(LAS bf16_t*)(lds + (n4 + 2) * 528 + (((k >> 3) ^ m) << 4) + (k & 7) * 2) = f2bf(t[2] * scale);
        *(LAS bf16_t*)(lds + (n4 + 3) * 528 + (((k >> 3) ^ m) << 4) + (k & 7) * 2) = f2bf(t[3] * scale); }
    __syncthreads();
#pragma unroll
    for (int i = 0; i < 4; ++i) { const int e = tid + 512 * i, n = e >> 5, kc = e & 31; const u32x4 w = *(const LAS u32x4*)(lds + n * 528 + ((kc ^ ((n >> 2) & 7)) << 4));
        *(u32x4*)(dst + (size_t)(n0 + n) * ldd + k0 + kc * 8) = w; }
    __syncthreads();
}
__device__ __forceinline__ void ada_item(const Params& p, LAS unsigned char* lds, int slab) {
    int tid_ = threadIdx.x; asm volatile("" : "+v"(tid_)); const int tid = tid_; float* ada = (float*)(p.ws + WS_ADA);
    LAS float* sc = (LAS float*)lds;
    LAS float* red = (LAS float*)(lds + 17 * 1024 * 4);
    for (int i = tid; i < 17 * 1024; i += 512) { const int b = i >> 10, k = i & 1023; const float c = b == 0 ? p.c_prompt[k] : p.c_sample[(b - 1) * 1024 + k]; sc[i] = siluf_(c); }
    __syncthreads();
    const int nl = tid & 31, kg = tid >> 5, n = slab * 32 + nl;
    float a[17];
#pragma unroll
    for (int b = 0; b < 17; ++b) a[b] = 0.f;
    for (int k16 = 0; k16 < 4; ++k16) { float w[16]; const float* wp = p.w_ada + (size_t)(kg * 64 + k16 * 16) * 3072 + n;
#pragma unroll
        for (int i = 0; i < 16; ++i) w[i] = wp[(size_t)i * 3072];
        __builtin_amdgcn_sched_barrier(0);
#pragma unroll
        for (int k4 = 0; k4 < 4; ++k4) { const int k = kg * 64 + k16 * 16 + k4 * 4;
#pragma unroll
            for (int b = 0; b < 17; ++b) { const f32x4 s = *(const LAS f32x4*)(sc + b * 1024 + k); a[b] += s[0] * w[k4 * 4] + s[1] * w[k4 * 4 + 1] + s[2] * w[k4 * 4 + 2] + s[3] * w[k4 * 4 + 3]; } } }
#pragma unroll
    for (int b = 0; b < 17; ++b) red[(kg * 17 + b) * 32 + nl] = a[b];
    __syncthreads();
    for (int i = tid; i < 17 * 32; i += 512) { const int b = i >> 5, c = i & 31; float s = p.b_ada[slab * 32 + c];
#pragma unroll
        for (int g = 0; g < 16; ++g) s += red[(g * 17 + b) * 32 + c];
        ada[b * 3072 + slab * 32 + c] = s; }
    __syncthreads();
}
__device__ __forceinline__ void phase0(const Params& p, LAS unsigned char* lds) {
    bf16_t* bt1 = (bf16_t*)((unsigned char*)p.out + RB_BT1); bf16_t* bta = (bf16_t*)(p.ws + WS_BTA); bf16_t* btb = (bf16_t*)(p.ws + WS_BTB); bf16_t* bto = (bf16_t*)(p.ws + WS_BTO);
    constexpr int N_ADA = 96, N_T1 = (N1 / 64) * 4, N_TS = 64;
    int bid_ = blockIdx.x; asm volatile("" : "+s"(bid_)); const int bid = bid_;
    for (int it = bid; it < N_ADA + N_T1 + 3 * N_TS; it += gridDim.x) {
        if (it < N_ADA) { ada_item(p, lds, it); continue; }
        int j = it - N_ADA;
        if (j < N_T1) { const int nt = j >> 2, kt = j & 3, n0 = nt * 64; int sc0, nv = 64;
            if (n0 < 3072) sc0 = n0;
            else if (n0 < 5120) { const int t = (n0 - 3072) >> 8, w = (n0 - 3072) & 255; sc0 = w < 128 ? 3088 + t * 128 + w : 5136 + t * 128 + (w - 128); }
            else if (n0 < 6144) sc0 = 4112 + (n0 - 5120);
            else if (n0 < 7168) sc0 = 6160 + (n0 - 6144);
            else if (n0 < 8192) sc0 = 7184 + (n0 - 7168);
            else { sc0 = 3072; nv = 16; }
            transpose_tile(lds, p.w_in, WIN_LD, sc0, nv, n0 < 512 ? 0.08838834764831845f : 1.0f, bt1, D, n0, kt * 256); continue; }
        j -= N_T1;
        const int which = j >> 6, nt = (j & 63) >> 2, kt = j & 3;
        if (which == 0) transpose_tile(lds, p.w_proj_a, D, nt * 64, 64, 1.0f, bta, D, nt * 64, kt * 256);
        else if (which == 1) transpose_tile(lds, p.w_proj_b, D, nt * 64, 64, 1.0f, btb, D, nt * 64, kt * 256);
        else transpose_tile(lds, p.w_out, D, nt * 64, 64, 1.0f, bto, D, nt * 64, kt * 256);
    }
}
__device__ __forceinline__ void phase1(const Params& p) {
    int tid_ = threadIdx.x; asm volatile("" : "+v"(tid_)); const int tid = tid_; int bid_ = blockIdx.x; asm volatile("" : "+s"(bid_)); const int bid = bid_;
    const int lane = tid & 63, wv = tid >> 6, l15 = lane & 15, g4 = lane >> 4; const float* ada = (const float*)(p.ws + WS_ADA); bf16_t* H = (bf16_t*)((unsigned char*)p.out + RB_H);
#pragma unroll 2
    for (int row = bid * 8 + wv; row < MTOT; row += gridDim.x * 8) {
        const float* xr = row < SEQ ? p.x_prompt + (size_t)row * D : p.x_sample + (size_t)(row - SEQ) * D; const int b = row < SEQ ? 0 : 1 + ((row - SEQ) >> 4);
        f32x4 v[4]; float ss = 0.f;
#pragma unroll
        for (int i = 0; i < 4; ++i) { v[i] = __builtin_nontemporal_load((const f32x4*)(xr + i * 256 + lane * 4)); ss += (v[i][0] * v[i][0] + v[i][1] * v[i][1]) + (v[i][2] * v[i][2] + v[i][3] * v[i][3]); }
        ss = wave_sum(ss); const float rstd = rsqrtf(ss * (1.0f / D) + EPS);
#pragma unroll
        for (int i = 0; i < 4; ++i) { const int c = i * 256 + lane * 4; const f32x4 nw = *(const f32x4*)(p.norm_w + c), sh = *(const f32x4*)(ada + b * 3072 + c), scl = *(const f32x4*)(ada + b * 3072 + 1024 + c);
            const f32x4 h = v[i] * rstd * nw * (scl + 1.0f) + sh; u32x2 w; w.x = cvt_pk_bf16(h[0], h[1]); w.y = cvt_pk_bf16(h[2], h[3]); *(u32x2*)(H + (size_t)row * D + c) = w; }
    }
    asm volatile("s_waitcnt vmcnt(0)" ::: "memory");
    __syncthreads();
    float* alr = (float*)(p.ws + WS_ALR);
    const bf16_t* w16 = (const bf16_t*)((const unsigned char*)p.out + RB_BT1) + (size_t)(8192 + l15) * D + 8 * g4;
    for (int gi = wv; bid * 8 + 2048 * gi < MTOT; gi += 8) { const int r0 = bid * 8 + 2048 * gi;
        f32x4 acc = (f32x4){0.f, 0.f, 0.f, 0.f};
        const bf16_t* ap = H + (size_t)(r0 + (l15 & 7)) * D + 8 * g4;
#pragma unroll
        for (int kb = 0; kb < 2; ++kb) { bf16x8 fa[16], fb[16];
#pragma unroll
            for (int s = 0; s < 16; ++s) { fa[s] = *(const bf16x8*)(ap + (kb * 16 + s) * 32); fb[s] = *(const bf16x8*)(w16 + (kb * 16 + s) * 32); }
#pragma unroll
            for (int s = 0; s < 16; ++s) acc = MFMA16(fb[s], fa[s], acc); }
        if (l15 < 8) *(f32x4*)(alr + (size_t)(r0 + l15) * 16 + 4 * g4) = acc; }
}
__device__ __forceinline__ void gla_prep(const Params& p, LAS unsigned char* lds, int tokbase, int nchunk, int nvalid, int h, int chunk0, bool tolds, int ldsK, int ldsDV) {
    int tid_ = threadIdx.x; asm volatile("" : "+v"(tid_)); const int tid = tid_, kap = tid & 127; const int c = __builtin_amdgcn_readfirstlane(tid >> 7);
    bf16_t* proj = (bf16_t*)(p.ws + WS_PROJ); const float* alr = (const float*)(p.ws + WS_ALR); float* dch = (float*)(p.ws + WS_DCH);
    if (c < nchunk) {
        float w2[16];
#pragma unroll
        for (int j = 0; j < 16; ++j) w2[j] = p.w_a2[j * 512 + h * 128 + kap];
        const float ba = p.b_a[h * 128 + kap];
        const int tok0 = tokbase + 64 * c; float run = 0.f;
        bf16_t* kp = proj + (size_t)tok0 * PJ + PC_K + h * 128 + kap; bf16_t* qp = proj + (size_t)tok0 * PJ + PC_Q + h * 128 + kap;
        const float* ar0 = alr + (size_t)tok0 * 16;
#pragma unroll 8
        for (int t = 0; t < nvalid; ++t) { const float* ar = ar0 + t * 16; float x = ba;
#pragma unroll
            for (int j = 0; j < 16; ++j) x += ar[j] * w2[j];
            const float la = -(fmaxf(-x, 0.f) + __logf(1.0f + __expf(-fabsf(x)))) * 0.0625f; run += la;
            const float kk = bf2f(kp[(size_t)t * PJ]), qq = bf2f(qp[(size_t)t * PJ]);
            const bf16_t kt = f2bf(kk * __expf(-run)); kp[(size_t)t * PJ] = kt; qp[(size_t)t * PJ] = f2bf(qq * __expf(run));
            if (tolds) *(LAS bf16_t*)(lds + ldsK + (64 * c + t) * 272 + kap * 2) = kt; }
        const float d = __expf(run); dch[((chunk0 + c) * 4 + h) * 128 + kap] = d; if (tolds) *(LAS float*)(lds + ldsDV + (c * 128 + kap) * 4) = d;
    }
}
constexpr int LA_K = 0, LA_V0 = 69632, LA_V1 = 103424, LA_DV = 137216;
constexpr int RS_QK = 272, RS_V = 528, RS_P = 144, RS_S = 272;
__device__ __forceinline__ void gla_segA(const Params& p, LAS unsigned char* lds, int seg, int h) {
    int tid_ = threadIdx.x; asm volatile("" : "+v"(tid_));
    const int tid = tid_, lane = tid & 63, w = tid >> 6, g4 = lane >> 4, l15 = lane & 15;
    const bf16_t* proj = (const bf16_t*)(p.ws + WS_PROJ); const int tokbase = seg * (SEGCH * 64);
    u32x4 vr[4];
#pragma unroll
    for (int i = 0; i < 4; ++i) { const int e = tid + 512 * i, r = e >> 5, c = e & 31; vr[i] = *(const u32x4*)(proj + (size_t)(tokbase + r) * PJ + PC_V + h * 256 + c * 8); }
    gla_prep(p, lds, tokbase, SEGCH, 64, h, seg * SEGCH, true, LA_K, LA_DV);
#pragma unroll
    for (int i = 0; i < 4; ++i) { const int e = tid + 512 * i, r = e >> 5, c = e & 31; *(LAS u32x4*)(lds + LA_V0 + r * RS_V + c * 16) = vr[i]; }
    __syncthreads();
    f32x4 acc[8][2];
#pragma unroll
    for (int kt = 0; kt < 8; ++kt)
#pragma unroll
        for (int j2 = 0; j2 < 2; ++j2) acc[kt][j2] = (f32x4){0.f, 0.f, 0.f, 0.f};
    for (int ch = 0; ch < SEGCH; ++ch) {
        int tok1 = tokbase + (ch + 1) * 64; asm volatile("" : "+v"(tok1));
        const int vb = (ch & 1) ? LA_V1 : LA_V0, vn = (ch & 1) ? LA_V0 : LA_V1;
        if (ch + 1 < SEGCH) {
#pragma unroll
            for (int i = 0; i < 4; ++i) { const int e = tid + 512 * i, r = e >> 5, c = e & 31; vr[i] = *(const u32x4*)(proj + (size_t)(tok1 + r) * PJ + PC_V + h * 256 + c * 8); } }
#pragma unroll
        for (int ks = 0; ks < 2; ++ks) { bf16x8 Bv[2];
#pragma unroll
            for (int j2 = 0; j2 < 2; ++j2) Bv[j2] = tr_frag(lds + vb + 32 * ks * RS_V + (32 * w + 16 * j2) * 2, RS_V, lane);
#pragma unroll
            for (int kt = 0; kt < 8; ++kt) { const bf16x8 Ak = tr_frag(lds + LA_K + (64 * ch + 32 * ks) * RS_QK + 16 * kt * 2, RS_QK, lane);
#pragma unroll
                for (int j2 = 0; j2 < 2; ++j2) acc[kt][j2] = MFMA16(Ak, Bv[j2], acc[kt][j2]); } }
#pragma unroll
        for (int kt = 0; kt < 8; ++kt) { const f32x4 d = *(const LAS f32x4*)(lds + LA_DV + (ch * 128 + 16 * kt + 4 * g4) * 4);
#pragma unroll
            for (int j2 = 0; j2 < 2; ++j2) acc[kt][j2] = acc[kt][j2] * d; }
        if (ch + 1 < SEGCH) {
#pragma unroll
            for (int i = 0; i < 4; ++i) { const int e = tid + 512 * i, r = e >> 5, c = e & 31; *(LAS u32x4*)(lds + vn + r * RS_V + c * 16) = vr[i]; } }
        __syncthreads();
    }
    bf16_t* us = (bf16_t*)((unsigned char*)p.out + RB_USEG) + ((size_t)(seg * 4 + h) * 256) * 128;
#pragma unroll
    for (int kt = 0; kt < 8; ++kt)
#pragma unroll
        for (int j2 = 0; j2 < 2; ++j2) { u32x2 pk; pk.x = cvt_pk_bf16(acc[kt][j2][0], acc[kt][j2][1]); pk.y = cvt_pk_bf16(acc[kt][j2][2], acc[kt][j2][3]);
            *(u32x2*)(us + (size_t)(32 * w + 16 * j2 + l15) * 128 + 16 * kt + 4 * g4) = pk; }
    if (tid < 128) { float d = 1.f;
#pragma unroll
        for (int c = 0; c < 4; ++c) d *= *(const LAS float*)(lds + LA_DV + (c * 128 + tid) * 4);
        ((float*)(p.ws + WS_DSEG))[(seg * 4 + h) * 128 + tid] = d; }
    __syncthreads();
}
constexpr int L_DV = 6144, L_RED = 6656, L_Q = 8704, L_K = 26112, L_V = 43520, L_P = 77312, L_S = 86528;
__device__ __forceinline__ void gla_out(const Params& p, LAS unsigned char* lds, int sample, int idx  , int h, bool nostore) {
    int tid_ = threadIdx.x; asm volatile("" : "+v"(tid_));
    const int tid = tid_, lane = tid & 63, w = tid >> 6, g4 = lane >> 4, l15 = lane & 15;
    bf16_t* proj = (bf16_t*)(p.ws + WS_PROJ); const float* dch = (const float*)(p.ws + WS_DCH);
    const int nchunk = sample ? 1 : SEGCH, nvalid = sample ? SAMP_T : 64, tokbase = sample ? SEQ + idx * SAMP_T : idx * (SEGCH * 64), chunk0 = sample ? 256 + idx : idx * SEGCH;
    f32x4 acc[8][2];
    if (!sample) { const bf16_t* ss = (const bf16_t*)((unsigned char*)p.out + RB_SSTART) + ((size_t)(idx * 4 + h) * 256) * 128;
#pragma unroll
        for (int kt = 0; kt < 8; ++kt)
#pragma unroll
            for (int j2 = 0; j2 < 2; ++j2) { const u32x2 pk = *(const u32x2*)(ss + (size_t)(32 * w + 16 * j2 + l15) * 128 + 16 * kt + 4 * g4);
                acc[kt][j2] = (f32x4){bflo(pk.x), bfhi(pk.x), bflo(pk.y), bfhi(pk.y)}; }
    } else { const float* s0 = p.state_gla + (size_t)(idx * 4 + h) * 128 * 256;
#pragma unroll
        for (int kt = 0; kt < 8; ++kt)
#pragma unroll
            for (int j2 = 0; j2 < 2; ++j2)
#pragma unroll
                for (int r = 0; r < 4; ++r) acc[kt][j2][r] = s0[(size_t)(16 * kt + 4 * g4 + r) * 256 + 32 * w + 16 * j2 + l15];
    }
    if (tid < 128) {
#pragma unroll
        for (int c = 0; c < SEGCH; ++c) if (c < nchunk) *(LAS float*)(lds + (c * 128 + tid) * 4) = dch[((chunk0 + c) * 4 + h) * 128 + tid]; }
    u32x4 rq[2], rk[2], rv[4];
#define GLA_LOAD_TILES(T0) do { \
        _Pragma("unroll") for (int i = 0; i < 2; ++i) { const int e = tid + 512 * i, r = e >> 4, c = e & 15; const bool ok = r < nvalid; const bf16_t* bp = proj + (size_t)((T0) + r) * PJ + h * 128 + c * 8; \
            rq[i] = ok ? __builtin_nontemporal_load((const u32x4*)(bp + PC_Q)) : (u32x4){0u, 0u, 0u, 0u}; rk[i] = ok ? __builtin_nontemporal_load((const u32x4*)(bp + PC_K)) : (u32x4){0u, 0u, 0u, 0u}; } \
        _Pragma("unroll") for (int i = 0; i < 4; ++i) { const int e = tid + 512 * i, r = e >> 5, c = e & 31; \
            rv[i] = (r < nvalid) ? __builtin_nontemporal_load((const u32x4*)(proj + (size_t)((T0) + r) * PJ + PC_V + h * 256 + c * 8)) : (u32x4){0u, 0u, 0u, 0u}; } } while (0)
    GLA_LOAD_TILES(tokbase);
    for (int ch = 0; ch < nchunk; ++ch) {
        int tok0 = tokbase + ch * 64; asm volatile("" : "+v"(tok0));
#pragma unroll
        for (int i = 0; i < 2; ++i) { const int e = tid + 512 * i, r = e >> 4, c = e & 15; *(LAS u32x4*)(lds + L_Q + r * RS_QK + c * 16) = rq[i]; *(LAS u32x4*)(lds + L_K + r * RS_QK + c * 16) = rk[i]; }
#pragma unroll
        for (int i = 0; i < 4; ++i) { const int e = tid + 512 * i, r = e >> 5, c = e & 31; *(LAS u32x4*)(lds + L_V + r * RS_V + c * 16) = rv[i]; }
#pragma unroll
        for (int kt = 0; kt < 8; ++kt)
#pragma unroll
            for (int j2 = 0; j2 < 2; ++j2) { u32x2 pk; pk.x = cvt_pk_bf16(acc[kt][j2][0], acc[kt][j2][1]); pk.y = cvt_pk_bf16(acc[kt][j2][2], acc[kt][j2][3]);
                *(LAS u32x2*)(lds + L_S + (32 * w + 16 * j2 + l15) * RS_S + (16 * kt + 4 * g4) * 2) = pk; }
        __syncthreads();
        if (ch + 1 < nchunk) { const int tok1 = tok0 + 64; GLA_LOAD_TILES(tok1); }
#pragma unroll
        for (int e = 0; e < 2; ++e) { const int tile = 2 * w + e, st = tile >> 2, tt = tile & 3; f32x4 ap = (f32x4){0.f, 0.f, 0.f, 0.f};
            if (st <= tt) {
#pragma unroll
                for (int ks = 0; ks < 4; ++ks) { const bf16x8 A = row_frag(lds + L_K + 16 * st * RS_QK + ks * 64, RS_QK, lane), B = row_frag(lds + L_Q + 16 * tt * RS_QK + ks * 64, RS_QK, lane); ap = MFMA16(A, B, ap); } }
            const int t = 16 * tt + l15, s0 = 16 * st + 4 * g4;
            u32x2 pk; pk.x = cvt_pk_bf16(s0 <= t ? ap[0] : 0.f, s0 + 1 <= t ? ap[1] : 0.f); pk.y = cvt_pk_bf16(s0 + 2 <= t ? ap[2] : 0.f, s0 + 3 <= t ? ap[3] : 0.f);
            *(LAS u32x2*)(lds + L_P + t * RS_P + s0 * 2) = pk; }
        __syncthreads();
        u32x2 rrv[4][2];
#pragma unroll
        for (int tt = 0; tt < 4; ++tt)
#pragma unroll
            for (int j2 = 0; j2 < 2; ++j2) rrv[tt][j2] = (16 * tt + l15 < nvalid) ? *(const u32x2*)(proj + (size_t)(tok0 + 16 * tt + l15) * PJ + PC_R + h * 256 + 32 * w + 16 * j2 + 4 * g4) : (u32x2){0u, 0u};
        f32x4 ao[2][4];
#pragma unroll
        for (int j2 = 0; j2 < 2; ++j2)
#pragma unroll
            for (int tt = 0; tt < 4; ++tt) ao[j2][tt] = (f32x4){0.f, 0.f, 0.f, 0.f};
#pragma unroll
        for (int ks = 0; ks < 2; ++ks) { bf16x8 Av[2];
#pragma unroll
            for (int j2 = 0; j2 < 2; ++j2) Av[j2] = tr_frag(lds + L_V + 32 * ks * RS_V + (32 * w + 16 * j2) * 2, RS_V, lane);
#pragma unroll
            for (int tt = 0; tt < 4; ++tt) { const bf16x8 Bp = row_frag(lds + L_P + 16 * tt * RS_P + ks * 64, RS_P, lane);
#pragma unroll
                for (int j2 = 0; j2 < 2; ++j2) ao[j2][tt] = MFMA16(Av[j2], Bp, ao[j2][tt]); } }
#pragma unroll
        for (int ks = 0; ks < 4; ++ks) { bf16x8 As[2];
#pragma unroll
            for (int j2 = 0; j2 < 2; ++j2) As[j2] = row_frag(lds + L_S + (32 * w + 16 * j2) * RS_S + ks * 64, RS_S, lane);
#pragma unroll
            for (int tt = 0; tt < 4; ++tt) { const bf16x8 Bq = row_frag(lds + L_Q + 16 * tt * RS_QK + ks * 64, RS_QK, lane);
#pragma unroll
                for (int j2 = 0; j2 < 2; ++j2) ao[j2][tt] = MFMA16(As[j2], Bq, ao[j2][tt]); } }
#pragma unroll
        for (int tt = 0; tt < 4; ++tt) { float ss = 0.f;
#pragma unroll
            for (int j2 = 0; j2 < 2; ++j2) ss += (ao[j2][tt][0] * ao[j2][tt][0] + ao[j2][tt][1] * ao[j2][tt][1]) + (ao[j2][tt][2] * ao[j2][tt][2] + ao[j2][tt][3] * ao[j2][tt][3]);
            ss += __shfl_xor(ss, 16); ss += __shfl_xor(ss, 32);
            if (g4 == 0) *(LAS float*)(lds + L_RED + (w * 64 + 16 * tt + l15) * 4) = ss; }
        __syncthreads();
#pragma unroll
        for (int tt = 0; tt < 4; ++tt) { const int t = 16 * tt + l15; float tot = 0.f;
#pragma unroll
            for (int ww = 0; ww < 8; ++ww) tot += *(const LAS float*)(lds + L_RED + (ww * 64 + t) * 4);
            const float rstd = rsqrtf(tot * (1.0f / 256.0f) + EPS);
            if (t < nvalid && !nostore) {
#pragma unroll
                for (int j2 = 0; j2 < 2; ++j2) { const int v0 = 32 * w + 16 * j2 + 4 * g4; bf16_t* rp = proj + (size_t)(tok0 + t) * PJ + PC_R + h * 256 + v0;
                    const u32x2 rr = rrv[tt][j2]; const f32x4 gn = *(const f32x4*)(p.gla_norm_w + v0); const f32x4 o = ao[j2][tt];
                    u32x2 pk; pk.x = cvt_pk_bf16(o[0] * rstd * gn[0] * siluf_(bflo(rr.x)), o[1] * rstd * gn[1] * siluf_(bfhi(rr.x)));
                    pk.y = cvt_pk_bf16(o[2] * rstd * gn[2] * siluf_(bflo(rr.y)), o[3] * rstd * gn[3] * siluf_(bfhi(rr.y)));
                    *(u32x2*)rp = pk; } } }
#pragma unroll
        for (int ks = 0; ks < 2; ++ks) { bf16x8 Bv[2];
#pragma unroll
            for (int j2 = 0; j2 < 2; ++j2) Bv[j2] = tr_frag(lds + L_V + 32 * ks * RS_V + (32 * w + 16 * j2) * 2, RS_V, lane);
#pragma unroll
            for (int kt = 0; kt < 8; ++kt) { const bf16x8 Ak = tr_frag(lds + L_K + 32 * ks * RS_QK + 16 * kt * 2, RS_QK, lane);
#pragma unroll
                for (int j2 = 0; j2 < 2; ++j2) acc[kt][j2] = MFMA16(Ak, Bv[j2], acc[kt][j2]); } }
#pragma unroll
        for (int kt = 0; kt < 8; ++kt) { const f32x4 d = *(const LAS f32x4*)(lds + (ch * 128 + 16 * kt + 4 * g4) * 4);
#pragma unroll
            for (int j2 = 0; j2 < 2; ++j2) acc[kt][j2] = acc[kt][j2] * d; }
        __syncthreads();
    }
#undef GLA_LOAD_TILES
    if (sample && !nostore) { float* so = p.out + OUT_SS + (size_t)(idx * 4 + h) * 128 * 256;
#pragma unroll
        for (int kt = 0; kt < 8; ++kt)
#pragma unroll
            for (int j2 = 0; j2 < 2; ++j2)
#pragma unroll
                for (int r = 0; r < 4; ++r) so[(size_t)(16 * kt + 4 * g4 + r) * 256 + 32 * w + 16 * j2 + l15] = acc[kt][j2][r];
    }
}
constexpr int G_VN = 0, G_WS = 67584, G_ST = 102400, RS_VN = 528, RS_WS = 272;
__device__ __forceinline__ void gmlp_item(const Params& p, LAS unsigned char* lds, int chunk, int g, bool nostore = false, bool build_ws = true) {
    int tid_ = threadIdx.x; asm volatile("" : "+v"(tid_));
    const int tid = tid_, lane = tid & 63, w = tid >> 6, g4 = lane >> 4, l15 = lane & 15;
    bf16_t* proj = (bf16_t*)(p.ws + WS_PROJ); const int tok0 = chunk * 128;
    u32x4 gvr[8]; u32x2 uzr[8][2];
#pragma unroll
    for (int i = 0; i < 8; ++i) { const int e = tid + 512 * i, r = e >> 5, c = e & 31; gvr[i] = *(const u32x4*)(proj + (size_t)(tok0 + r) * PJ + PC_GV + g * 256 + c * 8); }
#pragma unroll
    for (int it = 0; it < 8; ++it)
#pragma unroll
        for (int j2 = 0; j2 < 2; ++j2) uzr[it][j2] = *(const u32x2*)(proj + (size_t)(tok0 + 16 * it + l15) * PJ + PC_UZ + g * 256 + 32 * w + 16 * j2 + 4 * g4);
    if (tid < 128) { const float* gp = (const float*)(p.ws + WS_GVST) + (size_t)(tok0 + tid) * 32; float s = 0.f, q = 0.f;
#pragma unroll
        for (int k = 0; k < 8; ++k) { const f32x4 v = *(const f32x4*)(gp + 4 * k); s += v[0] + v[2]; q += v[1] + v[3]; }
        const float mean = s * (1.0f / 1024.0f), var = fmaxf(q * (1.0f / 1024.0f) - mean * mean, 0.f);
        *(LAS f32x2*)(lds + G_ST + tid * 8) = (f32x2){mean, rsqrtf(var + EPS)}; }
    if (build_ws)
#pragma unroll
    for (int i = 0; i < 8; ++i) { const int e = tid + 512 * i, r = e >> 5, j4 = (e & 31) * 4; f32x4 v = *(const f32x4*)(p.w_s + (size_t)(g * 128 + r) * 128 + j4);
        if (r < 64 && j4 >= 64) v = (f32x4){0.f, 0.f, 0.f, 0.f};
        u32x2 pk; pk.x = cvt_pk_bf16(v[0], v[1]); pk.y = cvt_pk_bf16(v[2], v[3]); *(LAS u32x2*)(lds + G_WS + r * RS_WS + j4 * 2) = pk; }
    __syncthreads();
#pragma unroll
    for (int i = 0; i < 8; ++i) { const int e = tid + 512 * i, r = e >> 5, c = e & 31; const u32x4 a = gvr[i];
        const f32x2 st = *(const LAS f32x2*)(lds + G_ST + r * 8); const float* lw = p.ln_v_w + g * 256 + c * 8; const float* lb = p.ln_v_b + g * 256 + c * 8;
        const f32x4 w0 = *(const f32x4*)lw, w1 = *(const f32x4*)(lw + 4), b0 = *(const f32x4*)lb, b1 = *(const f32x4*)(lb + 4);
        u32x4 o; o.x = cvt_pk_bf16((bflo(a.x) - st[0]) * st[1] * w0[0] + b0[0], (bfhi(a.x) - st[0]) * st[1] * w0[1] + b0[1]);
        o.y = cvt_pk_bf16((bflo(a.y) - st[0]) * st[1] * w0[2] + b0[2], (bfhi(a.y) - st[0]) * st[1] * w0[3] + b0[3]);
        o.z = cvt_pk_bf16((bflo(a.z) - st[0]) * st[1] * w1[0] + b1[0], (bfhi(a.z) - st[0]) * st[1] * w1[1] + b1[1]);
        o.w = cvt_pk_bf16((bflo(a.w) - st[0]) * st[1] * w1[2] + b1[2], (bfhi(a.w) - st[0]) * st[1] * w1[3] + b1[3]);
        *(LAS u32x4*)(lds + G_VN + r * RS_VN + c * 16) = o; }
    __syncthreads();
    f32x4 acc[2][8];
#pragma unroll
    for (int j2 = 0; j2 < 2; ++j2)
#pragma unroll
        for (int it = 0; it < 8; ++it) acc[j2][it] = (f32x4){0.f, 0.f, 0.f, 0.f};
#pragma unroll
    for (int ks = 0; ks < 4; ++ks) { bf16x8 Av[2];
#pragma unroll
        for (int j2 = 0; j2 < 2; ++j2) Av[j2] = tr_frag(lds + G_VN + 32 * ks * RS_VN + (32 * w + 16 * j2) * 2, RS_VN, lane);
#pragma unroll
        for (int it = 0; it < 8; ++it) { if (ks >= 2 && it < 4) continue; const bf16x8 Bw = row_frag(lds + G_WS + 16 * it * RS_WS + ks * 64, RS_WS, lane);
#pragma unroll
            for (int j2 = 0; j2 < 2; ++j2) acc[j2][it] = MFMA16(Av[j2], Bw, acc[j2][it]); } }
#pragma unroll
    for (int it = 0; it < 8; ++it) { const int i = 16 * it + l15; const float bs = p.b_s[g * 128 + i];
#pragma unroll
        for (int j2 = 0; j2 < 2; ++j2) { bf16_t* rp = proj + (size_t)(tok0 + i) * PJ + PC_UZ + g * 256 + 32 * w + 16 * j2 + 4 * g4; const u32x2 uz = uzr[it][j2]; const f32x4 a = acc[j2][it];
            u32x2 pk; pk.x = cvt_pk_bf16(bflo(uz.x) * (a[0] + bs), bfhi(uz.x) * (a[1] + bs)); pk.y = cvt_pk_bf16(bflo(uz.y) * (a[2] + bs), bfhi(uz.y) * (a[3] + bs)); if (!nostore) *(u32x2*)rp = pk; } }
    __syncthreads();
}
__device__ __forceinline__ void gmlp_sample_item(const Params& p, LAS unsigned char* lds, int b, bool nostore = false) {
    int tid_ = threadIdx.x; asm volatile("" : "+v"(tid_));
    const int tid = tid_, lane = tid & 63, w = tid >> 6; bf16_t* proj = (bf16_t*)(p.ws + WS_PROJ); const int tok0 = SEQ + b * SAMP_T;
    LAS float* vn = (LAS float*)lds; LAS float* wsm = (LAS float*)(lds + 65536); LAS float* st = (LAS float*)(lds + 65536 + 4096);
    for (int i = 0; i < 2; ++i) { const int r = 2 * w + i; const bf16_t* rp = proj + (size_t)(tok0 + r) * PJ + PC_GV;
        const u32x4 a = *(const u32x4*)(rp + lane * 8), bb = *(const u32x4*)(rp + 512 + lane * 8);
        float x[16]; x[0] = bflo(a.x); x[1] = bfhi(a.x); x[2] = bflo(a.y); x[3] = bfhi(a.y); x[4] = bflo(a.z); x[5] = bfhi(a.z); x[6] = bflo(a.w); x[7] = bfhi(a.w);
        x[8] = bflo(bb.x); x[9] = bfhi(bb.x); x[10] = bflo(bb.y); x[11] = bfhi(bb.y); x[12] = bflo(bb.z); x[13] = bfhi(bb.z); x[14] = bflo(bb.w); x[15] = bfhi(bb.w);
        float s = 0.f;
#pragma unroll
        for (int k = 0; k < 16; ++k) s += x[k];
        const float mean = wave_sum(s) * (1.0f / 1024.0f); float q = 0.f;
#pragma unroll
        for (int k = 0; k < 16; ++k) { const float d = x[k] - mean; q += d * d; }
        const float rstd = rsqrtf(wave_sum(q) * (1.0f / 1024.0f) + EPS);
        if (lane == 0) { st[r * 2] = mean; st[r * 2 + 1] = rstd; } }
    for (int e = tid; e < 1024; e += 512) { const int g = e >> 8, i = (e >> 4) & 15, j = e & 15; wsm[e] = p.w_s[(size_t)(g * 128 + i) * 128 + j]; }
    __syncthreads();
    float* vs = p.out + OUT_VS + (size_t)b * SAMP_T * 1024;
    for (int i = 0; i < 4; ++i) { const int e = tid + 512 * i, r = e >> 7, c = (e & 127) * 8; const u32x4 a = *(const u32x4*)(proj + (size_t)(tok0 + r) * PJ + PC_GV + c);
        const float mean = st[r * 2], rstd = st[r * 2 + 1]; const f32x4 w0 = *(const f32x4*)(p.ln_v_w + c), w1 = *(const f32x4*)(p.ln_v_w + c + 4), b0 = *(const f32x4*)(p.ln_v_b + c), b1 = *(const f32x4*)(p.ln_v_b + c + 4);
        f32x4 o0, o1; o0[0] = (bflo(a.x) - mean) * rstd * w0[0] + b0[0]; o0[1] = (bfhi(a.x) - mean) * rstd * w0[1] + b0[1]; o0[2] = (bflo(a.y) - mean) * rstd * w0[2] + b0[2]; o0[3] = (bfhi(a.y) - mean) * rstd * w0[3] + b0[3];
        o1[0] = (bflo(a.z) - mean) * rstd * w1[0] + b1[0]; o1[1] = (bfhi(a.z) - mean) * rstd * w1[1] + b1[1]; o1[2] = (bflo(a.w) - mean) * rstd * w1[2] + b1[2]; o1[3] = (bfhi(a.w) - mean) * rstd * w1[3] + b1[3];
        *(LAS f32x4*)(vn + r * 1024 + c) = o0; *(LAS f32x4*)(vn + r * 1024 + c + 4) = o1; *(f32x4*)(vs + r * 1024 + c) = o0; *(f32x4*)(vs + r * 1024 + c + 4) = o1; }
    __syncthreads();
    { const int c = tid * 2, g = c >> 8; f32x2 v[16];
#pragma unroll
      for (int j = 0; j < 16; ++j) v[j] = *(const LAS f32x2*)(vn + j * 1024 + c);
#pragma unroll
      for (int i = 0; i < 16; ++i) { float s0 = p.b_s[g * 128 + i], s1 = s0;
#pragma unroll
          for (int j = 0; j < 16; ++j) { const float wv = wsm[g * 256 + i * 16 + j]; s0 += wv * v[j][0]; s1 += wv * v[j][1]; }
          bf16_t* rp = proj + (size_t)(tok0 + i) * PJ + PC_UZ + c; const unsigned uz = *(const unsigned*)rp; if (!nostore) *(unsigned*)rp = cvt_pk_bf16(bflo(uz) * s0, bfhi(uz) * s1); } }
    __syncthreads();
}
__device__ __forceinline__ void phase4(const Params& p) {
    const unsigned* useg = (const unsigned*)((unsigned char*)p.out + RB_USEG); unsigned* sst = (unsigned*)((unsigned char*)p.out + RB_SSTART); const float* dseg = (const float*)(p.ws + WS_DSEG);
    int tid_ = threadIdx.x; asm volatile("" : "+v"(tid_)); const int tid = tid_; int bid_ = blockIdx.x; asm volatile("" : "+s"(bid_)); const int bid = bid_;
    for (int e2 = bid * 512 + tid; e2 < 65536; e2 += gridDim.x * 512) {
        const int e = e2 * 2, h = e >> 15, v = (e >> 7) & 255, kap = e & 127; float S0 = 0.f, S1 = 0.f;
        for (int s0 = 0; s0 < NSEG; s0 += 32) { unsigned u[32]; f32x2 dd[32];
#pragma unroll
            for (int s = 0; s < 32; ++s) { u[s] = __builtin_nontemporal_load(useg + (size_t)(s0 + s) * 65536 + e2); dd[s] = *(const f32x2*)(dseg + ((s0 + s) * 4 + h) * 128 + kap); }
#pragma unroll
            for (int s = 0; s < 32; ++s) { sst[(size_t)(s0 + s) * 65536 + e2] = cvt_pk_bf16(S0, S1); S0 = dd[s][0] * S0 + bflo(u[s]); S1 = dd[s][1] * S1 + bfhi(u[s]); } }
        p.out[OUT_SP + (size_t)(h * 128 + kap) * 256 + v] = S0; p.out[OUT_SP + (size_t)(h * 128 + kap + 1) * 256 + v] = S1; }
}
__device__ __forceinline__ void phase8(const Params& p, bool nostore = false) {
    int tid_ = threadIdx.x; asm volatile("" : "+v"(tid_)); const int tid = tid_; int bid_ = blockIdx.x; asm volatile("" : "+s"(bid_)); const int bid = bid_;
    const int lane = tid & 63, wv = tid >> 6;
    for (int row = SEQ + bid * 8 + wv; row < MTOT; row += gridDim.x * 8) { float* yr = p.out + (size_t)row * D;
        f32x4 v[4]; float ss = 0.f;
#pragma unroll
        for (int i = 0; i < 4; ++i) { v[i] = *(const f32x4*)(yr + i * 256 + lane * 4); ss += (v[i][0] * v[i][0] + v[i][1] * v[i][1]) + (v[i][2] * v[i][2] + v[i][3] * v[i][3]); }
        const float rstd = rsqrtf(wave_sum(ss) * (1.0f / D) + EPS);
#pragma unroll
        for (int i = 0; i < 4; ++i) { const int c = i * 256 + lane * 4; const f32x4 fw = *(const f32x4*)(p.final_norm_w + c); if (!nostore) *(f32x4*)(yr + c) = v[i] * rstd * fw; } }
}

__global__ __launch_bounds__(512, 2) void mega(Params p0) {
    extern __shared__ __attribute__((aligned(16))) unsigned char shm[];
    LAS unsigned char* lds = (LAS unsigned char*)shm;
    const bool multi = (p0.ph_hi - p0.ph_lo) > 1;
    if (multi) { volatile LAS unsigned* st = (volatile LAS unsigned*)(lds + LDS_BAR);
        if (threadIdx.x == 0) { st[0] = 0u; st[1] = 0u; }
        __syncthreads();
        (void)xcd_barrier_post((unsigned*)(p0.ws + WS_CTL), st); }
#ifdef PROBE_PH
    constexpr int PDUP = PROBE_PH >= 30 ? 3 : (PROBE_PH >= 20 ? 2 : PROBE_PH);
    const int nph = p0.ph_hi + 1;
#else
    const int nph = p0.ph_hi;
#endif
    for (int pi = p0.ph_lo; pi < nph; ++pi) {
#if defined(__HIP_DEVICE_COMPILE__)
        const __attribute__((address_space(4))) Params* kp = (const __attribute__((address_space(4))) Params*)__builtin_amdgcn_kernarg_segment_ptr();
        asm volatile("" : "+s"(kp));
        const Params p = *kp;
#else
        const Params p = p0;
#endif
        int bid_ = blockIdx.x; asm volatile("" : "+s"(bid_)); const int bid = bid_;
#ifdef PROBE_PH
        const int ph = pi > PDUP ? pi - 1 : pi; const bool first = (pi == PDUP); const bool nostore = first && (p.ph_hi < 100);
#else
        const int ph = pi; const bool nostore = false;
#endif
      {
        if (ph == 0) phase0(p, lds);
        else if (ph == 1) phase1(p);
        else if (ph == 2) { pg8::Order S; S.init(SEQ / 256, 32, gridDim.x, bid); Ptr1 P{(const char*)p.out + RB_H, (const char*)p.out + RB_BT1};
            Epi1 E{(bf16_t*)(p.ws + WS_PROJ), (float*)(p.ws + WS_GVST)};
#ifdef PROBE_PH
            if (!(first && PROBE_PH == 20)) pg8::gemm_phase<Epi1, Ptr1, pg8::Order>(lds, S, P, E, D, D, D);
            if (!(first && PROBE_PH == 21)) sample_gemm1(p, lds, bid);
#else
            if (bid & 1) sample_gemm1(p, lds, bid); pg8::gemm_phase<Epi1, Ptr1, pg8::Order>(lds, S, P, E, D, D, D); if (!(bid & 1)) sample_gemm1(p, lds, bid);
#endif
            }
        else if (ph == 3) {
            const int pm = (bid & 7) * 8 + (bid >> 5), hg = (bid >> 3) & 3;
            gla_segA(p, lds, pm, hg);
            gmlp_item(p, lds, 2 * pm, hg, nostore, true);
            gmlp_item(p, lds, 2 * pm + 1, hg, nostore, false);
            if (bid >= 16 && bid < 80) { const int it = bid - 16; gla_prep(p, lds, SEQ + (it >> 2) * SAMP_T, 1, SAMP_T, it & 3, 256 + (it >> 2), false, 0, 0); __syncthreads(); } }
        else if (ph == 4) { phase4(p); if (bid >= 128 && bid < 192) gla_out(p, lds, 1, (bid - 128) >> 2, (bid - 128) & 3, nostore);
            else if (bid >= 192 && bid < 208) gmlp_sample_item(p, lds, bid - 192, nostore); }
        else if (ph == 5) {
            gla_out(p, lds, 0, (bid & 7) * 8 + (bid >> 5), (bid >> 3) & 3, nostore); }
        else if (ph == 6) { pg8::Order2 S; S.c = bid; Ptr2 P{(const char*)(p.ws + WS_PROJ), (const char*)(p.ws + WS_BTA), (const char*)(p.ws + WS_BTB)};
            Epi2 E{(bf16_t*)(p.ws + WS_PROJ), p.b_gate, nostore}; if (bid & 1) sample_gemm2(p, bid, nostore); pg8::gemm_phase<Epi2, Ptr2, pg8::Order2>(lds, S, P, E, D, PJ, D); if (!(bid & 1)) sample_gemm2(p, bid, nostore); }
        else if (ph == 7) { pg8::Order S; S.init(SEQ / 256, 4, gridDim.x, bid); Ptr3 P{(const char*)(p.ws + WS_PROJ), (const char*)(p.ws + WS_BTO)};
            Epi3 E{p.x_prompt, (const float*)(p.ws + WS_ADA), p.final_norm_w, p.out, (float*)(p.ws + WS_XB), (unsigned*)(p.ws + WS_PCNT)}; if (bid & 1) sample_gemm3(p, bid); pg8::gemm_phase<Epi3, Ptr3, pg8::Order>(lds, S, P, E, D, PJ, D); if (!(bid & 1)) sample_gemm3(p, bid); }
        else if (ph == 8) phase8(p, nostore);
      }
        if (multi && pi + 1 < nph) { XcdBarrier xb; xb.bar = (unsigned*)(p.ws + WS_CTL); xb.x = xb_xcc_id(); xb.st = (volatile LAS unsigned*)(lds + LDS_BAR); xcd_barrier(xb); }
    }
}

#ifndef MK_LAUNCHES
#define MK_LAUNCHES 1
#endif
extern "C" void kernel_launch(void* const* d_in, const int* in_sizes, int n_in, void* d_out, int out_size, void* d_ws, size_t ws_size, hipStream_t stream) {
    static int ready = 0;
    if (ready == 0) {
        if (n_in != 21 || ws_size < WS_END) { fprintf(stderr, "kernel_launch: need 21 inputs and >= %zu bytes of workspace (got %d, %zu)\n", (size_t)WS_END, n_in, ws_size); ready = -1; return; }
        if (hipFuncSetAttribute((const void*)mega, hipFuncAttributeMaxDynamicSharedMemorySize, LDS_BYTES) != hipSuccess) { fprintf(stderr, "kernel_launch: hipFuncSetAttribute failed\n"); ready = -1; return; }
        int per_cu = 0; (void)hipOccupancyMaxActiveBlocksPerMultiprocessor(&per_cu, (const void*)mega, 512, LDS_BYTES); (void)hipGetLastError();
        if (per_cu < 1) fprintf(stderr, "kernel_launch: occupancy query reports %d blocks per CU\n", per_cu);
        ready = 1;
    }
    if (ready < 0) return;
    (void)hipMemsetAsync((char*)d_ws + WS_CTL, 0, 32768, stream);
    Params p{};
    const float** pp = (const float**)&p;
    for (int i = 0; i < 21; ++i) pp[i] = (const float*)d_in[i];
    p.out = (float*)d_out; p.ws = (unsigned char*)d_ws;
    const int nl = MK_LAUNCHES;
    for (int li = 0; li < nl; ++li) {
        p.ph_lo = (nl == 1) ? 0 : li; p.ph_hi = (nl == 1) ? 9 : li + 1;
        void* args[] = {&p};
        hipError_t e;
        if (nl == 1) e = hipLaunchCooperativeKernel((const void*)mega, dim3(256), dim3(512), args, LDS_BYTES, stream);
        else { hipLaunchKernelGGL(mega, dim3(256), dim3(512), LDS_BYTES, stream, p); e = hipPeekAtLastError(); }
        if (e != hipSuccess) { fprintf(stderr, "kernel_launch: launch %d failed: %s\n", li, hipGetErrorString(e)); break; }
    }
}
```

```cpp
#include <hip/hip_runtime.h>
#include <cstdio>

#define LAS __attribute__((address_space(3)))
typedef unsigned short bf16_t;
typedef short bf16x8 __attribute__((ext_vector_type(8)));
typedef short s16x4 __attribute__((ext_vector_type(4)));
typedef float f32x4 __attribute__((ext_vector_type(4)));
typedef float f32x2 __attribute__((ext_vector_type(2)));
typedef unsigned u32x4 __attribute__((ext_vector_type(4)));
typedef unsigned u32x2 __attribute__((ext_vector_type(2)));

constexpr int D = 1024, SEQ = 16384, NSAMP = 16, SAMP_T = 16, MTOT = SEQ + NSAMP * SAMP_T;
constexpr int WIN_LD = 8208;
constexpr int PJ = 7168;
constexpr int PC_Q = 0, PC_K = 512, PC_V = 1024, PC_R = 2048, PC_UZ = 3072, PC_GV = 4096, PC_GA = 5120;
constexpr int N1 = 8256;
constexpr int NSEG = 64, SEGCH = 4;
constexpr float EPS = 1e-6f;
constexpr size_t WS_CTL = 0, WS_PCNT = 16384, WS_ADA = 32768, WS_ALR = WS_ADA + 17 * 3072 * 4, WS_DSEG = WS_ALR + (size_t)MTOT * 16 * 4,
                 WS_ROWSS = WS_DSEG + NSEG * 4 * 128 * 4, WS_BTA = WS_ROWSS + (size_t)MTOT * 16 * 4, WS_BTB = WS_BTA + 2097152,
                 WS_BTO = WS_BTB + 2097152, WS_PROJ = WS_BTO + 4194304, WS_GVST = WS_PROJ + (size_t)MTOT * PJ * 2, WS_DCH = WS_GVST + (size_t)SEQ * 16 * 8, WS_XB = WS_DCH + (size_t)272 * 4 * 128 * 4, WS_END = WS_XB + (size_t)64 * 256 * 4 * 4;
constexpr size_t RB_H = 0, RB_BT1 = (size_t)MTOT * D * 2, RB_USEG = 0, RB_SSTART = 16777216;
constexpr size_t OUT_YS = (size_t)SEQ * D, OUT_SP = OUT_YS + 256 * D, OUT_SS = OUT_SP + 4 * 128 * 256, OUT_VS = OUT_SS + 16 * 4 * 128 * 256;
constexpr int LDS_BAR = 156160, LDS_BYTES = 156672;

struct Params {
    const float* x_prompt; const float* x_sample; const float* state_gla; const float* c_prompt; const float* c_sample;
    const float* norm_w; const float* w_ada; const float* b_ada; const float* w_in; const float* w_a2; const float* b_a;
    const float* gla_norm_w; const float* ln_v_w; const float* ln_v_b; const float* w_s; const float* b_s; const float* b_gate;
    const float* w_proj_a; const float* w_proj_b; const float* w_out; const float* final_norm_w;
    float* out; unsigned char* ws; int ph_lo; int ph_hi;
};

__device__ __forceinline__ unsigned cvt_pk_bf16(float lo, float hi) { unsigned r; asm volatile("v_cvt_pk_bf16_f32 %0, %1, %2" : "=v"(r) : "v"(lo), "v"(hi)); return r; }
__device__ __forceinline__ bf16_t f2bf(float f) { return (bf16_t)(cvt_pk_bf16(f, 0.f) & 0xffffu); }
__device__ __forceinline__ float bf2f(bf16_t b) { return __uint_as_float(((unsigned)b) << 16); }
__device__ __forceinline__ float bflo(unsigned w) { return __uint_as_float(w << 16); }
__device__ __forceinline__ float bfhi(unsigned w) { return __uint_as_float(w & 0xffff0000u); }
__device__ __forceinline__ float sigmoidf_(float x) { return __builtin_amdgcn_rcpf(1.0f + __expf(-x)); }
__device__ __forceinline__ float siluf_(float x) { return x * __builtin_amdgcn_rcpf(1.0f + __expf(-x)); }
__device__ __forceinline__ float wave_sum(float v) {
#pragma unroll
    for (int o = 32; o > 0; o >>= 1) v += __shfl_xor(v, o);
    return v;
}
__device__ __forceinline__ bf16x8 row_frag(const LAS unsigned char* base, int rs, int lane) { return *(const LAS bf16x8*)(base + rs * (lane & 15) + 16 * (lane >> 4)); }
__device__ __forceinline__ bf16x8 tr_frag(const LAS unsigned char* base, int rs, int lane) {
    const int g = lane >> 4, q = (lane & 15) >> 2, pp = lane & 3;
    const LAS unsigned char* a = base + rs * (8 * g + q) + 8 * pp;
    const s16x4 lo = __builtin_amdgcn_ds_read_tr16_b64_v4i16((LAS s16x4*)a);
    const s16x4 hi = __builtin_amdgcn_ds_read_tr16_b64_v4i16((LAS s16x4*)(a + 4 * rs));
    bf16x8 r; r[0] = lo[0]; r[1] = lo[1]; r[2] = lo[2]; r[3] = lo[3]; r[4] = hi[0]; r[5] = hi[1]; r[6] = hi[2]; r[7] = hi[3]; return r;
}
#define MFMA16(a, b, c) __builtin_amdgcn_mfma_f32_16x16x32_bf16(a, b, c, 0, 0, 0)

#define XB_TMO      128
#define XB_XCNT(j)  (256  + 64 * (j))
#define XB_XSUB(j)  (1280 + 64 * (j))
#define XB_XGEN(j)  (2304 + 64 * (j))
#define XB_TOP      3328
#define XB_TOPGEN   3392
#define XCD_BAR_WORDS 3456
#define XB_SPIN_CAP (1u << 22)
__device__ __forceinline__ unsigned xb_ld(unsigned* p)              { return __hip_atomic_load(p, __ATOMIC_RELAXED, __HIP_MEMORY_SCOPE_AGENT); }
__device__ __forceinline__ unsigned xb_add(unsigned* p, unsigned v) { return __hip_atomic_fetch_add(p, v, __ATOMIC_RELAXED, __HIP_MEMORY_SCOPE_AGENT); }
__device__ __forceinline__ unsigned xb_xcc_id() { return (unsigned)__builtin_amdgcn_s_getreg((3 << 11) | 20) & 0xFu; }
#define XB_SPIN(cond, bar) do { unsigned _sp = 0; while (cond) { __builtin_amdgcn_s_sleep(1); \
    if ((++_sp & 255u) == 0u) { if (xb_ld(&(bar)[XB_TMO])) break; if (_sp > XB_SPIN_CAP) { atomicAdd(&(bar)[XB_TMO], 1u); break; } } } } while (0)
struct XcdBarrier { unsigned* bar; unsigned x; volatile LAS unsigned* st; };
__device__ __forceinline__ XcdBarrier xcd_barrier_post(unsigned* bar, volatile LAS unsigned* st) {
    XcdBarrier b; b.bar = bar; b.x = xb_xcc_id(); b.st = st;
    if (threadIdx.x == 0) (void)xb_add(&bar[XB_XCNT(b.x)], 1u);
    return b;
}
__device__ __forceinline__ void xcd_barrier_complete(unsigned* bar, unsigned x, unsigned& nloc, unsigned& nx) {
    const unsigned G = gridDim.x * gridDim.y * gridDim.z;
    unsigned sum, cnt, mine, sp = 0u;
    for (;;) {
        sum = 0u; cnt = 0u; mine = 0u;
#pragma unroll
        for (unsigned j = 0; j < 16; ++j) { const unsigned c = xb_ld(&bar[XB_XCNT(j)]); sum += c; cnt += (c > 0u) ? 1u : 0u; mine = (j == x) ? c : mine; }
        if (sum == G) break;
        __builtin_amdgcn_s_sleep(1);
        if ((++sp & 255u) == 0u) { if (xb_ld(&bar[XB_TMO])) break; if (sp > XB_SPIN_CAP) { atomicAdd(&bar[XB_TMO], 1u); break; } }
    }
    nloc = mine > 0u ? mine : 1u; nx = cnt > 0u ? cnt : 1u;
}
__device__ __forceinline__ void xcd_barrier(const XcdBarrier& b) {
    asm volatile("s_waitcnt vmcnt(0)" ::: "memory");
    __syncthreads();
    if (threadIdx.x == 0) {
        unsigned* bar = b.bar;
        __builtin_amdgcn_s_waitcnt(0);
        unsigned nloc = b.st[0], nx = b.st[1];
        if (nloc == 0u) { xcd_barrier_complete(bar, b.x, nloc, nx); b.st[0] = nloc; b.st[1] = nx; }
        const unsigned old = xb_add(&bar[XB_XSUB(b.x)], 1u);
        const unsigned gen = old / nloc;
        if (old + 1u == (gen + 1u) * nloc) {
            __builtin_amdgcn_fence(__ATOMIC_RELEASE, "agent");
            asm volatile("s_waitcnt vmcnt(0)" ::: "memory");
            const unsigned og = xb_add(&bar[XB_TOP], 1u);
            const unsigned tg = og / nx;
            if (og + 1u == (tg + 1u) * nx) xb_add(&bar[XB_TOPGEN], 1u);
            else XB_SPIN(xb_ld(&bar[XB_TOPGEN]) == tg, bar);
            __builtin_amdgcn_fence(__ATOMIC_ACQUIRE, "agent");
            xb_add(&bar[XB_XGEN(b.x)], 1u);
            asm volatile("s_waitcnt vmcnt(0)" ::: "memory");
        } else {
            XB_SPIN(xb_ld(&bar[XB_XGEN(b.x)]) == gen, bar);
            __builtin_amdgcn_fence(__ATOMIC_ACQUIRE, "agent");
            asm volatile("s_waitcnt vmcnt(0)" ::: "memory");
        }
    }
    __syncthreads();
}

namespace pg8 {
constexpr int BM = 256, BK = 64, HALF = 128, HTB = HALF * BK * 2, NXCD = 8, WGM = 8;
__device__ __forceinline__ int lds_byte(int r, int c) { const int st = (r >> 4) * 2 + (c >> 5), rr = r & 15, cc = c & 31, ob = rr * 64 + cc * 2; return st * 1024 + (ob ^ (((ob >> 9) & 1) << 5)); }
__device__ __forceinline__ void stage_rc(int b, int& R, int& C) { const int st = b / 1024, sb = b % 1024, swz = sb ^ (((sb >> 9) & 1) << 5); R = (st >> 1) * 16 + swz / 64; C = (st & 1) * 32 + (swz % 64) / 2; }
__device__ __forceinline__ int perm32(int rho) { const int n = rho >> 4, i = rho & 15; return 8 * (i >> 2) + 4 * n + (i & 3); }
struct Unit { int pm, pn; };
struct Order {
    int nM, nN, nwg, G, c;
    __device__ void init(int nM_, int nN_, int G_, int c_) { nM = nM_; nN = nN_; nwg = nM * nN; G = G_; c = c_; }
    __device__ bool next(int i, Unit& u) const {
        const long L = (long)i * G + c; if (L >= nwg) return false;
        int wgid = (int)L; { const int q = nwg / NXCD, r = nwg % NXCD, xcd = wgid % NXCD, off = wgid / NXCD; wgid = (xcd < r ? xcd * (q + 1) : r * (q + 1) + (xcd - r) * q) + off; }
        const int nig = WGM * nN, gid = wgid / nig, fm = gid * WGM, gsz = (nM - fm) < WGM ? (nM - fm) : WGM;
        u.pm = fm + ((wgid % nig) % gsz); u.pn = (wgid % nig) / gsz; return true;
    }
};
struct Order2 {
    int c;
    __device__ bool next(int i, Unit& u) const { if (i >= 2) return false; const int x = c & 7, q = c >> 3; u.pm = x * 8 + (q >> 2); u.pn = (q & 3) + 4 * i; return true; }
};
template <class Epi, class Ptr, class Ord>
__device__ __forceinline__ void gemm_phase(LAS unsigned char* lds, const Ord& S, const Ptr& P, const Epi& E, int K, int lda, int ldb) {
    int tid_ = threadIdx.x; asm volatile("" : "+v"(tid_));
    const int tid = tid_, wid = __builtin_amdgcn_readfirstlane(tid >> 6), lane = tid & 63, wr = wid >> 2, wc = wid & 3, fr = lane & 15, fq = lane >> 4;
    const int nt = K / BK;
    unsigned voffA[2], voffB[2];
#pragma unroll
    for (int i = 0; i < 2; ++i) { int R, C; stage_rc(tid * 16 + i * 8192, R, C); const int Rb = Epi::PERM ? ((R & ~31) + perm32(R & 31)) : R;
        voffA[i] = (unsigned)(R * lda + C) * 2u; voffB[i] = (unsigned)(Rb * ldb + C) * 2u; }
    const size_t kstep = (size_t)(BK * 2);
    const size_t hstepA = (size_t)HALF * lda * 2, hstepB = (size_t)HALF * ldb * 2;
    const unsigned ldsw = (unsigned)wid * 1024u;
    const int aoff = lds_byte(wr * 64 + fr, fq * 8), boff = lds_byte(wc * 32 + fr, fq * 8);
#define PG8_SA(b, h) (((b) * 2 + (h)) * HTB)
#define PG8_SB(b, h) ((4 + (b) * 2 + (h)) * HTB)
#define PG8_STAGE(bufoff, gbase, voff) do { _Pragma("unroll") for (int _i = 0; _i < 2; ++_i) \
        __builtin_amdgcn_global_load_lds((const unsigned*)((const char*)(gbase) + (voff)[_i]), (LAS unsigned*)(lds + (bufoff) + ldsw + _i * 8192), 16, 0, 0); } while (0)
#define PG8_LDA(dst, b, h) do { _Pragma("unroll") for (int m = 0; m < 4; ++m) _Pragma("unroll") for (int k = 0; k < 2; ++k) dst[m][k] = *(const LAS bf16x8*)(lds + PG8_SA(b, h) + aoff + m * 2048 + k * 1024); } while (0)
#define PG8_LDB(dst, b, h) do { _Pragma("unroll") for (int n = 0; n < 2; ++n) _Pragma("unroll") for (int k = 0; k < 2; ++k) dst[n][k] = *(const LAS bf16x8*)(lds + PG8_SB(b, h) + boff + n * 2048 + k * 1024); } while (0)
#define PG8_MMA(ai, bj, At, Bt) do { __builtin_amdgcn_s_setprio(1); _Pragma("unroll") for (int m = 0; m < 4; ++m) _Pragma("unroll") for (int n = 0; n < 2; ++n) _Pragma("unroll") for (int k = 0; k < 2; ++k) \
        acc[ai][bj][m][n] = __builtin_amdgcn_mfma_f32_16x16x32_bf16(Bt[n][k], At[m][k], acc[ai][bj][m][n], 0, 0, 0); __builtin_amdgcn_s_setprio(0); } while (0)
#define PG8_WAIT_V(n) asm volatile("s_waitcnt vmcnt(" #n ")" ::: "memory")
#define PG8_WAIT_L(n) asm volatile("s_waitcnt lgkmcnt(" #n ")" ::: "memory")
#define PG8_BAR __builtin_amdgcn_s_barrier()
#define PG8_SCHED __builtin_amdgcn_sched_barrier(0)
    Unit cur, nxt; int ui = 0;
    if (!S.next(0, cur)) return;
    f32x4 acc[2][2][4][2];
#pragma unroll
    for (int a = 0; a < 2; ++a)
#pragma unroll
        for (int b = 0; b < 2; ++b)
#pragma unroll
            for (int m = 0; m < 4; ++m)
#pragma unroll
                for (int n = 0; n < 2; ++n) acc[a][b][m][n] = (f32x4){0.f, 0.f, 0.f, 0.f};
    bf16x8 At[4][2], B0[2][2], B1[2][2];
    const char* cA = P.aptr(cur); const char* cB = P.bptr(cur);
    PG8_STAGE(PG8_SB(0, 0), cB, voffB); PG8_STAGE(PG8_SA(0, 0), cA, voffA); PG8_STAGE(PG8_SB(0, 1), cB + hstepB, voffB); PG8_STAGE(PG8_SA(0, 1), cA + hstepA, voffA);
    if (wr == 1) PG8_BAR;
    PG8_WAIT_V(4); PG8_BAR;
    PG8_STAGE(PG8_SB(1, 0), cB + kstep, voffB); PG8_STAGE(PG8_SA(1, 0), cA + kstep, voffA); PG8_STAGE(PG8_SB(1, 1), cB + hstepB + kstep, voffB);
    PG8_WAIT_V(6); PG8_BAR;
    for (;;) {
        const bool has_next = S.next(ui + 1, nxt);
        const char* nA = has_next ? P.aptr(nxt) : cA; const char* nB = has_next ? P.bptr(nxt) : cB;
        for (int t = 0; t < nt; t += 2) {
            const bool last = (t == nt - 2);
            const char* a1 = cA + (size_t)(t + 1) * kstep;
            const char* a2 = last ? nA : cA + (size_t)(t + 2) * kstep; const char* b2 = last ? nB : cB + (size_t)(t + 2) * kstep;
            const char* a3 = a2 + kstep; const char* b3 = b2 + kstep;
            PG8_LDB(B0, 0, 0); PG8_SCHED; PG8_LDA(At, 0, 0); PG8_STAGE(PG8_SA(1, 1), a1 + hstepA, voffA);
            PG8_WAIT_L(8); PG8_BAR; PG8_WAIT_L(0); PG8_MMA(0, 0, At, B0); PG8_BAR; PG8_SCHED;
            PG8_LDB(B1, 0, 1); PG8_STAGE(PG8_SB(0, 0), b2, voffB);
            PG8_BAR; PG8_WAIT_L(0); PG8_MMA(0, 1, At, B1); PG8_BAR;
            PG8_LDA(At, 0, 1); PG8_STAGE(PG8_SA(0, 0), a2, voffA);
            PG8_BAR; PG8_WAIT_L(0); PG8_MMA(1, 0, At, B0); PG8_BAR; PG8_SCHED;
            PG8_STAGE(PG8_SB(0, 1), b2 + hstepB, voffB);
            PG8_WAIT_V(6); PG8_BAR; PG8_MMA(1, 1, At, B1); PG8_BAR;
            PG8_LDB(B0, 1, 0); PG8_SCHED; PG8_LDA(At, 1, 0); PG8_STAGE(PG8_SA(0, 1), a2 + hstepA, voffA);
            PG8_WAIT_L(8); PG8_BAR; PG8_WAIT_L(0); PG8_MMA(0, 0, At, B0); PG8_BAR; PG8_SCHED;
            PG8_LDB(B1, 1, 1); PG8_STAGE(PG8_SB(1, 0), b3, voffB);
            PG8_BAR; PG8_WAIT_L(0); PG8_MMA(0, 1, At, B1); PG8_BAR;
            PG8_LDA(At, 1, 1); PG8_STAGE(PG8_SA(1, 0), a3, voffA);
            PG8_BAR; PG8_WAIT_L(0); PG8_MMA(1, 0, At, B0); PG8_BAR; PG8_SCHED;
            PG8_STAGE(PG8_SB(1, 1), b3 + hstepB, voffB);
            PG8_WAIT_V(6); PG8_BAR; PG8_MMA(1, 1, At, B1); PG8_BAR;
        }
        bool keep = false;
        if constexpr (!Epi::AFTER_DRAIN) keep = E(acc, cur, wr, wc, fr, fq);
        if (!has_next) break;
        if (!keep) {
#pragma unroll
        for (int a = 0; a < 2; ++a)
#pragma unroll
            for (int b = 0; b < 2; ++b)
#pragma unroll
                for (int m = 0; m < 4; ++m)
#pragma unroll
                    for (int n = 0; n < 2; ++n) acc[a][b][m][n] = (f32x4){0.f, 0.f, 0.f, 0.f};
        }
        cur = nxt; cA = nA; cB = nB; ++ui;
    }
    PG8_WAIT_V(0);
    if (wr == 0) PG8_BAR;
    PG8_BAR;
    if constexpr (Epi::AFTER_DRAIN) E.fused(acc, cur, wr, wc, fr, fq, lds, wid, lane);
#undef PG8_SA
#undef PG8_SB
#undef PG8_STAGE
#undef PG8_LDA
#undef PG8_LDB
#undef PG8_MMA
#undef PG8_WAIT_V
#undef PG8_WAIT_L
#undef PG8_BAR
#undef PG8_SCHED
}
}
using pg8::Unit;

struct Ptr1 { const char* A; const char* B; __device__ const char* aptr(const Unit& u) const { return A + (size_t)u.pm * 256 * D * 2; } __device__ const char* bptr(const Unit& u) const { return B + (size_t)u.pn * 256 * D * 2; } };
struct Epi1 {
    static constexpr bool PERM = true, AFTER_DRAIN = false;
    bf16_t* proj; float* gvst;
    __device__ __forceinline__ bool operator()(f32x4 (&acc)[2][2][4][2], const Unit& u, int wr, int wc, int fr, int fq) const {
        asm volatile("" : "+v"(fr), "+v"(fq));
        const int row0 = u.pm * 256 + wr * 64 + fr;
        if (u.pn >= 12 && u.pn < 20) {
            const int col = PC_UZ + (u.pn - 12) * 128 + wc * 32 + 8 * fq;
#pragma unroll
            for (int ai = 0; ai < 2; ++ai)
#pragma unroll
                for (int m = 0; m < 4; ++m) { bf16_t* rp = proj + (size_t)(row0 + ai * 128 + m * 16) * PJ + col;
                    const f32x4 u0 = acc[ai][0][m][0], u1 = acc[ai][0][m][1], z0 = acc[ai][1][m][0], z1 = acc[ai][1][m][1];
                    u32x4 w; w.x = cvt_pk_bf16(u0[0] * siluf_(z0[0]), u0[1] * siluf_(z0[1])); w.y = cvt_pk_bf16(u0[2] * siluf_(z0[2]), u0[3] * siluf_(z0[3]));
                    w.z = cvt_pk_bf16(u1[0] * siluf_(z1[0]), u1[1] * siluf_(z1[1])); w.w = cvt_pk_bf16(u1[2] * siluf_(z1[2]), u1[3] * siluf_(z1[3]));
                    __builtin_nontemporal_store(w, (u32x4*)rp); }
            return false;
        }
        const int col = (u.pn < 12 ? u.pn * 256 : PC_GV + (u.pn - 20) * 256) + wc * 32 + 8 * fq;
        const bool isgv = u.pn >= 20 && u.pn < 24;
#pragma unroll
        for (int ai = 0; ai < 2; ++ai)
#pragma unroll
            for (int m = 0; m < 4; ++m) { const int row = row0 + ai * 128 + m * 16; bf16_t* rp = proj + (size_t)row * PJ + col; float s = 0.f, q = 0.f;
#pragma unroll
                for (int bj = 0; bj < 2; ++bj) { const f32x4 v0 = acc[ai][bj][m][0], v1 = acc[ai][bj][m][1];
                    u32x4 w; w.x = cvt_pk_bf16(v0[0], v0[1]); w.y = cvt_pk_bf16(v0[2], v0[3]); w.z = cvt_pk_bf16(v1[0], v1[1]); w.w = cvt_pk_bf16(v1[2], v1[3]);
                    __builtin_nontemporal_store(w, (u32x4*)(rp + bj * 128));
                    s += (v0[0] + v0[1]) + (v0[2] + v0[3]) + (v1[0] + v1[1]) + (v1[2] + v1[3]);
                    q += (v0[0] * v0[0] + v0[1] * v0[1]) + (v0[2] * v0[2] + v0[3] * v0[3]) + (v1[0] * v1[0] + v1[1] * v1[1]) + (v1[2] * v1[2] + v1[3] * v1[3]); }
                if (isgv) { s += __shfl_xor(s, 16); s += __shfl_xor(s, 32); q += __shfl_xor(q, 16); q += __shfl_xor(q, 32);
                    if (fq == 0) *(f32x2*)(gvst + ((size_t)row * 16 + (u.pn - 20) * 4 + wc) * 2) = (f32x2){s, q}; } }
        return false;
    }
};
struct Ptr2 { const char* proj; const char* BA; const char* BB;
    __device__ const char* aptr(const Unit& u) const { return proj + ((size_t)u.pm * 256 * PJ + (u.pn < 4 ? PC_R : PC_UZ)) * 2; }
    __device__ const char* bptr(const Unit& u) const { return (u.pn < 4 ? BA : BB) + (size_t)(u.pn & 3) * 256 * D * 2; } };
struct Epi2 {
    static constexpr bool PERM = true, AFTER_DRAIN = false;
    bf16_t* proj; const float* b_gate; bool nostore;
    __device__ __forceinline__ bool operator()(f32x4 (&acc)[2][2][4][2], const Unit& u, int wr, int wc, int fr, int fq) const {
        asm volatile("" : "+v"(fr), "+v"(fq));
        const int row0 = u.pm * 256 + wr * 64 + fr, col = (u.pn & 3) * 256 + wc * 32 + 8 * fq; const bool first = u.pn < 4;
        bf16_t* base = proj + (size_t)row0 * PJ + PC_GA + col;
        if (first) {
#pragma unroll
            for (int bj = 0; bj < 2; ++bj) { const float* ba = b_gate + col + bj * 128; const f32x4 bA0 = *(const f32x4*)ba, bA1 = *(const f32x4*)(ba + 4), bB0 = *(const f32x4*)(ba + 1024), bB1 = *(const f32x4*)(ba + 1028);
#pragma unroll
                for (int ai = 0; ai < 2; ++ai) { u32x4 ga[4], gb[4];
#pragma unroll
                    for (int m = 0; m < 4; ++m) { const bf16_t* rp = base + (size_t)(ai * 128 + m * 16) * PJ + bj * 128; ga[m] = *(const u32x4*)rp; gb[m] = *(const u32x4*)(rp + 1024); }
                    __builtin_amdgcn_sched_barrier(0);
#pragma unroll
                    for (int m = 0; m < 4; ++m) { float ea[8], eb[8];
                        ea[0] = __expf(-(bflo(ga[m].x) + bA0[0])); ea[1] = __expf(-(bfhi(ga[m].x) + bA0[1])); ea[2] = __expf(-(bflo(ga[m].y) + bA0[2])); ea[3] = __expf(-(bfhi(ga[m].y) + bA0[3]));
                        ea[4] = __expf(-(bflo(ga[m].z) + bA1[0])); ea[5] = __expf(-(bfhi(ga[m].z) + bA1[1])); ea[6] = __expf(-(bflo(ga[m].w) + bA1[2])); ea[7] = __expf(-(bfhi(ga[m].w) + bA1[3]));
                        eb[0] = __expf(-(bflo(gb[m].x) + bB0[0])); eb[1] = __expf(-(bfhi(gb[m].x) + bB0[1])); eb[2] = __expf(-(bflo(gb[m].y) + bB0[2])); eb[3] = __expf(-(bfhi(gb[m].y) + bB0[3]));
                        eb[4] = __expf(-(bflo(gb[m].z) + bB1[0])); eb[5] = __expf(-(bfhi(gb[m].z) + bB1[1])); eb[6] = __expf(-(bflo(gb[m].w) + bB1[2])); eb[7] = __expf(-(bfhi(gb[m].w) + bB1[3]));
#pragma unroll
                        for (int j = 0; j < 4; ++j) { acc[ai][bj][m][0][j] *= (1.0f + eb[j]) * __builtin_amdgcn_rcpf(1.0f + ea[j]); acc[ai][bj][m][1][j] *= (1.0f + eb[4 + j]) * __builtin_amdgcn_rcpf(1.0f + ea[4 + j]); } } } }
            return true;
        }
#pragma unroll
        for (int bj = 0; bj < 2; ++bj) { const float* ba = b_gate + col + bj * 128; const f32x4 bB0 = *(const f32x4*)(ba + 1024), bB1 = *(const f32x4*)(ba + 1028);
#pragma unroll
            for (int ai = 0; ai < 2; ++ai) { u32x4 gb[4];
#pragma unroll
                for (int m = 0; m < 4; ++m) gb[m] = *(const u32x4*)(base + (size_t)(ai * 128 + m * 16) * PJ + bj * 128 + 1024);
                __builtin_amdgcn_sched_barrier(0);
#pragma unroll
                for (int m = 0; m < 4; ++m) { float sb[8];
                    sb[0] = sigmoidf_(bflo(gb[m].x) + bB0[0]); sb[1] = sigmoidf_(bfhi(gb[m].x) + bB0[1]); sb[2] = sigmoidf_(bflo(gb[m].y) + bB0[2]); sb[3] = sigmoidf_(bfhi(gb[m].y) + bB0[3]);
                    sb[4] = sigmoidf_(bflo(gb[m].z) + bB1[0]); sb[5] = sigmoidf_(bfhi(gb[m].z) + bB1[1]); sb[6] = sigmoidf_(bflo(gb[m].w) + bB1[2]); sb[7] = sigmoidf_(bfhi(gb[m].w) + bB1[3]);
                    const f32x4 v0 = acc[ai][bj][m][0], v1 = acc[ai][bj][m][1];
                    u32x4 w; w.x = cvt_pk_bf16(v0[0] * sb[0], v0[1] * sb[1]); w.y = cvt_pk_bf16(v0[2] * sb[2], v0[3] * sb[3]); w.z = cvt_pk_bf16(v1[0] * sb[4], v1[1] * sb[5]); w.w = cvt_pk_bf16(v1[2] * sb[6], v1[3] * sb[7]);
                    if (!nostore) *(u32x4*)(base + (size_t)(ai * 128 + m * 16) * PJ + bj * 128) = w; } } }
        return false;
    }
};
struct Ptr3 { const char* proj; const char* BO;
    __device__ const char* aptr(const Unit& u) const { return proj + ((size_t)u.pm * 256 * PJ + PC_GA) * 2; }
    __device__ const char* bptr(const Unit& u) const { return BO + (size_t)u.pn * 256 * D * 2; } };
struct Epi3 {
    static constexpr bool PERM = false, AFTER_DRAIN = true;
    const float* xp; const float* ada; const float* fw; float* out; float* xbuf; unsigned* cnt;
    __device__ __forceinline__ bool operator()(f32x4 (&acc)[2][2][4][2], const Unit& u, int wr, int wc, int fr, int fq) const { return false; }
    __device__ __forceinline__ void fused(f32x4 (&acc)[2][2][4][2], const Unit& u, int wr, int wc, int fr, int fq, LAS unsigned char* lds, int wid, int lane) const {
        asm volatile("" : "+v"(fr), "+v"(fq));
        LAS float* P = (LAS float*)lds; LAS float* S = (LAS float*)(lds + 4096);
        const int row0 = u.pm * 256 + wr * 64 + fr, col0 = u.pn * 256 + wc * 32 + 4 * fq;
        f32x4 gt[4];
#pragma unroll
        for (int q = 0; q < 4; ++q) gt[q] = *(const f32x4*)(ada + 2048 + col0 + (q >> 1) * 128 + (q & 1) * 16);
#pragma unroll
        for (int ai = 0; ai < 2; ++ai) { f32x4 xv[4][4];
#pragma unroll
            for (int m = 0; m < 4; ++m)
#pragma unroll
                for (int q = 0; q < 4; ++q) xv[m][q] = __builtin_nontemporal_load((const f32x4*)(xp + (size_t)(row0 + ai * 128 + m * 16) * D + col0 + (q >> 1) * 128 + (q & 1) * 16));
            __builtin_amdgcn_sched_barrier(0);
#pragma unroll
            for (int m = 0; m < 4; ++m) { const int lrow = ai * 128 + wr * 64 + m * 16 + fr; float ss = 0.f;
#pragma unroll
                for (int q = 0; q < 4; ++q) { const f32x4 r = xv[m][q] + gt[q] * acc[ai][q >> 1][m][q & 1]; acc[ai][q >> 1][m][q & 1] = r; ss += (r[0] * r[0] + r[1] * r[1]) + (r[2] * r[2] + r[3] * r[3]); }
                ss += __shfl_xor(ss, 16); ss += __shfl_xor(ss, 32);
                if (fq == 0) P[lrow * 4 + wc] = ss; } }
        __syncthreads();
        const int prow = wid * 32 + (lane & 31);
        if (lane < 32) { const f32x4 pp = *(const LAS f32x4*)(P + prow * 4);
            __hip_atomic_store(xbuf + ((size_t)u.pm * 256 + prow) * 4 + u.pn, (pp[0] + pp[1]) + (pp[2] + pp[3]), __ATOMIC_RELAXED, __HIP_MEMORY_SCOPE_AGENT); }
        asm volatile("s_waitcnt vmcnt(0)" ::: "memory");
        if (lane == 0) __hip_atomic_fetch_add(cnt + 64 * u.pm, 1u, __ATOMIC_RELAXED, __HIP_MEMORY_SCOPE_AGENT);
        if (wid == 0) { unsigned sp = 0u;
            while ((unsigned)__builtin_amdgcn_readfirstlane(__hip_atomic_load(cnt + 64 * u.pm, __ATOMIC_RELAXED, __HIP_MEMORY_SCOPE_AGENT)) < 32u) { __builtin_amdgcn_s_sleep(2); if (++sp > (1u << 22)) break; }
            __builtin_amdgcn_fence(__ATOMIC_ACQUIRE, "agent"); }
        asm volatile("s_waitcnt vmcnt(0) lgkmcnt(0)" ::: "memory"); __syncthreads();
        if (lane < 32) { const float* sl = xbuf + ((size_t)u.pm * 256 + prow) * 4; float t = 0.f;
#pragma unroll
            for (int q = 0; q < 4; ++q) t += __hip_atomic_load(sl + q, __ATOMIC_RELAXED, __HIP_MEMORY_SCOPE_AGENT);
            S[prow] = rsqrtf(t * (1.0f / D) + EPS); }
        __syncthreads();
        f32x4 fv[4];
#pragma unroll
        for (int q = 0; q < 4; ++q) fv[q] = *(const f32x4*)(fw + col0 + (q >> 1) * 128 + (q & 1) * 16);
#pragma unroll
        for (int ai = 0; ai < 2; ++ai)
#pragma unroll
            for (int m = 0; m < 4; ++m) { const int row = row0 + ai * 128 + m * 16, lrow = ai * 128 + wr * 64 + m * 16 + fr; const float rs = S[lrow]; float* orow = out + (size_t)row * D + col0;
#pragma unroll
                for (int q = 0; q < 4; ++q) __builtin_nontemporal_store(acc[ai][q >> 1][m][q & 1] * rs * fv[q], (f32x4*)(orow + (q >> 1) * 128 + (q & 1) * 16)); }
    }
};
template <int AM, int BN>
__device__ __forceinline__ void wave_gemm(const bf16_t* const (&Ar)[AM], int lda, const bf16_t* const (&Br)[BN], int ldb, int K, int lane, f32x4 (&acc)[AM][BN]) {
    const bf16_t* a[AM]; const bf16_t* b[BN];
#pragma unroll
    for (int i = 0; i < AM; ++i) a[i] = Ar[i] + (size_t)(lane & 15) * lda + 8 * (lane >> 4);
#pragma unroll
    for (int i = 0; i < BN; ++i) b[i] = Br[i] + (size_t)(lane & 15) * ldb + 8 * (lane >> 4);
    constexpr int KB = (AM + BN) >= 4 ? 8 : 16;
    for (int k0 = 0; k0 < K; k0 += 32 * KB) { bf16x8 fa[KB][AM], fb[KB][BN];
#pragma unroll
        for (int s = 0; s < KB; ++s) {
#pragma unroll
            for (int i = 0; i < AM; ++i) fa[s][i] = *(const bf16x8*)(a[i] + k0 + 32 * s);
#pragma unroll
            for (int i = 0; i < BN; ++i) fb[s][i] = *(const bf16x8*)(b[i] + k0 + 32 * s); }
        __builtin_amdgcn_sched_barrier(0);
#pragma unroll
        for (int s = 0; s < KB; ++s)
#pragma unroll
            for (int i = 0; i < AM; ++i)
#pragma unroll
                for (int j = 0; j < BN; ++j) acc[i][j] = MFMA16(fb[s][j], fa[s][i], acc[i][j]); }
}
__device__ __forceinline__ void sample_gemm1(const Params& p, LAS unsigned char* lds, int bid) {
    int tid_ = threadIdx.x; asm volatile("" : "+v"(tid_)); const int tid = tid_, lane = tid & 63, w = tid >> 6, g4 = lane >> 4, l15 = lane & 15;
    const bf16_t* H = (const bf16_t*)((const unsigned char*)p.out + RB_H); const bf16_t* bt1 = (const bf16_t*)((const unsigned char*)p.out + RB_BT1); bf16_t* proj = (bf16_t*)(p.ws + WS_PROJ);
    constexpr int RS = 528, LB = 256 * RS;
    int b0, b1, ocol; const bool uz = bid >= 96 && bid < 160;
    if (bid < 96) { b0 = 32 * bid; b1 = b0 + 16; ocol = 32 * bid; }
    else if (uz) { const int j = bid - 96; b0 = 3072 + (j >> 3) * 256 + (j & 7) * 16; b1 = b0 + 128; ocol = PC_UZ + 16 * j; }
    else { b0 = 5120 + 32 * (bid - 160); b1 = b0 + 16; ocol = PC_GV + 32 * (bid - 160); }
    u32x4 ra[16], rb[2];
    const int pr = tid >> 5, pc = tid & 31;
    const bf16_t* ag = H + (size_t)(SEQ + pr) * D + pc * 8;
    const bf16_t* bg0 = bt1 + (size_t)(b0 + pr) * D + pc * 8; const bf16_t* bg1 = bt1 + (size_t)(b1 + pr) * D + pc * 8;
#pragma unroll
    for (int i = 0; i < 16; ++i) ra[i] = *(const u32x4*)(ag + (size_t)i * 16 * D);
    rb[0] = *(const u32x4*)bg0; rb[1] = *(const u32x4*)bg1;
    f32x4 acc[2][2];
#pragma unroll
    for (int i = 0; i < 2; ++i)
#pragma unroll
        for (int j = 0; j < 2; ++j) acc[i][j] = (f32x4){0.f, 0.f, 0.f, 0.f};
    for (int kc = 0; kc < 4; ++kc) {
#pragma unroll
        for (int i = 0; i < 16; ++i) *(LAS u32x4*)(lds + (pr + 16 * i) * RS + pc * 16) = ra[i];
        *(LAS u32x4*)(lds + LB + pr * RS + pc * 16) = rb[0]; *(LAS u32x4*)(lds + LB + (16 + pr) * RS + pc * 16) = rb[1];
        __syncthreads();
        if (kc + 1 < 4) { int ko = (kc + 1) * 256; asm volatile("" : "+v"(ko));
#pragma unroll
            for (int i = 0; i < 16; ++i) ra[i] = *(const u32x4*)(ag + (size_t)i * 16 * D + ko);
            rb[0] = *(const u32x4*)(bg0 + ko); rb[1] = *(const u32x4*)(bg1 + ko); }
#pragma unroll
        for (int ks = 0; ks < 8; ++ks) { bf16x8 fa[2], fb[2];
#pragma unroll
            for (int i = 0; i < 2; ++i) { fa[i] = row_frag(lds + (32 * w + 16 * i) * RS + ks * 64, RS, lane); fb[i] = row_frag(lds + LB + 16 * i * RS + ks * 64, RS, lane); }
#pragma unroll
            for (int i = 0; i < 2; ++i)
#pragma unroll
                for (int j = 0; j < 2; ++j) acc[i][j] = MFMA16(fb[j], fa[i], acc[i][j]); }
        __syncthreads();
    }
    const int r0 = SEQ + 32 * w;
#pragma unroll
    for (int i = 0; i < 2; ++i) { bf16_t* rp = proj + (size_t)(r0 + 16 * i + l15) * PJ + ocol + 4 * g4;
        if (uz) { const f32x4 u = acc[i][0], z = acc[i][1]; u32x2 pk; pk.x = cvt_pk_bf16(u[0] * siluf_(z[0]), u[1] * siluf_(z[1])); pk.y = cvt_pk_bf16(u[2] * siluf_(z[2]), u[3] * siluf_(z[3])); *(u32x2*)rp = pk; }
        else {
#pragma unroll
            for (int j = 0; j < 2; ++j) { u32x2 pk; pk.x = cvt_pk_bf16(acc[i][j][0], acc[i][j][1]); pk.y = cvt_pk_bf16(acc[i][j][2], acc[i][j][3]); *(u32x2*)(rp + 16 * j) = pk; } } }
}
__device__ __forceinline__ void sample_gemm2(const Params& p, int bid, bool nostore) {
    int tid_ = threadIdx.x; asm volatile("" : "+v"(tid_)); const int lane = tid_ & 63, w = tid_ >> 6, g4 = lane >> 4, l15 = lane & 15;
    if (w >= 4) return;
    bf16_t* proj = (bf16_t*)(p.ws + WS_PROJ); const bf16_t* bta = (const bf16_t*)(p.ws + WS_BTA); const bf16_t* btb = (const bf16_t*)(p.ws + WS_BTB);
    const int tile = bid * 4 + w, rt = tile >> 6, ct = tile & 63, r0 = SEQ + 16 * rt, c0 = 16 * ct;
    f32x4 aa[1][1], ab[1][1]; aa[0][0] = (f32x4){0.f, 0.f, 0.f, 0.f}; ab[0][0] = aa[0][0];
    { const bf16_t* const Ar[1] = {proj + (size_t)r0 * PJ + PC_R}; const bf16_t* const Br[1] = {bta + (size_t)c0 * D}; wave_gemm<1, 1>(Ar, PJ, Br, D, D, lane, aa); }
    { const bf16_t* const Ar[1] = {proj + (size_t)r0 * PJ + PC_UZ}; const bf16_t* const Br[1] = {btb + (size_t)c0 * D}; wave_gemm<1, 1>(Ar, PJ, Br, D, D, lane, ab); }
    bf16_t* rp = proj + (size_t)(r0 + l15) * PJ + PC_GA + c0 + 4 * g4; const u32x2 ga = *(const u32x2*)rp, gb = *(const u32x2*)(rp + 1024);
    const f32x4 bA = *(const f32x4*)(p.b_gate + c0 + 4 * g4), bB = *(const f32x4*)(p.b_gate + 1024 + c0 + 4 * g4);
    float o[4];
    o[0] = sigmoidf_(bflo(ga.x) + bA[0]) * aa[0][0][0] + sigmoidf_(bflo(gb.x) + bB[0]) * ab[0][0][0]; o[1] = sigmoidf_(bfhi(ga.x) + bA[1]) * aa[0][0][1] + sigmoidf_(bfhi(gb.x) + bB[1]) * ab[0][0][1];
    o[2] = sigmoidf_(bflo(ga.y) + bA[2]) * aa[0][0][2] + sigmoidf_(bflo(gb.y) + bB[2]) * ab[0][0][2]; o[3] = sigmoidf_(bfhi(ga.y) + bA[3]) * aa[0][0][3] + sigmoidf_(bfhi(gb.y) + bB[3]) * ab[0][0][3];
    u32x2 pk; pk.x = cvt_pk_bf16(o[0], o[1]); pk.y = cvt_pk_bf16(o[2], o[3]); if (!nostore) *(u32x2*)rp = pk;
}
__device__ __forceinline__ void sample_gemm3(const Params& p, int bid) {
    int tid_ = threadIdx.x; asm volatile("" : "+v"(tid_)); const int lane = tid_ & 63, w = tid_ >> 6, g4 = lane >> 4, l15 = lane & 15;
    if (w >= 4) return;
    const bf16_t* proj = (const bf16_t*)(p.ws + WS_PROJ); const bf16_t* bto = (const bf16_t*)(p.ws + WS_BTO); const float* ada = (const float*)(p.ws + WS_ADA);
    const int tile = bid * 4 + w, rt = tile >> 6, ct = tile & 63, c0 = 16 * ct + 4 * g4, rs = 16 * rt + l15;
    f32x4 acc[1][1]; acc[0][0] = (f32x4){0.f, 0.f, 0.f, 0.f};
    { const bf16_t* const Ar[1] = {proj + (size_t)(SEQ + 16 * rt) * PJ + PC_GA}; const bf16_t* const Br[1] = {bto + (size_t)16 * ct * D}; wave_gemm<1, 1>(Ar, PJ, Br, D, D, lane, acc); }
    const f32x4 xv = *(const f32x4*)(p.x_sample + (size_t)rs * D + c0), gt = *(const f32x4*)(ada + (1 + rt) * 3072 + 2048 + c0);
    *(f32x4*)(p.out + OUT_YS + (size_t)rs * D + c0) = xv + gt * acc[0][0];
}

__device__ __forceinline__ void transpose_tile(LAS unsigned char* lds, const float* src, int ldsrc, int scol0, int nvalid, float scale, bf16_t* dst, int ldd, int n0, int k0) {
    int tid_ = threadIdx.x; asm volatile("" : "+v"(tid_)); const int tid = tid_;
    f32x4 v[8];
#pragma unroll
    for (int i = 0; i < 8; ++i) { const int e = tid + 512 * i, k = e >> 4, n4 = (e & 15) * 4; f32x4 t = (f32x4){0.f, 0.f, 0.f, 0.f};
        if (n4 < nvalid) t = __builtin_nontemporal_load((const f32x4*)(src + (size_t)(k0 + k) * ldsrc + scol0 + n4));
        v[i] = t; }
#pragma unroll
    for (int i = 0; i < 8; ++i) { const int e = tid + 512 * i, k = e >> 4, n4 = (e & 15) * 4, m = (e & 15) & 7;
        const f32x4 t = v[i];
        *(LAS bf16_t*)(lds + (n4 + 0) * 528 + (((k >> 3) ^ m) << 4) + (k & 7) * 2) = f2bf(t[0] * scale);
        *(LAS bf16_t*)(lds + (n4 + 1) * 528 + (((k >> 3) ^ m) << 4) + (k & 7) * 2) = f2bf(t[1] * scale);
        *(LAS bf16_t*)(lds + (n4 + 2) * 528 + (((k >> 3) ^ m) << 4) + (k & 7) * 2) = f2bf(t[2] * scale);
        *(LAS bf16_t*)(lds + (n4 + 3) * 528 + (((k >> 3) ^ m) << 4) + (k & 7) * 2) = f2bf(t[3] * scale); }
    __syncthreads();
#pragma unroll
    for (int i = 0; i < 4; ++i) { const int e = tid + 512 * i, n = e >> 5, kc = e & 31; const u32x4 w = *(const LAS u32x4*)(lds + n * 528 + ((kc ^ ((n >> 2) & 7)) << 4));
        *(u32x4*)(dst + (size_t)(n0 + n) * ldd + k0 + kc * 8) = w; }
    __syncthreads();
}
__device__ __forceinline__ void ada_item(const Params& p, LAS unsigned char* lds, int slab) {
    int tid_ = threadIdx.x; asm volatile("" : "+v"(tid_)); const int tid = tid_; float* ada = (float*)(p.ws + WS_ADA);
    LAS float* sc = (LAS float*)lds;
    LAS float* red = (LAS float*)(lds + 17 * 1024 * 4);
    for (int i = tid; i < 17 * 1024; i += 512) { const int b = i >> 10, k = i & 1023; const float c = b == 0 ? p.c_prompt[k] : p.c_sample[(b - 1) * 1024 + k]; sc[i] = siluf_(c); }
    __syncthreads();
    const int nl = tid & 31, kg = tid >> 5, n = slab * 32 + nl;
    float a[17];
#pragma unroll
    for (int b = 0; b < 17; ++b) a[b] = 0.f;
    for (int k16 = 0; k16 < 4; ++k16) { float w[16]; const float* wp = p.w_ada + (size_t)(kg * 64 + k16 * 16) * 3072 + n;
#pragma unroll
        for (int i = 0; i < 16; ++i) w[i] = wp[(size_t)i * 3072];
        __builtin_amdgcn_sched_barrier(0);
#pragma unroll
        for (int k4 = 0; k4 < 4; ++k4) { const int k = kg * 64 + k16 * 16 + k4 * 4;
#pragma unroll
            for (int b = 0; b < 17; ++b) { const f32x4 s = *(const LAS f32x4*)(sc + b * 1024 + k); a[b] += s[0] * w[k4 * 4] + s[1] * w[k4 * 4 + 1] + s[2] * w[k4 * 4 + 2] + s[3] * w[k4 * 4 + 3]; } } }
#pragma unroll
    for (int b = 0; b < 17; ++b) red[(kg * 17 + b) * 32 + nl] = a[b];
    __syncthreads();
    for (int i = tid; i < 17 * 32; i += 512) { const int b = i >> 5, c = i & 31; float s = p.b_ada[slab * 32 + c];
#pragma unroll
        for (int g = 0; g < 16; ++g) s += red[(g * 17 + b) * 32 + c];
        ada[b * 3072 + slab * 32 + c] = s; }
    __syncthreads();
}
__device__ __forceinline__ void phase0(const Params& p, LAS unsigned char* lds) {
    bf16_t* bt1 = (bf16_t*)((unsigned char*)p.out + RB_BT1); bf16_t* bta = (bf16_t*)(p.ws + WS_BTA); bf16_t* btb = (bf16_t*)(p.ws + WS_BTB); bf16_t* bto = (bf16_t*)(p.ws + WS_BTO);
    constexpr int N_ADA = 96, N_T1 = (N1 / 64) * 4, N_TS = 64;
    int bid_ = blockIdx.x; asm volatile("" : "+s"(bid_)); const int bid = bid_;
    for (int it = bid; it < N_ADA + N_T1 + 3 * N_TS; it += gridDim.x) {
        if (it < N_ADA) { ada_item(p, lds, it); continue; }
        int j = it - N_ADA;
        if (j < N_T1) { const int nt = j >> 2, kt = j & 3, n0 = nt * 64; int sc0, nv = 64;
            if (n0 < 3072) sc0 = n0;
            else if (n0 < 5120) { const int t = (n0 - 3072) >> 8, w = (n0 - 3072) & 255; sc0 = w < 128 ? 3088 + t * 128 + w : 5136 + t * 128 + (w - 128); }
            else if (n0 < 6144) sc0 = 4112 + (n0 - 5120);
            else if (n0 < 7168) sc0 = 6160 + (n0 - 6144);
            else if (n0 < 8192) sc0 = 7184 + (n0 - 7168);
            else { sc0 = 3072; nv = 16; }
            transpose_tile(lds, p.w_in, WIN_LD, sc0, nv, n0 < 512 ? 0.08838834764831845f : 1.0f, bt1, D, n0, kt * 256); continue; }
        j -= N_T1;
        const int which = j >> 6, nt = (j & 63) >> 2, kt = j & 3;
        if (which == 0) transpose_tile(lds, p.w_proj_a, D, nt * 64, 64, 1.0f, bta, D, nt * 64, kt * 256);
        else if (which == 1) transpose_tile(lds, p.w_proj_b, D, nt * 64, 64, 1.0f, btb, D, nt * 64, kt * 256);
        else transpose_tile(lds, p.w_out, D, nt * 64, 64, 1.0f, bto, D, nt * 64, kt * 256);
    }
}
__device__ __forceinline__ void phase1(const Params& p) {
    int tid_ = threadIdx.x; asm volatile("" : "+v"(tid_)); const int tid = tid_; int bid_ = blockIdx.x; asm volatile("" : "+s"(bid_)); const int bid = bid_;
    const int lane = tid & 63, wv = tid >> 6, l15 = lane & 15, g4 = lane >> 4; const float* ada = (const float*)(p.ws + WS_ADA); bf16_t* H = (bf16_t*)((unsigned char*)p.out + RB_H);
#pragma unroll 2
    for (int row = bid * 8 + wv; row < MTOT; row += gridDim.x * 8) {
        const float* xr = row < SEQ ? p.x_prompt + (size_t)row * D : p.x_sample + (size_t)(row - SEQ) * D; const int b = row < SEQ ? 0 : 1 + ((row - SEQ) >> 4);
        f32x4 v[4]; float ss = 0.f;
#pragma unroll
        for (int i = 0; i < 4; ++i) { v[i] = __builtin_nontemporal_load((const f32x4*)(xr + i * 256 + lane * 4)); ss += (v[i][0] * v[i][0] + v[i][1] * v[i][1]) + (v[i][2] * v[i][2] + v[i][3] * v[i][3]); }
        ss = wave_sum(ss); const float rstd = rsqrtf(ss * (1.0f / D) + EPS);
#pragma unroll
        for (int i = 0; i < 4; ++i) { const int c = i * 256 + lane * 4; const f32x4 nw = *(const f32x4*)(p.norm_w + c), sh = *(const f32x4*)(ada + b * 3072 + c), scl = *(const f32x4*)(ada + b * 3072 + 1024 + c);
            const f32x4 h = v[i] * rstd * nw * (scl + 1.0f) + sh; u32x2 w; w.x = cvt_pk_bf16(h[0], h[1]); w.y = cvt_pk_bf16(h[2], h[3]); *(u32x2*)(H + (size_t)row * D + c) = w; }
    }
    asm volatile("s_waitcnt vmcnt(0)" ::: "memory");
    __syncthreads();
    float* alr = (float*)(p.ws + WS_ALR);
    const bf16_t* w16 = (const bf16_t*)((const unsigned char*)p.out + RB_BT1) + (size_t)(8192 + l15) * D + 8 * g4;
    for (int gi = wv; bid * 8 + 2048 * gi < MTOT; gi += 8) { const int r0 = bid * 8 + 2048 * gi;
        f32x4 acc = (f32x4){0.f, 0.f, 0.f, 0.f};
        const bf16_t* ap = H + (size_t)(r0 + (l15 & 7)) * D + 8 * g4;
#pragma unroll
        for (int kb = 0; kb < 2; ++kb) { bf16x8 fa[16], fb[16];
#pragma unroll
            for (int s = 0; s < 16; ++s) { fa[s] = *(const bf16x8*)(ap + (kb * 16 + s) * 32); fb[s] = *(const bf16x8*)(w16 + (kb * 16 + s) * 32); }
#pragma unroll
            for (int s = 0; s < 16; ++s) acc = MFMA16(fb[s], fa[s], acc); }
        if (l15 < 8) *(f32x4*)(alr + (size_t)(r0 + l15) * 16 + 4 * g4) = acc; }
}
__device__ __forceinline__ void gla_prep(const Params& p, LAS unsigned char* lds, int tokbase, int nchunk, int nvalid, int h, int chunk0, bool tolds, int ldsK, int ldsDV) {
    int tid_ = threadIdx.x; asm volatile("" : "+v"(tid_)); const int tid = tid_, kap = tid & 127; const int c = __builtin_amdgcn_readfirstlane(tid >> 7);
    bf16_t* proj = (bf16_t*)(p.ws + WS_PROJ); const float* alr = (const float*)(p.ws + WS_ALR); float* dch = (float*)(p.ws + WS_DCH);
    if (c < nchunk) {
        float w2[16];
#pragma unroll
        for (int j = 0; j < 16; ++j) w2[j] = p.w_a2[j * 512 + h * 128 + kap];
        const float ba = p.b_a[h * 128 + kap];
        const int tok0 = tokbase + 64 * c; float run = 0.f;
        bf16_t* kp = proj + (size_t)tok0 * PJ + PC_K + h * 128 + kap; bf16_t* qp = proj + (size_t)tok0 * PJ + PC_Q + h * 128 + kap;
        const float* ar0 = alr + (size_t)tok0 * 16;
#pragma unroll 8
        for (int t = 0; t < nvalid; ++t) { const float* ar = ar0 + t * 16; float x = ba;
#pragma unroll
            for (int j = 0; j < 16; ++j) x += ar[j] * w2[j];
            const float la = -(fmaxf(-x, 0.f) + __logf(1.0f + __expf(-fabsf(x)))) * 0.0625f; run += la;
            const float kk = bf2f(kp[(size_t)t * PJ]), qq = bf2f(qp[(size_t)t * PJ]);
            const bf16_t kt = f2bf(kk * __expf(-run)); kp[(size_t)t * PJ] = kt; qp[(size_t)t * PJ] = f2bf(qq * __expf(run));
            if (tolds) *(LAS bf16_t*)(lds + ldsK + (64 * c + t) * 272 + kap * 2) = kt; }
        const float d = __expf(run); dch[((chunk0 + c) * 4 + h) * 128 + kap] = d; if (tolds) *(LAS float*)(lds + ldsDV + (c * 128 + kap) * 4) = d;
    }
}
constexpr int LA_K = 0, LA_V0 = 69632, LA_V1 = 103424, LA_DV = 137216;
constexpr int RS_QK = 272, RS_V = 528, RS_P = 144, RS_S = 272;
__device__ __forceinline__ void gla_segA(const Params& p, LAS unsigned char* lds, int seg, int h) {
    int tid_ = threadIdx.x; asm volatile("" : "+v"(tid_));
    const int tid = tid_, lane = tid & 63, w = tid >> 6, g4 = lane >> 4, l15 = lane & 15;
    const bf16_t* proj = (const bf16_t*)(p.ws + WS_PROJ); const int tokbase = seg * (SEGCH * 64);
    u32x4 vr[4];
#pragma unroll
    for (int i = 0; i < 4; ++i) { const int e = tid + 512 * i, r = e >> 5, c = e & 31; vr[i] = *(const u32x4*)(proj + (size_t)(tokbase + r) * PJ + PC_V + h * 256 + c * 8); }
    gla_prep(p, lds, tokbase, SEGCH, 64, h, seg * SEGCH, true, LA_K, LA_DV);
#pragma unroll
    for (int i = 0; i < 4; ++i) { const int e = tid + 512 * i, r = e >> 5, c = e & 31; *(LAS u32x4*)(lds + LA_V0 + r * RS_V + c * 16) = vr[i]; }
    __syncthreads();
    f32x4 acc[8][2];
#pragma unroll
    for (int kt = 0; kt < 8; ++kt)
#pragma unroll
        for (int j2 = 0; j2 < 2; ++j2) acc[kt][j2] = (f32x4){0.f, 0.f, 0.f, 0.f};
    for (int ch = 0; ch < SEGCH; ++ch) {
        int tok1 = tokbase + (ch + 1) * 64; asm volatile("" : "+v"(tok1));
        const int vb = (ch & 1) ? LA_V1 : LA_V0, vn = (ch & 1) ? LA_V0 : LA_V1;
        if (ch + 1 < SEGCH) {
#pragma unroll
            for (int i = 0; i < 4; ++i) { const int e = tid + 512 * i, r = e >> 5, c = e & 31; vr[i] = *(const u32x4*)(proj + (size_t)(tok1 + r) * PJ + PC_V + h * 256 + c * 8); } }
#pragma unroll
        for (int ks = 0; ks < 2; ++ks) { bf16x8 Bv[2];
#pragma unroll
            for (int j2 = 0; j2 < 2; ++j2) Bv[j2] = tr_frag(lds + vb + 32 * ks * RS_V + (32 * w + 16 * j2) * 2, RS_V, lane);
#pragma unroll
            for (int kt = 0; kt < 8; ++kt) { const bf16x8 Ak = tr_frag(lds + LA_K + (64 * ch + 32 * ks) * RS_QK + 16 * kt * 2, RS_QK, lane);
#pragma unroll
                for (int j2 = 0; j2 < 2; ++j2) acc[kt][j2] = MFMA16(Ak, Bv[j2], acc[kt][j2]); } }
#pragma unroll
        for (int kt = 0; kt < 8; ++kt) { const f32x4 d = *(const LAS f32x4*)(lds + LA_DV + (ch * 128 + 16 * kt + 4 * g4) * 4);
#pragma unroll
            for (int j2 = 0; j2 < 2; ++j2) acc[kt][j2] = acc[kt][j2] * d; }
        if (ch + 1 < SEGCH) {
#pragma unroll
            for (int i = 0; i < 4; ++i) { const int e = tid + 512 * i, r = e >> 5, c = e & 31; *(LAS u32x4*)(lds + vn + r * RS_V + c * 16) = vr[i]; } }
        __syncthreads();
    }
    bf16_t* us = (bf16_t*)((unsigned char*)p.out + RB_USEG) + ((size_t)(seg * 4 + h) * 256) * 128;
#pragma unroll
    for (int kt = 0; kt < 8; ++kt)
#pragma unroll
        for (int j2 = 0; j2 < 2; ++j2) { u32x2 pk; pk.x = cvt_pk_bf16(acc[kt][j2][0], acc[kt][j2][1]); pk.y = cvt_pk_bf16(acc[kt][j2][2], acc[kt][j2][3]);
            *(u32x2*)(us + (size_t)(32 * w + 16 * j2 + l15) * 128 + 16 * kt + 4 * g4) = pk; }
    if (tid < 128) { float d = 1.f;
#pragma unroll
        for (int c = 0; c < 4; ++c) d *= *(const LAS float*)(lds + LA_DV + (c * 128 + tid) * 4);
        ((float*)(p.ws + WS_DSEG))[(seg * 4 + h) * 128 + tid] = d; }
    __syncthreads();
}
constexpr int L_DV = 6144, L_RED = 6656, L_Q = 8704, L_K = 26112, L_V = 43520, L_P = 77312, L_S = 86528;
__device__ __forceinline__ void gla_out(const Params& p, LAS unsigned char* lds, int sample, int idx  , int h, bool nostore) {
    int tid_ = threadIdx.x; asm volatile("" : "+v"(tid_));
    const int tid = tid_, lane = tid & 63, w = tid >> 6, g4 = lane >> 4, l15 = lane & 15;
    bf16_t* proj = (bf16_t*)(p.ws + WS_PROJ); const float* dch = (const float*)(p.ws + WS_DCH);
    const int nchunk = sample ? 1 : SEGCH, nvalid = sample ? SAMP_T : 64, tokbase = sample ? SEQ + idx * SAMP_T : idx * (SEGCH * 64), chunk0 = sample ? 256 + idx : idx * SEGCH;
    f32x4 acc[8][2];
    if (!sample) { const bf16_t* ss = (const bf16_t*)((unsigned char*)p.out + RB_SSTART) + ((size_t)(idx * 4 + h) * 256) * 128;
#pragma unroll
        for (int kt = 0; kt < 8; ++kt)
#pragma unroll
            for (int j2 = 0; j2 < 2; ++j2) { const u32x2 pk = *(const u32x2*)(ss + (size_t)(32 * w + 16 * j2 + l15) * 128 + 16 * kt + 4 * g4);
                acc[kt][j2] = (f32x4){bflo(pk.x), bfhi(pk.x), bflo(pk.y), bfhi(pk.y)}; }
    } else { const float* s0 = p.state_gla + (size_t)(idx * 4 + h) * 128 * 256;
#pragma unroll
        for (int kt = 0; kt < 8; ++kt)
#pragma unroll
            for (int j2 = 0; j2 < 2; ++j2)
#pragma unroll
                for (int r = 0; r < 4; ++r) acc[kt][j2][r] = s0[(size_t)(16 * kt + 4 * g4 + r) * 256 + 32 * w + 16 * j2 + l15];
    }
    if (tid < 128) {
#pragma unroll
        for (int c = 0; c < SEGCH; ++c) if (c < nchunk) *(LAS float*)(lds + (c * 128 + tid) * 4) = dch[((chunk0 + c) * 4 + h) * 128 + tid]; }
    u32x4 rq[2], rk[2], rv[4];
#define GLA_LOAD_TILES(T0) do { \
        _Pragma("unroll") for (int i = 0; i < 2; ++i) { const int e = tid + 512 * i, r = e >> 4, c = e & 15; const bool ok = r < nvalid; const bf16_t* bp = proj + (size_t)((T0) + r) * PJ + h * 128 + c * 8; \
            rq[i] = ok ? __builtin_nontemporal_load((const u32x4*)(bp + PC_Q)) : (u32x4){0u, 0u, 0u, 0u}; rk[i] = ok ? __builtin_nontemporal_load((const u32x4*)(bp + PC_K)) : (u32x4){0u, 0u, 0u, 0u}; } \
        _Pragma("unroll") for (int i = 0; i < 4; ++i) { const int e = tid + 512 * i, r = e >> 5, c = e & 31; \
            rv[i] = (r < nvalid) ? __builtin_nontemporal_load((const u32x4*)(proj + (size_t)((T0) + r) * PJ + PC_V + h * 256 + c * 8)) : (u32x4){0u, 0u, 0u, 0u}; } } while (0)
    GLA_LOAD_TILES(tokbase);
    for (int ch = 0; ch < nchunk; ++ch) {
        int tok0 = tokbase + ch * 64; asm volatile("" : "+v"(tok0));
#pragma unroll
        for (int i = 0; i < 2; ++i) { const int e = tid + 512 * i, r = e >> 4, c = e & 15; *(LAS u32x4*)(lds + L_Q + r * RS_QK + c * 16) = rq[i]; *(LAS u32x4*)(lds + L_K + r * RS_QK + c * 16) = rk[i]; }
#pragma unroll
        for (int i = 0; i < 4; ++i) { const int e = tid + 512 * i, r = e >> 5, c = e & 31; *(LAS u32x4*)(lds + L_V + r * RS_V + c * 16) = rv[i]; }
#pragma unroll
        for (int kt = 0; kt < 8; ++kt)
#pragma unroll
            for (int j2 = 0; j2 < 2; ++j2) { u32x2 pk; pk.x = cvt_pk_bf16(acc[kt][j2][0], acc[kt][j2][1]); pk.y = cvt_pk_bf16(acc[kt][j2][2], acc[kt][j2][3]);
                *(LAS u32x2*)(lds + L_S + (32 * w + 16 * j2 + l15) * RS_S + (16 * kt + 4 * g4) * 2) = pk; }
        __syncthreads();
        if (ch + 1 < nchunk) { const int tok1 = tok0 + 64; GLA_LOAD_TILES(tok1); }
#pragma unroll
        for (int e = 0; e < 2; ++e) { const int tile = 2 * w + e, st = tile >> 2, tt = tile & 3; f32x4 ap = (f32x4){0.f, 0.f, 0.f, 0.f};
            if (st <= tt) {
#pragma unroll
                for (int ks = 0; ks < 4; ++ks) { const bf16x8 A = row_frag(lds + L_K + 16 * st * RS_QK + ks * 64, RS_QK, lane), B = row_frag(lds + L_Q + 16 * tt * RS_QK + ks * 64, RS_QK, lane); ap = MFMA16(A, B, ap); } }
            const int t = 16 * tt + l15, s0 = 16 * st + 4 * g4;
            u32x2 pk; pk.x = cvt_pk_bf16(s0 <= t ? ap[0] : 0.f, s0 + 1 <= t ? ap[1] : 0.f); pk.y = cvt_pk_bf16(s0 + 2 <= t ? ap[2] : 0.f, s0 + 3 <= t ? ap[3] : 0.f);
            *(LAS u32x2*)(lds + L_P + t * RS_P + s0 * 2) = pk; }
        __syncthreads();
        u32x2 rrv[4][2];
#pragma unroll
        for (int tt = 0; tt < 4; ++tt)
#pragma unroll
            for (int j2 = 0; j2 < 2; ++j2) rrv[tt][j2] = (16 * tt + l15 < nvalid) ? *(const u32x2*)(proj + (size_t)(tok0 + 16 * tt + l15) * PJ + PC_R + h * 256 + 32 * w + 16 * j2 + 4 * g4) : (u32x2){0u, 0u};
        f32x4 ao[2][4];
#pragma unroll
        for (int j2 = 0; j2 < 2; ++j2)
#pragma unroll
            for (int tt = 0; tt < 4; ++tt) ao[j2][tt] = (f32x4){0.f, 0.f, 0.f, 0.f};
#pragma unroll
        for (int ks = 0; ks < 2; ++ks) { bf16x8 Av[2];
#pragma unroll
            for (int j2 = 0; j2 < 2; ++j2) Av[j2] = tr_frag(lds + L_V + 32 * ks * RS_V + (32 * w + 16 * j2) * 2, RS_V, lane);
#pragma unroll
            for (int tt = 0; tt < 4; ++tt) { const bf16x8 Bp = row_frag(lds + L_P + 16 * tt * RS_P + ks * 64, RS_P, lane);
#pragma unroll
                for (int j2 = 0; j2 < 2; ++j2) ao[j2][tt] = MFMA16(Av[j2], Bp, ao[j2][tt]); } }
#pragma unroll
        for (int ks = 0; ks < 4; ++ks) { bf16x8 As[2];
#pragma unroll
            for (int j2 = 0; j2 < 2; ++j2) As[j2] = row_frag(lds + L_S + (32 * w + 16 * j2) * RS_S + ks * 64, RS_S, lane);
#pragma unroll
            for (int tt = 0; tt < 4; ++tt) { const bf16x8 Bq = row_frag(lds + L_Q + 16 * tt * RS_QK + ks * 64, RS_QK, lane);
#pragma unroll
                for (int j2 = 0; j2 < 2; ++j2) ao[j2][tt] = MFMA16(As[j2], Bq, ao[j2][tt]); } }
#pragma unroll
        for (int tt = 0; tt < 4; ++tt) { float ss = 0.f;
#pragma unroll
            for (int j2 = 0; j2 < 2; ++j2) ss += (ao[j2][tt][0] * ao[j2][tt][0] + ao[j2][tt][1] * ao[j2][tt][1]) + (ao[j2][tt][2] * ao[j2][tt][2] + ao[j2][tt][3] * ao[j2][tt][3]);
            ss += __shfl_xor(ss, 16); ss += __shfl_xor(ss, 32);
            if (g4 == 0) *(LAS float*)(lds + L_RED + (w * 64 + 16 * tt + l15) * 4) = ss; }
        __syncthreads();
#pragma unroll
        for (int tt = 0; tt < 4; ++tt) { const int t = 16 * tt + l15; float tot = 0.f;
#pragma unroll
            for (int ww = 0; ww < 8; ++ww) tot += *(const LAS float*)(lds + L_RED + (ww * 64 + t) * 4);
            const float rstd = rsqrtf(tot * (1.0f / 256.0f) + EPS);
            if (t < nvalid && !nostore) {
#pragma unroll
                for (int j2 = 0; j2 < 2; ++j2) { const int v0 = 32 * w + 16 * j2 + 4 * g4; bf16_t* rp = proj + (size_t)(tok0 + t) * PJ + PC_R + h * 256 + v0;
                    const u32x2 rr = rrv[tt][j2]; const f32x4 gn = *(const f32x4*)(p.gla_norm_w + v0); const f32x4 o = ao[j2][tt];
                    u32x2 pk; pk.x = cvt_pk_bf16(o[0] * rstd * gn[0] * siluf_(bflo(rr.x)), o[1] * rstd * gn[1] * siluf_(bfhi(rr.x)));
                    pk.y = cvt_pk_bf16(o[2] * rstd * gn[2] * siluf_(bflo(rr.y)), o[3] * rstd * gn[3] * siluf_(bfhi(rr.y)));
                    *(u32x2*)rp = pk; } } }
#pragma unroll
        for (int ks = 0; ks < 2; ++ks) { bf16x8 Bv[2];
#pragma unroll
            for (int j2 = 0; j2 < 2; ++j2) Bv[j2] = tr_frag(lds + L_V + 32 * ks * RS_V + (32 * w + 16 * j2) * 2, RS_V, lane);
#pragma unroll
            for (int kt = 0; kt < 8; ++kt) { const bf16x8 Ak = tr_frag(lds + L_K + 32 * ks * RS_QK + 16 * kt * 2, RS_QK, lane);
#pragma unroll
                for (int j2 = 0; j2 < 2; ++j2) acc[kt][j2] = MFMA16(Ak, Bv[j2], acc[kt][j2]); } }
#pragma unroll
        for (int kt = 0; kt < 8; ++kt) { const f32x4 d = *(const LAS f32x4*)(lds + (ch * 128 + 16 * kt + 4 * g4) * 4);
#pragma unroll
            for (int j2 = 0; j2 < 2; ++j2) acc[kt][j2] = acc[kt][j2] * d; }
        __syncthreads();
    }
#undef GLA_LOAD_TILES
    if (sample && !nostore) { float* so = p.out + OUT_SS + (size_t)(idx * 4 + h) * 128 * 256;
#pragma unroll
        for (int kt = 0; kt < 8; ++kt)
#pragma unroll
            for (int j2 = 0; j2 < 2; ++j2)
#pragma unroll
                for (int r = 0; r < 4; ++r) so[(size_t)(16 * kt + 4 * g4 + r) * 256 + 32 * w + 16 * j2 + l15] = acc[kt][j2][r];
    }
}
constexpr int G_VN = 0, G_WS = 67584, G_ST = 102400, RS_VN = 528, RS_WS = 272;
__device__ __forceinline__ void gmlp_item(const Params& p, LAS unsigned char* lds, int chunk, int g, bool nostore = false, bool build_ws = true) {
    int tid_ = threadIdx.x; asm volatile("" : "+v"(tid_));
    const int tid = tid_, lane = tid & 63, w = tid >> 6, g4 = lane >> 4, l15 = lane & 15;
    bf16_t* proj = (bf16_t*)(p.ws + WS_PROJ); const int tok0 = chunk * 128;
    u32x4 gvr[8]; u32x2 uzr[8][2];
#pragma unroll
    for (int i = 0; i < 8; ++i) { const int e = tid + 512 * i, r = e >> 5, c = e & 31; gvr[i] = *(const u32x4*)(proj + (size_t)(tok0 + r) * PJ + PC_GV + g * 256 + c * 8); }
#pragma unroll
    for (int it = 0; it < 8; ++it)
#pragma unroll
        for (int j2 = 0; j2 < 2; ++j2) uzr[it][j2] = *(const u32x2*)(proj + (size_t)(tok0 + 16 * it + l15) * PJ + PC_UZ + g * 256 + 32 * w + 16 * j2 + 4 * g4);
    if (tid < 128) { const float* gp = (const float*)(p.ws + WS_GVST) + (size_t)(tok0 + tid) * 32; float s = 0.f, q = 0.f;
#pragma unroll
        for (int k = 0; k < 8; ++k) { const f32x4 v = *(const f32x4*)(gp + 4 * k); s += v[0] + v[2]; q += v[1] + v[3]; }
        const float mean = s * (1.0f / 1024.0f), var = fmaxf(q * (1.0f / 1024.0f) - mean * mean, 0.f);
        *(LAS f32x2*)(lds + G_ST + tid * 8) = (f32x2){mean, rsqrtf(var + EPS)}; }
    if (build_ws)
#pragma unroll
    for (int i = 0; i < 8; ++i) { const int e = tid + 512 * i, r = e >> 5, j4 = (e & 31) * 4; f32x4 v = *(const f32x4*)(p.w_s + (size_t)(g * 128 + r) * 128 + j4);
        if (r < 64 && j4 >= 64) v = (f32x4){0.f, 0.f, 0.f, 0.f};
        u32x2 pk; pk.x = cvt_pk_bf16(v[0], v[1]); pk.y = cvt_pk_bf16(v[2], v[3]); *(LAS u32x2*)(lds + G_WS + r * RS_WS + j4 * 2) = pk; }
    __syncthreads();
#pragma unroll
    for (int i = 0; i < 8; ++i) { const int e = tid + 512 * i, r = e >> 5, c = e & 31; const u32x4 a = gvr[i];
        const f32x2 st = *(const LAS f32x2*)(lds + G_ST + r * 8); const float* lw = p.ln_v_w + g * 256 + c * 8; const float* lb = p.ln_v_b + g * 256 + c * 8;
        const f32x4 w0 = *(const f32x4*)lw, w1 = *(const f32x4*)(lw + 4), b0 = *(const f32x4*)lb, b1 = *(const f32x4*)(lb + 4);
        u32x4 o; o.x = cvt_pk_bf16((bflo(a.x) - st[0]) * st[1] * w0[0] + b0[0], (bfhi(a.x) - st[0]) * st[1] * w0[1] + b0[1]);
        o.y = cvt_pk_bf16((bflo(a.y) - st[0]) * st[1] * w0[2] + b0[2], (bfhi(a.y) - st[0]) * st[1] * w0[3] + b0[3]);
        o.z = cvt_pk_bf16((bflo(a.z) - st[0]) * st[1] * w1[0] + b1[0], (bfhi(a.z) - st[0]) * st[1] * w1[1] + b1[1]);
        o.w = cvt_pk_bf16((bflo(a.w) - st[0]) * st[1] * w1[2] + b1[2], (bfhi(a.w) - st[0]) * st[1] * w1[3] + b1[3]);
        *(LAS u32x4*)(lds + G_VN + r * RS_VN + c * 16) = o; }
    __syncthreads();
    f32x4 acc[2][8];
#pragma unroll
    for (int j2 = 0; j2 < 2; ++j2)
#pragma unroll
        for (int it = 0; it < 8; ++it) acc[j2][it] = (f32x4){0.f, 0.f, 0.f, 0.f};
#pragma unroll
    for (int ks = 0; ks < 4; ++ks) { bf16x8 Av[2];
#pragma unroll
        for (int j2 = 0; j2 < 2; ++j2) Av[j2] = tr_frag(lds + G_VN + 32 * ks * RS_VN + (32 * w + 16 * j2) * 2, RS_VN, lane);
#pragma unroll
        for (int it = 0; it < 8; ++it) { if (ks >= 2 && it < 4) continue; const bf16x8 Bw = row_frag(lds + G_WS + 16 * it * RS_WS + ks * 64, RS_WS, lane);
#pragma unroll
            for (int j2 = 0; j2 < 2; ++j2) acc[j2][it] = MFMA16(Av[j2], Bw, acc[j2][it]); } }
#pragma unroll
    for (int it = 0; it < 8; ++it) { const int i = 16 * it + l15; const float bs = p.b_s[g * 128 + i];
#pragma unroll
        for (int j2 = 0; j2 < 2; ++j2) { bf16_t* rp = proj + (size_t)(tok0 + i) * PJ + PC_UZ + g * 256 + 32 * w + 16 * j2 + 4 * g4; const u32x2 uz = uzr[it][j2]; const f32x4 a = acc[j2][it];
            u32x2 pk; pk.x = cvt_pk_bf16(bflo(uz.x) * (a[0] + bs), bfhi(uz.x) * (a[1] + bs)); pk.y = cvt_pk_bf16(bflo(uz.y) * (a[2] + bs), bfhi(uz.y) * (a[3] + bs)); if (!nostore) *(u32x2*)rp = pk; } }
    __syncthreads();
}
__device__ __forceinline__ void gmlp_sample_item(const Params& p, LAS unsigned char* lds, int b, bool nostore = false) {
    int tid_ = threadIdx.x; asm volatile("" : "+v"(tid_));
    const int tid = tid_, lane = tid & 63, w = tid >> 6; bf16_t* proj = (bf16_t*)(p.ws + WS_PROJ); const int tok0 = SEQ + b * SAMP_T;
    LAS float* vn = (LAS float*)lds; LAS float* wsm = (LAS float*)(lds + 65536); LAS float* st = (LAS float*)(lds + 65536 + 4096);
    for (int i = 0; i < 2; ++i) { const int r = 2 * w + i; const bf16_t* rp = proj + (size_t)(tok0 + r) * PJ + PC_GV;
        const u32x4 a = *(const u32x4*)(rp + lane * 8), bb = *(const u32x4*)(rp + 512 + lane * 8);
        float x[16]; x[0] = bflo(a.x); x[1] = bfhi(a.x); x[2] = bflo(a.y); x[3] = bfhi(a.y); x[4] = bflo(a.z); x[5] = bfhi(a.z); x[6] = bflo(a.w); x[7] = bfhi(a.w);
        x[8] = bflo(bb.x); x[9] = bfhi(bb.x); x[10] = bflo(bb.y); x[11] = bfhi(bb.y); x[12] = bflo(bb.z); x[13] = bfhi(bb.z); x[14] = bflo(bb.w); x[15] = bfhi(bb.w);
        float s = 0.f;
#pragma unroll
        for (int k = 0; k < 16; ++k) s += x[k];
        const float mean = wave_sum(s) * (1.0f / 1024.0f); float q = 0.f;
#pragma unroll
        for (int k = 0; k < 16; ++k) { const float d = x[k] - mean; q += d * d; }
        const float rstd = rsqrtf(wave_sum(q) * (1.0f / 1024.0f) + EPS);
        if (lane == 0) { st[r * 2] = mean; st[r * 2 + 1] = rstd; } }
    for (int e = tid; e < 1024; e += 512) { const int g = e >> 8, i = (e >> 4) & 15, j = e & 15; wsm[e] = p.w_s[(size_t)(g * 128 + i) * 128 + j]; }
    __syncthreads();
    float* vs = p.out + OUT_VS + (size_t)b * SAMP_T * 1024;
    for (int i = 0; i < 4; ++i) { const int e = tid + 512 * i, r = e >> 7, c = (e & 127) * 8; const u32x4 a = *(const u32x4*)(proj + (size_t)(tok0 + r) * PJ + PC_GV + c);
        const float mean = st[r * 2], rstd = st[r * 2 + 1]; const f32x4 w0 = *(const f32x4*)(p.ln_v_w + c), w1 = *(const f32x4*)(p.ln_v_w + c + 4), b0 = *(const f32x4*)(p.ln_v_b + c), b1 = *(const f32x4*)(p.ln_v_b + c + 4);
        f32x4 o0, o1; o0[0] = (bflo(a.x) - mean) * rstd * w0[0] + b0[0]; o0[1] = (bfhi(a.x) - mean) * rstd * w0[1] + b0[1]; o0[2] = (bflo(a.y) - mean) * rstd * w0[2] + b0[2]; o0[3] = (bfhi(a.y) - mean) * rstd * w0[3] + b0[3];
        o1[0] = (bflo(a.z) - mean) * rstd * w1[0] + b1[0]; o1[1] = (bfhi(a.z) - mean) * rstd * w1[1] + b1[1]; o1[2] = (bflo(a.w) - mean) * rstd * w1[2] + b1[2]; o1[3] = (bfhi(a.w) - mean) * rstd * w1[3] + b1[3];
        *(LAS f32x4*)(vn + r * 1024 + c) = o0; *(LAS f32x4*)(vn + r * 1024 + c + 4) = o1; *(f32x4*)(vs + r * 1024 + c) = o0; *(f32x4*)(vs + r * 1024 + c + 4) = o1; }
    __syncthreads();
    { const int c = tid * 2, g = c >> 8; f32x2 v[16];
#pragma unroll
      for (int j = 0; j < 16; ++j) v[j] = *(const LAS f32x2*)(vn + j * 1024 + c);
#pragma unroll
      for (int i = 0; i < 16; ++i) { float s0 = p.b_s[g * 128 + i], s1 = s0;
#pragma unroll
          for (int j = 0; j < 16; ++j) { const float wv = wsm[g * 256 + i * 16 + j]; s0 += wv * v[j][0]; s1 += wv * v[j][1]; }
          bf16_t* rp = proj + (size_t)(tok0 + i) * PJ + PC_UZ + c; const unsigned uz = *(const unsigned*)rp; if (!nostore) *(unsigned*)rp = cvt_pk_bf16(bflo(uz) * s0, bfhi(uz) * s1); } }
    __syncthreads();
}
__device__ __forceinline__ void phase4(const Params& p) {
    const unsigned* useg = (const unsigned*)((unsigned char*)p.out + RB_USEG); unsigned* sst = (unsigned*)((unsigned char*)p.out + RB_SSTART); const float* dseg = (const float*)(p.ws + WS_DSEG);
    int tid_ = threadIdx.x; asm volatile("" : "+v"(tid_)); const int tid = tid_; int bid_ = blockIdx.x; asm volatile("" : "+s"(bid_)); const int bid = bid_;
    for (int e2 = bid * 512 + tid; e2 < 65536; e2 += gridDim.x * 512) {
        const int e = e2 * 2, h = e >> 15, v = (e >> 7) & 255, kap = e & 127; float S0 = 0.f, S1 = 0.f;
        for (int s0 = 0; s0 < NSEG; s0 += 32) { unsigned u[32]; f32x2 dd[32];
#pragma unroll
            for (int s = 0; s < 32; ++s) { u[s] = __builtin_nontemporal_load(useg + (size_t)(s0 + s) * 65536 + e2); dd[s] = *(const f32x2*)(dseg + ((s0 + s) * 4 + h) * 128 + kap); }
#pragma unroll
            for (int s = 0; s < 32; ++s) { sst[(size_t)(s0 + s) * 65536 + e2] = cvt_pk_bf16(S0, S1); S0 = dd[s][0] * S0 + bflo(u[s]); S1 = dd[s][1] * S1 + bfhi(u[s]); } }
        p.out[OUT_SP + (size_t)(h * 128 + kap) * 256 + v] = S0; p.out[OUT_SP + (size_t)(h * 128 + kap + 1) * 256 + v] = S1; }
}
__device__ __forceinline__ void phase8(const Params& p, bool nostore = false) {
    int tid_ = threadIdx.x; asm volatile("" : "+v"(tid_)); const int tid = tid_; int bid_ = blockIdx.x; asm volatile("" : "+s"(bid_)); const int bid = bid_;
    const int lane = tid & 63, wv = tid >> 6;
    for (int row = SEQ + bid * 8 + wv; row < MTOT; row += gridDim.x * 8) { float* yr = p.out + (size_t)row * D;
        f32x4 v[4]; float ss = 0.f;
#pragma unroll
        for (int i = 0; i < 4; ++i) { v[i] = *(const f32x4*)(yr + i * 256 + lane * 4); ss += (v[i][0] * v[i][0] + v[i][1] * v[i][1]) + (v[i][2] * v[i][2] + v[i][3] * v[i][3]); }
        const float rstd = rsqrtf(wave_sum(ss) * (1.0f / D) + EPS);
#pragma unroll
        for (int i = 0; i < 4; ++i) { const int c = i * 256 + lane * 4; const f32x4 fw = *(const f32x4*)(p.final_norm_w + c); if (!nostore) *(f32x4*)(yr + c) = v[i] * rstd * fw; } }
}

__global__ __launch_bounds__(512, 2) void mega(Params p0) {
    extern __shared__ __attribute__((aligned(16))) unsigned char shm[];
    LAS unsigned char* lds = (LAS unsigned char*)shm;
    const bool multi = (p0.ph_hi - p0.ph_lo) > 1;
    if (multi) { volatile LAS unsigned* st = (volatile LAS unsigned*)(lds + LDS_BAR);
        if (threadIdx.x == 0) { st[0] = 0u; st[1] = 0u; }
        __syncthreads();
        (void)xcd_barrier_post((unsigned*)(p0.ws + WS_CTL), st); }
#ifdef PROBE_PH
    constexpr int PDUP = PROBE_PH >= 30 ? 3 : (PROBE_PH >= 20 ? 2 : PROBE_PH);
    const int nph = p0.ph_hi + 1;
#else
    const int nph = p0.ph_hi;
#endif
    for (int pi = p0.ph_lo; pi < nph; ++pi) {
#if defined(__HIP_DEVICE_COMPILE__)
        const __attribute__((address_space(4))) Params* kp = (const __attribute__((address_space(4))) Params*)__builtin_amdgcn_kernarg_segment_ptr();
        asm volatile("" : "+s"(kp));
        const Params p = *kp;
#else
        const Params p = p0;
#endif
        int bid_ = blockIdx.x; asm volatile("" : "+s"(bid_)); const int bid = bid_;
#ifdef PROBE_PH
        const int ph = pi > PDUP ? pi - 1 : pi; const bool first = (pi == PDUP); const bool nostore = first && (p.ph_hi < 100);
#else
        const int ph = pi; const bool nostore = false;
#endif
      {
        if (ph == 0) phase0(p, lds);
        else if (ph == 1) phase1(p);
        else if (ph == 2) { pg8::Order S; S.init(SEQ / 256, 32, gridDim.x, bid); Ptr1 P{(const char*)p.out + RB_H, (const char*)p.out + RB_BT1};
            Epi1 E{(bf16_t*)(p.ws + WS_PROJ), (float*)(p.ws + WS_GVST)};
#ifdef PROBE_PH
            if (!(first && PROBE_PH == 20)) pg8::gemm_phase<Epi1, Ptr1, pg8::Order>(lds, S, P, E, D, D, D);
            if (!(first && PROBE_PH == 21)) sample_gemm1(p, lds, bid);
#else
            if (bid & 8) sample_gemm1(p, lds, bid); pg8::gemm_phase<Epi1, Ptr1, pg8::Order>(lds, S, P, E, D, D, D); if (!(bid & 8)) sample_gemm1(p, lds, bid);
#endif
            }
        else if (ph == 3) {
            const int pm = (bid & 7) * 8 + (bid >> 5), hg = (bid >> 3) & 3;
            gla_segA(p, lds, pm, hg);
            gmlp_item(p, lds, 2 * pm, hg, nostore, true);
            gmlp_item(p, lds, 2 * pm + 1, hg, nostore, false);
            if (bid >= 16 && bid < 80) { const int it = bid - 16; gla_prep(p, lds, SEQ + (it >> 2) * SAMP_T, 1, SAMP_T, it & 3, 256 + (it >> 2), false, 0, 0); __syncthreads(); } }
        else if (ph == 4) { phase4(p); if (bid >= 128 && bid < 192) gla_out(p, lds, 1, (bid - 128) >> 2, (bid - 128) & 3, nostore);
            else if (bid >= 192 && bid < 208) gmlp_sample_item(p, lds, bid - 192, nostore); }
        else if (ph == 5) {
            gla_out(p, lds, 0, (bid & 7) * 8 + (bid >> 5), (bid >> 3) & 3, nostore); }
        else if (ph == 6) { pg8::Order2 S; S.c = bid; Ptr2 P{(const char*)(p.ws + WS_PROJ), (const char*)(p.ws + WS_BTA), (const char*)(p.ws + WS_BTB)};
            Epi2 E{(bf16_t*)(p.ws + WS_PROJ), p.b_gate, nostore}; if (bid & 8) sample_gemm2(p, bid, nostore); pg8::gemm_phase<Epi2, Ptr2, pg8::Order2>(lds, S, P, E, D, PJ, D); if (!(bid & 8)) sample_gemm2(p, bid, nostore); }
        else if (ph == 7) { pg8::Order S; S.init(SEQ / 256, 4, gridDim.x, bid); Ptr3 P{(const char*)(p.ws + WS_PROJ), (const char*)(p.ws + WS_BTO)};
            Epi3 E{p.x_prompt, (const float*)(p.ws + WS_ADA), p.final_norm_w, p.out, (float*)(p.ws + WS_XB), (unsigned*)(p.ws + WS_PCNT)}; if (bid & 8) sample_gemm3(p, bid); pg8::gemm_phase<Epi3, Ptr3, pg8::Order>(lds, S, P, E, D, PJ, D); if (!(bid & 8)) sample_gemm3(p, bid); }
        else if (ph == 8) phase8(p, nostore);
      }
        if (multi && pi + 1 < nph) { XcdBarrier xb; xb.bar = (unsigned*)(p.ws + WS_CTL); xb.x = xb_xcc_id(); xb.st = (volatile LAS unsigned*)(lds + LDS_BAR); xcd_barrier(xb); }
    }
}

#ifndef MK_LAUNCHES
#define MK_LAUNCHES 1
#endif
extern "C" void kernel_launch(void* const* d_in, const int* in_sizes, int n_in, void* d_out, int out_size, void* d_ws, size_t ws_size, hipStream_t stream) {
    static int ready = 0;
    if (ready == 0) {
        if (n_in != 21 || ws_size < WS_END) { fprintf(stderr, "kernel_launch: need 21 inputs and >= %zu bytes of workspace (got %d, %zu)\n", (size_t)WS_END, n_in, ws_size); ready = -1; return; }
        if (hipFuncSetAttribute((const void*)mega, hipFuncAttributeMaxDynamicSharedMemorySize, LDS_BYTES) != hipSuccess) { fprintf(stderr, "kernel_launch: hipFuncSetAttribute failed\n"); ready = -1; return; }
        int per_cu = 0; (void)hipOccupancyMaxActiveBlocksPerMultiprocessor(&per_cu, (const void*)mega, 512, LDS_BYTES); (void)hipGetLastError();
        if (per_cu < 1) fprintf(stderr, "kernel_launch: occupancy query reports %d blocks per CU\n", per_cu);
        ready = 1;
    }
    if (ready < 0) return;
    (void)hipMemsetAsync((char*)d_ws + WS_CTL, 0, 32768, stream);
    Params p{};
    const float** pp = (const float**)&p;
    for (int i = 0; i < 21; ++i) pp[i] = (const float*)d_in[i];
    p.out = (float*)d_out; p.ws = (unsigned char*)d_ws;
    const int nl = MK_LAUNCHES;
    for (int li = 0; li < nl; ++li) {
        p.ph_lo = (nl == 1) ? 0 : li; p.ph_hi = (nl == 1) ? 9 : li + 1;
        void* args[] = {&p};
        hipError_t e;
        if (nl == 1) e = hipLaunchCooperativeKernel((const void*)mega, dim3(256), dim3(512), args, LDS_BYTES, stream);
        else { hipLaunchKernelGGL(mega, dim3(256), dim3(512), LDS_BYTES, stream, p); e = hipPeekAtLastError(); }
        if (e != hipSuccess) { fprintf(stderr, "kernel_launch: launch %d failed: %s\n", li, hipGetErrorString(e)); break; }
    }
}
```

```cpp
#include <hip/hip_runtime.h>
#include <cstdio>

#define LAS __attribute__((address_space(3)))
typedef unsigned short bf16_t;
typedef short bf16x8 __attribute__((ext_vector_type(8)));
typedef short s16x4 __attribute__((ext_vector_type(4)));
typedef float f32x4 __attribute__((ext_vector_type(4)));
typedef float f32x2 __attribute__((ext_vector_type(2)));
typedef unsigned u32x4 __attribute__((ext_vector_type(4)));
typedef unsigned u32x2 __attribute__((ext_vector_type(2)));

constexpr int D = 1024, SEQ = 16384, NSAMP = 16, SAMP_T = 16, MTOT = SEQ + NSAMP * SAMP_T;
constexpr int WIN_LD = 8208;
constexpr int PJ = 7168;
constexpr int PC_Q = 0, PC_K = 512, PC_V = 1024, PC_R = 2048, PC_UZ = 3072, PC_GV = 4096, PC_GA = 5120;
constexpr int N1 = 8256;
constexpr int NSEG = 64, SEGCH = 4;
constexpr float EPS = 1e-6f;
constexpr size_t WS_CTL = 0, WS_PCNT = 16384, WS_ADA = 32768, WS_ALR = WS_ADA + 17 * 3072 * 4, WS_DSEG = WS_ALR + (size_t)MTOT * 16 * 4,
                 WS_ROWSS = WS_DSEG + NSEG * 4 * 128 * 4, WS_BTA = WS_ROWSS + (size_t)MTOT * 16 * 4, WS_BTB = WS_BTA + 2097152,
                 WS_BTO = WS_BTB + 2097152, WS_PROJ = WS_BTO + 4194304, WS_GVST = WS_PROJ + (size_t)MTOT * PJ * 2, WS_DCH = WS_GVST + (size_t)SEQ * 16 * 8, WS_XB = WS_DCH + (size_t)272 * 4 * 128 * 4, WS_END = WS_XB + (size_t)64 * 256 * 4 * 4;
constexpr size_t RB_H = 0, RB_BT1 = (size_t)MTOT * D * 2, RB_USEG = 0, RB_SSTART = 16777216;
constexpr size_t OUT_YS = (size_t)SEQ * D, OUT_SP = OUT_YS + 256 * D, OUT_SS = OUT_SP + 4 * 128 * 256, OUT_VS = OUT_SS + 16 * 4 * 128 * 256;
constexpr int LDS_BAR = 156160, LDS_BYTES = 156672;

struct Params {
    const float* x_prompt; const float* x_sample; const float* state_gla; const float* c_prompt; const float* c_sample;
    const float* norm_w; const float* w_ada; const float* b_ada; const float* w_in; const float* w_a2; const float* b_a;
    const float* gla_norm_w; const float* ln_v_w; const float* ln_v_b; const float* w_s; const float* b_s; const float* b_gate;
    const float* w_proj_a; const float* w_proj_b; const float* w_out; const float* final_norm_w;
    float* out; unsigned char* ws; int ph_lo; int ph_hi;
};

__device__ __forceinline__ unsigned cvt_pk_bf16(float lo, float hi) { unsigned r; asm volatile("v_cvt_pk_bf16_f32 %0, %1, %2" : "=v"(r) : "v"(lo), "v"(hi)); return r; }
__device__ __forceinline__ bf16_t f2bf(float f) { return (bf16_t)(cvt_pk_bf16(f, 0.f) & 0xffffu); }
__device__ __forceinline__ float bf2f(bf16_t b) { return __uint_as_float(((unsigned)b) << 16); }
__device__ __forceinline__ float bflo(unsigned w) { return __uint_as_float(w << 16); }
__device__ __forceinline__ float bfhi(unsigned w) { return __uint_as_float(w & 0xffff0000u); }
__device__ __forceinline__ float sigmoidf_(float x) { return __builtin_amdgcn_rcpf(1.0f + __expf(-x)); }
__device__ __forceinline__ float siluf_(float x) { return x * __builtin_amdgcn_rcpf(1.0f + __expf(-x)); }
__device__ __forceinline__ float wave_sum(float v) {
#pragma unroll
    for (int o = 32; o > 0; o >>= 1) v += __shfl_xor(v, o);
    return v;
}
__device__ __forceinline__ bf16x8 row_frag(const LAS unsigned char* base, int rs, int lane) { return *(const LAS bf16x8*)(base + rs * (lane & 15) + 16 * (lane >> 4)); }
__device__ __forceinline__ bf16x8 tr_frag(const LAS unsigned char* base, int rs, int lane) {
    const int g = lane >> 4, q = (lane & 15) >> 2, pp = lane & 3;
    const LAS unsigned char* a = base + rs * (8 * g + q) + 8 * pp;
    const s16x4 lo = __builtin_amdgcn_ds_read_tr16_b64_v4i16((LAS s16x4*)a);
    const s16x4 hi = __builtin_amdgcn_ds_read_tr16_b64_v4i16((LAS s16x4*)(a + 4 * rs));
    bf16x8 r; r[0] = lo[0]; r[1] = lo[1]; r[2] = lo[2]; r[3] = lo[3]; r[4] = hi[0]; r[5] = hi[1]; r[6] = hi[2]; r[7] = hi[3]; return r;
}
#define MFMA16(a, b, c) __builtin_amdgcn_mfma_f32_16x16x32_bf16(a, b, c, 0, 0, 0)

#define XB_TMO      128
#define XB_XCNT(j)  (256  + 64 * (j))
#define XB_XSUB(j)  (1280 + 64 * (j))
#define XB_XGEN(j)  (2304 + 64 * (j))
#define XB_TOP      3328
#define XB_TOPGEN   3392
#define XCD_BAR_WORDS 3456
#define XB_SPIN_CAP (1u << 22)
__device__ __forceinline__ unsigned xb_ld(unsigned* p)              { return __hip_atomic_load(p, __ATOMIC_RELAXED, __HIP_MEMORY_SCOPE_AGENT); }
__device__ __forceinline__ unsigned xb_add(unsigned* p, unsigned v) { return __hip_atomic_fetch_add(p, v, __ATOMIC_RELAXED, __HIP_MEMORY_SCOPE_AGENT); }
__device__ __forceinline__ unsigned xb_xcc_id() { return (unsigned)__builtin_amdgcn_s_getreg((3 << 11) | 20) & 0xFu; }
#define XB_SPIN(cond, bar) do { unsigned _sp = 0; while (cond) { __builtin_amdgcn_s_sleep(1); \
    if ((++_sp & 255u) == 0u) { if (xb_ld(&(bar)[XB_TMO])) break; if (_sp > XB_SPIN_CAP) { atomicAdd(&(bar)[XB_TMO], 1u); break; } } } } while (0)
struct XcdBarrier { unsigned* bar; unsigned x; volatile LAS unsigned* st; };
__device__ __forceinline__ XcdBarrier xcd_barrier_post(unsigned* bar, volatile LAS unsigned* st) {
    XcdBarrier b; b.bar = bar; b.x = xb_xcc_id(); b.st = st;
    if (threadIdx.x == 0) (void)xb_add(&bar[XB_XCNT(b.x)], 1u);
    return b;
}
__device__ __forceinline__ void xcd_barrier_complete(unsigned* bar, unsigned x, unsigned& nloc, unsigned& nx) {
    const unsigned G = gridDim.x * gridDim.y * gridDim.z;
    unsigned sum, cnt, mine, sp = 0u;
    for (;;) {
        sum = 0u; cnt = 0u; mine = 0u;
#pragma unroll
        for (unsigned j = 0; j < 16; ++j) { const unsigned c = xb_ld(&bar[XB_XCNT(j)]); sum += c; cnt += (c > 0u) ? 1u : 0u; mine = (j == x) ? c : mine; }
        if (sum == G) break;
        __builtin_amdgcn_s_sleep(1);
        if ((++sp & 255u) == 0u) { if (xb_ld(&bar[XB_TMO])) break; if (sp > XB_SPIN_CAP) { atomicAdd(&bar[XB_TMO], 1u); break; } }
    }
    nloc = mine > 0u ? mine : 1u; nx = cnt > 0u ? cnt : 1u;
}
__device__ __forceinline__ void xcd_barrier(const XcdBarrier& b) {
    asm volatile("s_waitcnt vmcnt(0)" ::: "memory");
    __syncthreads();
    if (threadIdx.x == 0) {
        unsigned* bar = b.bar;
        __builtin_amdgcn_s_waitcnt(0);
        unsigned nloc = b.st[0], nx = b.st[1];
        if (nloc == 0u) { xcd_barrier_complete(bar, b.x, nloc, nx); b.st[0] = nloc; b.st[1] = nx; }
        const unsigned old = xb_add(&bar[XB_XSUB(b.x)], 1u);
        const unsigned gen = old / nloc;
        if (old + 1u == (gen + 1u) * nloc) {
            __builtin_amdgcn_fence(__ATOMIC_RELEASE, "agent");
            asm volatile("s_waitcnt vmcnt(0)" ::: "memory");
            const unsigned og = xb_add(&bar[XB_TOP], 1u);
            const unsigned tg = og / nx;
            if (og + 1u == (tg + 1u) * nx) xb_add(&bar[XB_TOPGEN], 1u);
            else XB_SPIN(xb_ld(&bar[XB_TOPGEN]) == tg, bar);
            __builtin_amdgcn_fence(__ATOMIC_ACQUIRE, "agent");
            xb_add(&bar[XB_XGEN(b.x)], 1u);
            asm volatile("s_waitcnt vmcnt(0)" ::: "memory");
        } else {
            XB_SPIN(xb_ld(&bar[XB_XGEN(b.x)]) == gen, bar);
            __builtin_amdgcn_fence(__ATOMIC_ACQUIRE, "agent");
            asm volatile("s_waitcnt vmcnt(0)" ::: "memory");
        }
    }
    __syncthreads();
}

namespace pg8 {
constexpr int BM = 256, BK = 64, HALF = 128, HTB = HALF * BK * 2, NXCD = 8, WGM = 8;
__device__ __forceinline__ int lds_byte(int r, int c) { const int st = (r >> 4) * 2 + (c >> 5), rr = r & 15, cc = c & 31, ob = rr * 64 + cc * 2; return st * 1024 + (ob ^ (((ob >> 9) & 1) << 5)); }
__device__ __forceinline__ void stage_rc(int b, int& R, int& C) { const int st = b / 1024, sb = b % 1024, swz = sb ^ (((sb >> 9) & 1) << 5); R = (st >> 1) * 16 + swz / 64; C = (st & 1) * 32 + (swz % 64) / 2; }
__device__ __forceinline__ int perm32(int rho) { const int n = rho >> 4, i = rho & 15; return 8 * (i >> 2) + 4 * n + (i & 3); }
struct Unit { int pm, pn; };
struct Order {
    int nM, nN, nwg, G, c;
    __device__ void init(int nM_, int nN_, int G_, int c_) { nM = nM_; nN = nN_; nwg = nM * nN; G = G_; c = c_; }
    __device__ bool next(int i, Unit& u) const {
        const long L = (long)i * G + c; if (L >= nwg) return false;
        int wgid = (int)L; { const int q = nwg / NXCD, r = nwg % NXCD, xcd = wgid % NXCD, off = wgid / NXCD; wgid = (xcd < r ? xcd * (q + 1) : r * (q + 1) + (xcd - r) * q) + off; }
        const int nig = WGM * nN, gid = wgid / nig, fm = gid * WGM, gsz = (nM - fm) < WGM ? (nM - fm) : WGM;
        u.pm = fm + ((wgid % nig) % gsz); u.pn = (wgid % nig) / gsz; return true;
    }
};
struct Order2 {
    int c;
    __device__ bool next(int i, Unit& u) const { if (i >= 2) return false; const int x = c & 7, q = c >> 3; u.pm = x * 8 + (q >> 2); u.pn = (q & 3) + 4 * i; return true; }
};
template <class Epi, class Ptr, class Ord>
__device__ __forceinline__ void gemm_phase(LAS unsigned char* lds, const Ord& S, const Ptr& P, const Epi& E, int K, int lda, int ldb) {
    int tid_ = threadIdx.x; asm volatile("" : "+v"(tid_));
    const int tid = tid_, wid = __builtin_amdgcn_readfirstlane(tid >> 6), lane = tid & 63, wr = wid >> 2, wc = wid & 3, fr = lane & 15, fq = lane >> 4;
    const int nt = K / BK;
    unsigned voffA[2], voffB[2];
#pragma unroll
    for (int i = 0; i < 2; ++i) { int R, C; stage_rc(tid * 16 + i * 8192, R, C); const int Rb = Epi::PERM ? ((R & ~31) + perm32(R & 31)) : R;
        voffA[i] = (unsigned)(R * lda + C) * 2u; voffB[i] = (unsigned)(Rb * ldb + C) * 2u; }
    const size_t kstep = (size_t)(BK * 2);
    const size_t hstepA = (size_t)HALF * lda * 2, hstepB = (size_t)HALF * ldb * 2;
    const unsigned ldsw = (unsigned)wid * 1024u;
    const int aoff = lds_byte(wr * 64 + fr, fq * 8), boff = lds_byte(wc * 32 + fr, fq * 8);
#define PG8_SA(b, h) (((b) * 2 + (h)) * HTB)
#define PG8_SB(b, h) ((4 + (b) * 2 + (h)) * HTB)
#define PG8_STAGE(bufoff, gbase, voff) do { _Pragma("unroll") for (int _i = 0; _i < 2; ++_i) \
        __builtin_amdgcn_global_load_lds((const unsigned*)((const char*)(gbase) + (voff)[_i]), (LAS unsigned*)(lds + (bufoff) + ldsw + _i * 8192), 16, 0, 0); } while (0)
#define PG8_LDA(dst, b, h) do { _Pragma("unroll") for (int m = 0; m < 4; ++m) _Pragma("unroll") for (int k = 0; k < 2; ++k) dst[m][k] = *(const LAS bf16x8*)(lds + PG8_SA(b, h) + aoff + m * 2048 + k * 1024); } while (0)
#define PG8_LDB(dst, b, h) do { _Pragma("unroll") for (int n = 0; n < 2; ++n) _Pragma("unroll") for (int k = 0; k < 2; ++k) dst[n][k] = *(const LAS bf16x8*)(lds + PG8_SB(b, h) + boff + n * 2048 + k * 1024); } while (0)
#define PG8_MMA(ai, bj, At, Bt) do { __builtin_amdgcn_s_setprio(1); _Pragma("unroll") for (int m = 0; m < 4; ++m) _Pragma("unroll") for (int n = 0; n < 2; ++n) _Pragma("unroll") for (int k = 0; k < 2; ++k) \
        acc[ai][bj][m][n] = __builtin_amdgcn_mfma_f32_16x16x32_bf16(Bt[n][k], At[m][k], acc[ai][bj][m][n], 0, 0, 0); __builtin_amdgcn_s_setprio(0); } while (0)
#define PG8_WAIT_V(n) asm volatile("s_waitcnt vmcnt(" #n ")" ::: "memory")
#define PG8_WAIT_L(n) asm volatile("s_waitcnt lgkmcnt(" #n ")" ::: "memory")
#define PG8_BAR __builtin_amdgcn_s_barrier()
#define PG8_SCHED __builtin_amdgcn_sched_barrier(0)
    Unit cur, nxt; int ui = 0;
    if (!S.next(0, cur)) return;
    f32x4 acc[2][2][4][2];
#pragma unroll
    for (int a = 0; a < 2; ++a)
#pragma unroll
        for (int b = 0; b < 2; ++b)
#pragma unroll
            for (int m = 0; m < 4; ++m)
#pragma unroll
                for (int n = 0; n < 2; ++n) acc[a][b][m][n] = (f32x4){0.f, 0.f, 0.f, 0.f};
    bf16x8 At[4][2], B0[2][2], B1[2][2];
    const char* cA = P.aptr(cur); const char* cB = P.bptr(cur);
    PG8_STAGE(PG8_SB(0, 0), cB, voffB); PG8_STAGE(PG8_SA(0, 0), cA, voffA); PG8_STAGE(PG8_SB(0, 1), cB + hstepB, voffB); PG8_STAGE(PG8_SA(0, 1), cA + hstepA, voffA);
    if (wr == 1) PG8_BAR;
    PG8_WAIT_V(4); PG8_BAR;
    PG8_STAGE(PG8_SB(1, 0), cB + kstep, voffB); PG8_STAGE(PG8_SA(1, 0), cA + kstep, voffA); PG8_STAGE(PG8_SB(1, 1), cB + hstepB + kstep, voffB);
    PG8_WAIT_V(6); PG8_BAR;
    for (;;) {
        const bool has_next = S.next(ui + 1, nxt);
        const char* nA = has_next ? P.aptr(nxt) : cA; const char* nB = has_next ? P.bptr(nxt) : cB;
        for (int t = 0; t < nt; t += 2) {
            const bool last = (t == nt - 2);
            const char* a1 = cA + (size_t)(t + 1) * kstep;
            const char* a2 = last ? nA : cA + (size_t)(t + 2) * kstep; const char* b2 = last ? nB : cB + (size_t)(t + 2) * kstep;
            const char* a3 = a2 + kstep; const char* b3 = b2 + kstep;
            PG8_LDB(B0, 0, 0); PG8_SCHED; PG8_LDA(At, 0, 0); PG8_STAGE(PG8_SA(1, 1), a1 + hstepA, voffA);
            PG8_WAIT_L(8); PG8_BAR; PG8_WAIT_L(0); PG8_MMA(0, 0, At, B0); PG8_BAR; PG8_SCHED;
            PG8_LDB(B1, 0, 1); PG8_STAGE(PG8_SB(0, 0), b2, voffB);
            PG8_BAR; PG8_WAIT_L(0); PG8_MMA(0, 1, At, B1); PG8_BAR;
            PG8_LDA(At, 0, 1); PG8_STAGE(PG8_SA(0, 0), a2, voffA);
            PG8_BAR; PG8_WAIT_L(0); PG8_MMA(1, 0, At, B0); PG8_BAR; PG8_SCHED;
            PG8_STAGE(PG8_SB(0, 1), b2 + hstepB, voffB);
            PG8_WAIT_V(6); PG8_BAR; PG8_MMA(1, 1, At, B1); PG8_BAR;
            PG8_LDB(B0, 1, 0); PG8_SCHED; PG8_LDA(At, 1, 0); PG8_STAGE(PG8_SA(0, 1), a2 + hstepA, voffA);
            PG8_WAIT_L(8); PG8_BAR; PG8_WAIT_L(0); PG8_MMA(0, 0, At, B0); PG8_BAR; PG8_SCHED;
            PG8_LDB(B1, 1, 1); PG8_STAGE(PG8_SB(1, 0), b3, voffB);
            PG8_BAR; PG8_WAIT_L(0); PG8_MMA(0, 1, At, B1); PG8_BAR;
            PG8_LDA(At, 1, 1); PG8_STAGE(PG8_SA(1, 0), a3, voffA);
            PG8_BAR; PG8_WAIT_L(0); PG8_MMA(1, 0, At, B0); PG8_BAR; PG8_SCHED;
            PG8_STAGE(PG8_SB(1, 1), b3 + hstepB, voffB);
            PG8_WAIT_V(6); PG8_BAR; PG8_MMA(1, 1, At, B1); PG8_BAR;
        }
        bool keep = false;
        if constexpr (!Epi::AFTER_DRAIN) keep = E(acc, cur, wr, wc, fr, fq);
        if (!has_next) break;
        if (!keep) {
#pragma unroll
        for (int a = 0; a < 2; ++a)
#pragma unroll
            for (int b = 0; b < 2; ++b)
#pragma unroll
                for (int m = 0; m < 4; ++m)
#pragma unroll
                    for (int n = 0; n < 2; ++n) acc[a][b][m][n] = (f32x4){0.f, 0.f, 0.f, 0.f};
        }
        cur = nxt; cA = nA; cB = nB; ++ui;
    }
    PG8_WAIT_V(0);
    if (wr == 0) PG8_BAR;
    PG8_BAR;
    if constexpr (Epi::AFTER_DRAIN) E.fused(acc, cur, wr, wc, fr, fq, lds, wid, lane);
#undef PG8_SA
#undef PG8_SB
#undef PG8_STAGE
#undef PG8_LDA
#undef PG8_LDB
#undef PG8_MMA
#undef PG8_WAIT_V
#undef PG8_WAIT_L
#undef PG8_BAR
#undef PG8_SCHED
}
}
using pg8::Unit;

struct Ptr1 { const char* A; const char* B; __device__ const char* aptr(const Unit& u) const { return A + (size_t)u.pm * 256 * D * 2; } __device__ const char* bptr(const Unit& u) const { return B + (size_t)u.pn * 256 * D * 2; } };
struct Epi1 {
    static constexpr bool PERM = true, AFTER_DRAIN = false;
    bf16_t* proj; float* gvst;
    __device__ __forceinline__ bool operator()(f32x4 (&acc)[2][2][4][2], const Unit& u, int wr, int wc, int fr, int fq) const {
        asm volatile("" : "+v"(fr), "+v"(fq));
        const int row0 = u.pm * 256 + wr * 64 + fr;
        if (u.pn >= 12 && u.pn < 20) {
            const int col = PC_UZ + (u.pn - 12) * 128 + wc * 32 + 8 * fq;
#pragma unroll
            for (int ai = 0; ai < 2; ++ai)
#pragma unroll
                for (int m = 0; m < 4; ++m) { bf16_t* rp = proj + (size_t)(row0 + ai * 128 + m * 16) * PJ + col;
                    const f32x4 u0 = acc[ai][0][m][0], u1 = acc[ai][0][m][1], z0 = acc[ai][1][m][0], z1 = acc[ai][1][m][1];
                    u32x4 w; w.x = cvt_pk_bf16(u0[0] * siluf_(z0[0]), u0[1] * siluf_(z0[1])); w.y = cvt_pk_bf16(u0[2] * siluf_(z0[2]), u0[3] * siluf_(z0[3]));
                    w.z = cvt_pk_bf16(u1[0] * siluf_(z1[0]), u1[1] * siluf_(z1[1])); w.w = cvt_pk_bf16(u1[2] * siluf_(z1[2]), u1[3] * siluf_(z1[3]));
                    __builtin_nontemporal_store(w, (u32x4*)rp); }
            return false;
        }
        const int col = (u.pn < 12 ? u.pn * 256 : PC_GV + (u.pn - 20) * 256) + wc * 32 + 8 * fq;
        const bool isgv = u.pn >= 20 && u.pn < 24;
#pragma unroll
        for (int ai = 0; ai < 2; ++ai)
#pragma unroll
            for (int m = 0; m < 4; ++m) { const int row = row0 + ai * 128 + m * 16; bf16_t* rp = proj + (size_t)row * PJ + col; float s = 0.f, q = 0.f;
#pragma unroll
                for (int bj = 0; bj < 2; ++bj) { const f32x4 v0 = acc[ai][bj][m][0], v1 = acc[ai][bj][m][1];
                    u32x4 w; w.x = cvt_pk_bf16(v0[0], v0[1]); w.y = cvt_pk_bf16(v0[2], v0[3]); w.z = cvt_pk_bf16(v1[0], v1[1]); w.w = cvt_pk_bf16(v1[2], v1[3]);
                    __builtin_nontemporal_store(w, (u32x4*)(rp + bj * 128));
                    s += (v0[0] + v0[1]) + (v0[2] + v0[3]) + (v1[0] + v1[1]) + (v1[2] + v1[3]);
                    q += (v0[0] * v0[0] + v0[1] * v0[1]) + (v0[2] * v0[2] + v0[3] * v0[3]) + (v1[0] * v1[0] + v1[1] * v1[1]) + (v1[2] * v1[2] + v1[3] * v1[3]); }
                if (isgv) { s += __shfl_xor(s, 16); s += __shfl_xor(s, 32); q += __shfl_xor(q, 16); q += __shfl_xor(q, 32);
                    if (fq == 0) *(f32x2*)(gvst + ((size_t)row * 16 + (u.pn - 20) * 4 + wc) * 2) = (f32x2){s, q}; } }
        return false;
    }
};
struct Ptr2 { const char* proj; const char* BA; const char* BB;
    __device__ const char* aptr(const Unit& u) const { return proj + ((size_t)u.pm * 256 * PJ + (u.pn < 4 ? PC_R : PC_UZ)) * 2; }
    __device__ const char* bptr(const Unit& u) const { return (u.pn < 4 ? BA : BB) + (size_t)(u.pn & 3) * 256 * D * 2; } };
struct Epi2 {
    static constexpr bool PERM = true, AFTER_DRAIN = false;
    bf16_t* proj; const float* b_gate; bool nostore;
    __device__ __forceinline__ bool operator()(f32x4 (&acc)[2][2][4][2], const Unit& u, int wr, int wc, int fr, int fq) const {
        asm volatile("" : "+v"(fr), "+v"(fq));
        const int row0 = u.pm * 256 + wr * 64 + fr, col = (u.pn & 3) * 256 + wc * 32 + 8 * fq; const bool first = u.pn < 4;
        bf16_t* base = proj + (size_t)row0 * PJ + PC_GA + col;
        if (first) {
#pragma unroll
            for (int bj = 0; bj < 2; ++bj) { const float* ba = b_gate + col + bj * 128; const f32x4 bA0 = *(const f32x4*)ba, bA1 = *(const f32x4*)(ba + 4), bB0 = *(const f32x4*)(ba + 1024), bB1 = *(const f32x4*)(ba + 1028);
#pragma unroll
                for (int ai = 0; ai < 2; ++ai) { u32x4 ga[4], gb[4];
#pragma unroll
                    for (int m = 0; m < 4; ++m) { const bf16_t* rp = base + (size_t)(ai * 128 + m * 16) * PJ + bj * 128; ga[m] = *(const u32x4*)rp; gb[m] = *(const u32x4*)(rp + 1024); }
                    __builtin_amdgcn_sched_barrier(0);
#pragma unroll
                    for (int m = 0; m < 4; ++m) { float ea[8], eb[8];
                        ea[0] = __expf(-(bflo(ga[m].x) + bA0[0])); ea[1] = __expf(-(bfhi(ga[m].x) + bA0[1])); ea[2] = __expf(-(bflo(ga[m].y) + bA0[2])); ea[3] = __expf(-(bfhi(ga[m].y) + bA0[3]));
                        ea[4] = __expf(-(bflo(ga[m].z) + bA1[0])); ea[5] = __expf(-(bfhi(ga[m].z) + bA1[1])); ea[6] = __expf(-(bflo(ga[m].w) + bA1[2])); ea[7] = __expf(-(bfhi(ga[m].w) + bA1[3]));
                        eb[0] = __expf(-(bflo(gb[m].x) + bB0[0])); eb[1] = __expf(-(bfhi(gb[m].x) + bB0[1])); eb[2] = __expf(-(bflo(gb[m].y) + bB0[2])); eb[3] = __expf(-(bfhi(gb[m].y) + bB0[3]));
                        eb[4] = __expf(-(bflo(gb[m].z) + bB1[0])); eb[5] = __expf(-(bfhi(gb[m].z) + bB1[1])); eb[6] = __expf(-(bflo(gb[m].w) + bB1[2])); eb[7] = __expf(-(bfhi(gb[m].w) + bB1[3]));
#pragma unroll
                        for (int j = 0; j < 4; ++j) { acc[ai][bj][m][0][j] *= (1.0f + eb[j]) * __builtin_amdgcn_rcpf(1.0f + ea[j]); acc[ai][bj][m][1][j] *= (1.0f + eb[4 + j]) * __builtin_amdgcn_rcpf(1.0f + ea[4 + j]); } } } }
            return true;
        }
#pragma unroll
        for (int bj = 0; bj < 2; ++bj) { const float* ba = b_gate + col + bj * 128; const f32x4 bB0 = *(const f32x4*)(ba + 1024), bB1 = *(const f32x4*)(ba + 1028);
#pragma unroll
            for (int ai = 0; ai < 2; ++ai) { u32x4 gb[4];
#pragma unroll
                for (int m = 0; m < 4; ++m) gb[m] = *(const u32x4*)(base + (size_t)(ai * 128 + m * 16) * PJ + bj * 128 + 1024);
                __builtin_amdgcn_sched_barrier(0);
#pragma unroll
                for (int m = 0; m < 4; ++m) { float sb[8];
                    sb[0] = sigmoidf_(bflo(gb[m].x) + bB0[0]); sb[1] = sigmoidf_(bfhi(gb[m].x) + bB0[1]); sb[2] = sigmoidf_(bflo(gb[m].y) + bB0[2]); sb[3] = sigmoidf_(bfhi(gb[m].y) + bB0[3]);
                    sb[4] = sigmoidf_(bflo(gb[m].z) + bB1[0]); sb[5] = sigmoidf_(bfhi(gb[m].z) + bB1[1]); sb[6] = sigmoidf_(bflo(gb[m].w) + bB1[2]); sb[7] = sigmoidf_(bfhi(gb[m].w) + bB1[3]);
                    const f32x4 v0 = acc[ai][bj][m][0], v1 = acc[ai][bj][m][1];
                    u32x4 w; w.x = cvt_pk_bf16(v0[0] * sb[0], v0[1] * sb[1]); w.y = cvt_pk_bf16(v0[2] * sb[2], v0[3] * sb[3]); w.z = cvt_pk_bf16(v1[0] * sb[4], v1[1] * sb[5]); w.w = cvt_pk_bf16(v1[2] * sb[6], v1[3] * sb[7]);
                    if (!nostore) *(u32x4*)(base + (size_t)(ai * 128 + m * 16) * PJ + bj * 128) = w; } } }
        return false;
    }
};
struct Ptr3 { const char* proj; const char* BO;
    __device__ const char* aptr(const Unit& u) const { return proj + ((size_t)u.pm * 256 * PJ + PC_GA) * 2; }
    __device__ const char* bptr(const Unit& u) const { return BO + (size_t)u.pn * 256 * D * 2; } };
struct Epi3 {
    static constexpr bool PERM = false, AFTER_DRAIN = true;
    const float* xp; const float* ada; const float* fw; float* out; float* xbuf; unsigned* cnt;
    __device__ __forceinline__ bool operator()(f32x4 (&acc)[2][2][4][2], const Unit& u, int wr, int wc, int fr, int fq) const { return false; }
    __device__ __forceinline__ void fused(f32x4 (&acc)[2][2][4][2], const Unit& u, int wr, int wc, int fr, int fq, LAS unsigned char* lds, int wid, int lane) const {
        asm volatile("" : "+v"(fr), "+v"(fq));
        LAS float* P = (LAS float*)lds; LAS float* S = (LAS float*)(lds + 4096);
        const int row0 = u.pm * 256 + wr * 64 + fr, col0 = u.pn * 256 + wc * 32 + 4 * fq;
        f32x4 gt[4];
#pragma unroll
        for (int q = 0; q < 4; ++q) gt[q] = *(const f32x4*)(ada + 2048 + col0 + (q >> 1) * 128 + (q & 1) * 16);
#pragma unroll
        for (int ai = 0; ai < 2; ++ai) { f32x4 xv[4][4];
#pragma unroll
            for (int m = 0; m < 4; ++m)
#pragma unroll
                for (int q = 0; q < 4; ++q) xv[m][q] = __builtin_nontemporal_load((const f32x4*)(xp + (size_t)(row0 + ai * 128 + m * 16) * D + col0 + (q >> 1) * 128 + (q & 1) * 16));
            __builtin_amdgcn_sched_barrier(0);
#pragma unroll
            for (int m = 0; m < 4; ++m) { const int lrow = ai * 128 + wr * 64 + m * 16 + fr; float ss = 0.f;
#pragma unroll
                for (int q = 0; q < 4; ++q) { const f32x4 r = xv[m][q] + gt[q] * acc[ai][q >> 1][m][q & 1]; acc[ai][q >> 1][m][q & 1] = r; ss += (r[0] * r[0] + r[1] * r[1]) + (r[2] * r[2] + r[3] * r[3]); }
                ss += __shfl_xor(ss, 16); ss += __shfl_xor(ss, 32);
                if (fq == 0) P[lrow * 4 + wc] = ss; } }
        __syncthreads();
        const int prow = wid * 32 + (lane & 31);
        if (lane < 32) { const f32x4 pp = *(const LAS f32x4*)(P + prow * 4);
            __hip_atomic_store(xbuf + ((size_t)u.pm * 256 + prow) * 4 + u.pn, (pp[0] + pp[1]) + (pp[2] + pp[3]), __ATOMIC_RELAXED, __HIP_MEMORY_SCOPE_AGENT); }
        asm volatile("s_waitcnt vmcnt(0)" ::: "memory");
        if (lane == 0) __hip_atomic_fetch_add(cnt + 64 * u.pm, 1u, __ATOMIC_RELAXED, __HIP_MEMORY_SCOPE_AGENT);
        if (wid == 0) { unsigned sp = 0u;
            while ((unsigned)__builtin_amdgcn_readfirstlane(__hip_atomic_load(cnt + 64 * u.pm, __ATOMIC_RELAXED, __HIP_MEMORY_SCOPE_AGENT)) < 32u) { __builtin_amdgcn_s_sleep(2); if (++sp > (1u << 22)) break; }
            __builtin_amdgcn_fence(__ATOMIC_ACQUIRE, "agent"); }
        asm volatile("s_waitcnt vmcnt(0) lgkmcnt(0)" ::: "memory"); __syncthreads();
        if (lane < 32) { const float* sl = xbuf + ((size_t)u.pm * 256 + prow) * 4; float t = 0.f;
#pragma unroll
            for (int q = 0; q < 4; ++q) t += __hip_atomic_load(sl + q, __ATOMIC_RELAXED, __HIP_MEMORY_SCOPE_AGENT);
            S[prow] = rsqrtf(t * (1.0f / D) + EPS); }
        __syncthreads();
        f32x4 fv[4];
#pragma unroll
        for (int q = 0; q < 4; ++q) fv[q] = *(const f32x4*)(fw + col0 + (q >> 1) * 128 + (q & 1) * 16);
#pragma unroll
        for (int ai = 0; ai < 2; ++ai)
#pragma unroll
            for (int m = 0; m < 4; ++m) { const int row = row0 + ai * 128 + m * 16, lrow = ai * 128 + wr * 64 + m * 16 + fr; const float rs = S[lrow]; float* orow = out + (size_t)row * D + col0;
#pragma unroll
                for (int q = 0; q < 4; ++q) __builtin_nontemporal_store(acc[ai][q >> 1][m][q & 1] * rs * fv[q], (f32x4*)(orow + (q >> 1) * 128 + (q & 1) * 16)); }
    }
};
template <int AM, int BN>
__device__ __forceinline__ void wave_gemm(const bf16_t* const (&Ar)[AM], int lda, const bf16_t* const (&Br)[BN], int ldb, int K, int lane, f32x4 (&acc)[AM][BN]) {
    const bf16_t* a[AM]; const bf16_t* b[BN];
#pragma unroll
    for (int i = 0; i < AM; ++i) a[i] = Ar[i] + (size_t)(lane & 15) * lda + 8 * (lane >> 4);
#pragma unroll
    for (int i = 0; i < BN; ++i) b[i] = Br[i] + (size_t)(lane & 15) * ldb + 8 * (lane >> 4);
    constexpr int KB = (AM + BN) >= 4 ? 8 : 16;
    for (int k0 = 0; k0 < K; k0 += 32 * KB) { bf16x8 fa[KB][AM], fb[KB][BN];
#pragma unroll
        for (int s = 0; s < KB; ++s) {
#pragma unroll
            for (int i = 0; i < AM; ++i) fa[s][i] = *(const bf16x8*)(a[i] + k0 + 32 * s);
#pragma unroll
            for (int i = 0; i < BN; ++i) fb[s][i] = *(const bf16x8*)(b[i] + k0 + 32 * s); }
        __builtin_amdgcn_sched_barrier(0);
#pragma unroll
        for (int s = 0; s < KB; ++s)
#pragma unroll
            for (int i = 0; i < AM; ++i)
#pragma unroll
                for (int j = 0; j < BN; ++j) acc[i][j] = MFMA16(fb[s][j], fa[s][i], acc[i][j]); }
}
__device__ __forceinline__ void sample_gemm1(const Params& p, LAS unsigned char* lds, int bid) {
    int tid_ = threadIdx.x; asm volatile("" : "+v"(tid_)); const int tid = tid_, lane = tid & 63, w = tid >> 6, g4 = lane >> 4, l15 = lane & 15;
    const bf16_t* H = (const bf16_t*)((const unsigned char*)p.out + RB_H); const bf16_t* bt1 = (const bf16_t*)((const unsigned char*)p.out + RB_BT1); bf16_t* proj = (bf16_t*)(p.ws + WS_PROJ);
    constexpr int RS = 528, LB = 256 * RS;
    int b0, b1, ocol; const bool uz = bid >= 96 && bid < 160;
    if (bid < 96) { b0 = 32 * bid; b1 = b0 + 16; ocol = 32 * bid; }
    else if (uz) { const int j = bid - 96; b0 = 3072 + (j >> 3) * 256 + (j & 7) * 16; b1 = b0 + 128; ocol = PC_UZ + 16 * j; }
    else { b0 = 5120 + 32 * (bid - 160); b1 = b0 + 16; ocol = PC_GV + 32 * (bid - 160); }
    u32x4 ra[16], rb[2];
    const int pr = tid >> 5, pc = tid & 31;
    const bf16_t* ag = H + (size_t)(SEQ + pr) * D + pc * 8;
    const bf16_t* bg0 = bt1 + (size_t)(b0 + pr) * D + pc * 8; const bf16_t* bg1 = bt1 + (size_t)(b1 + pr) * D + pc * 8;
#pragma unroll
    for (int i = 0; i < 16; ++i) ra[i] = *(const u32x4*)(ag + (size_t)i * 16 * D);
    rb[0] = *(const u32x4*)bg0; rb[1] = *(const u32x4*)bg1;
    f32x4 acc[2][2];
#pragma unroll
    for (int i = 0; i < 2; ++i)
#pragma unroll
        for (int j = 0; j < 2; ++j) acc[i][j] = (f32x4){0.f, 0.f, 0.f, 0.f};
    for (int kc = 0; kc < 4; ++kc) {
#pragma unroll
        for (int i = 0; i < 16; ++i) *(LAS u32x4*)(lds + (pr + 16 * i) * RS + pc * 16) = ra[i];
        *(LAS u32x4*)(lds + LB + pr * RS + pc * 16) = rb[0]; *(LAS u32x4*)(lds + LB + (16 + pr) * RS + pc * 16) = rb[1];
        __syncthreads();
        if (kc + 1 < 4) { int ko = (kc + 1) * 256; asm volatile("" : "+v"(ko));
#pragma unroll
            for (int i = 0; i < 16; ++i) ra[i] = *(const u32x4*)(ag + (size_t)i * 16 * D + ko);
            rb[0] = *(const u32x4*)(bg0 + ko); rb[1] = *(const u32x4*)(bg1 + ko); }
#pragma unroll
        for (int ks = 0; ks < 8; ++ks) { bf16x8 fa[2], fb[2];
#pragma unroll
            for (int i = 0; i < 2; ++i) { fa[i] = row_frag(lds + (32 * w + 16 * i) * RS + ks * 64, RS, lane); fb[i] = row_frag(lds + LB + 16 * i * RS + ks * 64, RS, lane); }
#pragma unroll
            for (int i = 0; i < 2; ++i)
#pragma unroll
                for (int j = 0; j < 2; ++j) acc[i][j] = MFMA16(fb[j], fa[i], acc[i][j]); }
        __syncthreads();
    }
    const int r0 = SEQ + 32 * w;
#pragma unroll
    for (int i = 0; i < 2; ++i) { bf16_t* rp = proj + (size_t)(r0 + 16 * i + l15) * PJ + ocol + 4 * g4;
        if (uz) { const f32x4 u = acc[i][0], z = acc[i][1]; u32x2 pk; pk.x = cvt_pk_bf16(u[0] * siluf_(z[0]), u[1] * siluf_(z[1])); pk.y = cvt_pk_bf16(u[2] * siluf_(z[2]), u[3] * siluf_(z[3])); *(u32x2*)rp = pk; }
        else {
#pragma unroll
            for (int j = 0; j < 2; ++j) { u32x2 pk; pk.x = cvt_pk_bf16(acc[i][j][0], acc[i][j][1]); pk.y = cvt_pk_bf16(acc[i][j][2], acc[i][j][3]); *(u32x2*)(rp + 16 * j) = pk; } } }
}
__device__ __forceinline__ void sample_gemm2(const Params& p, int bid, bool nostore) {
    int tid_ = threadIdx.x; asm volatile("" : "+v"(tid_)); const int lane = tid_ & 63, w = tid_ >> 6, g4 = lane >> 4, l15 = lane & 15;
    if (w >= 4) return;
    bf16_t* proj = (bf16_t*)(p.ws + WS_PROJ); const bf16_t* bta = (const bf16_t*)(p.ws + WS_BTA); const bf16_t* btb = (const bf16_t*)(p.ws + WS_BTB);
    const int tile = bid * 4 + w, rt = tile >> 6, ct = tile & 63, r0 = SEQ + 16 * rt, c0 = 16 * ct;
    f32x4 aa[1][1], ab[1][1]; aa[0][0] = (f32x4){0.f, 0.f, 0.f, 0.f}; ab[0][0] = aa[0][0];
    { const bf16_t* const Ar[1] = {proj + (size_t)r0 * PJ + PC_R}; const bf16_t* const Br[1] = {bta + (size_t)c0 * D}; wave_gemm<1, 1>(Ar, PJ, Br, D, D, lane, aa); }
    { const bf16_t* const Ar[1] = {proj + (size_t)r0 * PJ + PC_UZ}; const bf16_t* const Br[1] = {btb + (size_t)c0 * D}; wave_gemm<1, 1>(Ar, PJ, Br, D, D, lane, ab); }
    bf16_t* rp = proj + (size_t)(r0 + l15) * PJ + PC_GA + c0 + 4 * g4; const u32x2 ga = *(const u32x2*)rp, gb = *(const u32x2*)(rp + 1024);
    const f32x4 bA = *(const f32x4*)(p.b_gate + c0 + 4 * g4), bB = *(const f32x4*)(p.b_gate + 1024 + c0 + 4 * g4);
    float o[4];
    o[0] = sigmoidf_(bflo(ga.x) + bA[0]) * aa[0][0][0] + sigmoidf_(bflo(gb.x) + bB[0]) * ab[0][0][0]; o[1] = sigmoidf_(bfhi(ga.x) + bA[1]) * aa[0][0][1] + sigmoidf_(bfhi(gb.x) + bB[1]) * ab[0][0][1];
    o[2] = sigmoidf_(bflo(ga.y) + bA[2]) * aa[0][0][2] + sigmoidf_(bflo(gb.y) + bB[2]) * ab[0][0][2]; o[3] = sigmoidf_(bfhi(ga.y) + bA[3]) * aa[0][0][3] + sigmoidf_(bfhi(gb.y) + bB[3]) * ab[0][0][3];
    u32x2 pk; pk.x = cvt_pk_bf16(o[0], o[1]); pk.y = cvt_pk_bf16(o[2], o[3]); if (!nostore) *(u32x2*)rp = pk;
}
__device__ __forceinline__ void sample_gemm3(const Params& p, int bid) {
    int tid_ = threadIdx.x; asm volatile("" : "+v"(tid_)); const int lane = tid_ & 63, w = tid_ >> 6, g4 = lane >> 4, l15 = lane & 15;
    if (w >= 4) return;
    const bf16_t* proj = (const bf16_t*)(p.ws + WS_PROJ); const bf16_t* bto = (const bf16_t*)(p.ws + WS_BTO); const float* ada = (const float*)(p.ws + WS_ADA);
    const int tile = bid * 4 + w, rt = tile >> 6, ct = tile & 63, c0 = 16 * ct + 4 * g4, rs = 16 * rt + l15;
    f32x4 acc[1][1]; acc[0][0] = (f32x4){0.f, 0.f, 0.f, 0.f};
    { const bf16_t* const Ar[1] = {proj + (size_t)(SEQ + 16 * rt) * PJ + PC_GA}; const bf16_t* const Br[1] = {bto + (size_t)16 * ct * D}; wave_gemm<1, 1>(Ar, PJ, Br, D, D, lane, acc); }
    const f32x4 xv = *(const f32x4*)(p.x_sample + (size_t)rs * D + c0), gt = *(const f32x4*)(ada + (1 + rt) * 3072 + 2048 + c0);
    *(f32x4*)(p.out + OUT_YS + (size_t)rs * D + c0) = xv + gt * acc[0][0];
}

__device__ __forceinline__ void transpose_tile(LAS unsigned char* lds, const float* src, int ldsrc, int scol0, int nvalid, float scale, bf16_t* dst, int ldd, int n0, int k0) {
    int tid_ = threadIdx.x; asm volatile("" : "+v"(tid_)); const int tid = tid_;
    f32x4 v[8];
#pragma unroll
    for (int i = 0; i < 8; ++i) { const int e = tid + 512 * i, k = e >> 4, n4 = (e & 15) * 4; f32x4 t = (f32x4){0.f, 0.f, 0.f, 0.f};
        if (n4 < nvalid) t = __builtin_nontemporal_load((const f32x4*)(src + (size_t)(k0 + k) * ldsrc + scol0 + n4));
        v[i] = t; }
#pragma unroll
    for (int i = 0; i < 8; ++i) { const int e = tid + 512 * i, k = e >> 4, n4 = (e & 15) * 4, m = (e & 15) & 7;
        const f32x4 t = v[i];
        *(LAS bf16_t*)(lds + (n4 + 0) * 528 + (((k >> 3) ^ m) << 4) + (k & 7) * 2) = f2bf(t[0] * scale);
        *(LAS bf16_t*)(lds + (n4 + 1) * 528 + (((k >> 3) ^ m) << 4) + (k & 7) * 2) = f2bf(t[1] * scale);
        *(LAS bf16_t*)(lds + (n4 + 2) * 528 + (((k >> 3) ^ m) << 4) + (k & 7) * 2) = f2bf(t[2] * scale);
        *(LAS bf16_t*)(lds + (n4 + 3) * 528 + (((k >> 3) ^ m) << 4) + (k & 7) * 2) = f2bf(t[3] * scale); }
    __syncthreads();
#pragma unroll
    for (int i = 0; i < 4; ++i) { const int e = tid + 512 * i, n = e >> 5, kc = e & 31; const u32x4 w = *(const LAS u32x4*)(lds + n * 528 + ((kc ^ ((n >> 2) & 7)) << 4));
        *(u32x4*)(dst + (size_t)(n0 + n) * ldd + k0 + kc * 8) = w; }
    __syncthreads();
}
__device__ __forceinline__ void ada_item(const Params& p, LAS unsigned char* lds, int slab) {
    int tid_ = threadIdx.x; asm volatile("" : "+v"(tid_)); const int tid = tid_; float* ada = (float*)(p.ws + WS_ADA);
    LAS float* sc = (LAS float*)lds;
    LAS float* red = (LAS float*)(lds + 17 * 1024 * 4);
    for (int i = tid; i < 17 * 1024; i += 512) { const int b = i >> 10, k = i & 1023; const float c = b == 0 ? p.c_prompt[k] : p.c_sample[(b - 1) * 1024 + k]; sc[i] = siluf_(c); }
    __syncthreads();
    const int nl = tid & 31, kg = tid >> 5, n = slab * 32 + nl;
    float a[17];
#pragma unroll
    for (int b = 0; b < 17; ++b) a[b] = 0.f;
    for (int k16 = 0; k16 < 4; ++k16) { float w[16]; const float* wp = p.w_ada + (size_t)(kg * 64 + k16 * 16) * 3072 + n;
#pragma unroll
        for (int i = 0; i < 16; ++i) w[i] = wp[(size_t)i * 3072];
        __builtin_amdgcn_sched_barrier(0);
#pragma unroll
        for (int k4 = 0; k4 < 4; ++k4) { const int k = kg * 64 + k16 * 16 + k4 * 4;
#pragma unroll
            for (int b = 0; b < 17; ++b) { const f32x4 s = *(const LAS f32x4*)(sc + b * 1024 + k); a[b] += s[0] * w[k4 * 4] + s[1] * w[k4 * 4 + 1] + s[2] * w[k4 * 4 + 2] + s[3] * w[k4 * 4 + 3]; } } }
#pragma unroll
    for (int b = 0; b < 17; ++b) red[(kg * 17 + b) * 32 + nl] = a[b];
    __syncthreads();
    for (int i = tid; i < 17 * 32; i += 512) { const int b = i >> 5, c = i & 31; float s = p.b_ada[slab * 32 + c];
#pragma unroll
        for (int g = 0; g < 16; ++g) s += red[(g * 17 + b) * 32 + c];
        ada[b * 3072 + slab * 32 + c] = s; }
    __syncthreads();
}
__device__ __forceinline__ void phase0(const Params& p, LAS unsigned char* lds) {
    bf16_t* bt1 = (bf16_t*)((unsigned char*)p.out + RB_BT1); bf16_t* bta = (bf16_t*)(p.ws + WS_BTA); bf16_t* btb = (bf16_t*)(p.ws + WS_BTB); bf16_t* bto = (bf16_t*)(p.ws + WS_BTO);
    constexpr int N_ADA = 96, N_T1 = (N1 / 64) * 4, N_TS = 64;
    int bid_ = blockIdx.x; asm volatile("" : "+s"(bid_)); const int bid = bid_;
    for (int it = bid; it < N_ADA + N_T1 + 3 * N_TS; it += gridDim.x) {
        if (it < N_ADA) { ada_item(p, lds, it); continue; }
        int j = it - N_ADA;
        if (j < N_T1) { const int nt = j >> 2, kt = j & 3, n0 = nt * 64; int sc0, nv = 64;
            if (n0 < 3072) sc0 = n0;
            else if (n0 < 5120) { const int t = (n0 - 3072) >> 8, w = (n0 - 3072) & 255; sc0 = w < 128 ? 3088 + t * 128 + w : 5136 + t * 128 + (w - 128); }
            else if (n0 < 6144) sc0 = 4112 + (n0 - 5120);
            else if (n0 < 7168) sc0 = 6160 + (n0 - 6144);
            else if (n0 < 8192) sc0 = 7184 + (n0 - 7168);
            else { sc0 = 3072; nv = 16; }
            transpose_tile(lds, p.w_in, WIN_LD, sc0, nv, n0 < 512 ? 0.08838834764831845f : 1.0f, bt1, D, n0, kt * 256); continue; }
        j -= N_T1;
        const int which = j >> 6, nt = (j & 63) >> 2, kt = j & 3;
        if (which == 0) transpose_tile(lds, p.w_proj_a, D, nt * 64, 64, 1.0f, bta, D, nt * 64, kt * 256);
        else if (which == 1) transpose_tile(lds, p.w_proj_b, D, nt * 64, 64, 1.0f, btb, D, nt * 64, kt * 256);
        else transpose_tile(lds, p.w_out, D, nt * 64, 64, 1.0f, bto, D, nt * 64, kt * 256);
    }
}
__device__ __forceinline__ void phase1(const Params& p) {
    int tid_ = threadIdx.x; asm volatile("" : "+v"(tid_)); const int tid = tid_; int bid_ = blockIdx.x; asm volatile("" : "+s"(bid_)); const int bid = bid_;
    const int lane = tid & 63, wv = tid >> 6, l15 = lane & 15, g4 = lane >> 4; const float* ada = (const float*)(p.ws + WS_ADA); bf16_t* H = (bf16_t*)((unsigned char*)p.out + RB_H);
#pragma unroll 2
    for (int row = bid * 8 + wv; row < MTOT; row += gridDim.x * 8) {
        const float* xr = row < SEQ ? p.x_prompt + (size_t)row * D : p.x_sample + (size_t)(row - SEQ) * D; const int b = row < SEQ ? 0 : 1 + ((row - SEQ) >> 4);
        f32x4 v[4]; float ss = 0.f;
#pragma unroll
        for (int i = 0; i < 4; ++i) { v[i] = __builtin_nontemporal_load((const f32x4*)(xr + i * 256 + lane * 4)); ss += (v[i][0] * v[i][0] + v[i][1] * v[i][1]) + (v[i][2] * v[i][2] + v[i][3] * v[i][3]); }
        ss = wave_sum(ss); const float rstd = rsqrtf(ss * (1.0f / D) + EPS);
#pragma unroll
        for (int i = 0; i < 4; ++i) { const int c = i * 256 + lane * 4; const f32x4 nw = *(const f32x4*)(p.norm_w + c), sh = *(const f32x4*)(ada + b * 3072 + c), scl = *(const f32x4*)(ada + b * 3072 + 1024 + c);
            const f32x4 h = v[i] * rstd * nw * (scl + 1.0f) + sh; u32x2 w; w.x = cvt_pk_bf16(h[0], h[1]); w.y = cvt_pk_bf16(h[2], h[3]); *(u32x2*)(H + (size_t)row * D + c) = w; }
    }
    asm volatile("s_waitcnt vmcnt(0)" ::: "memory");
    __syncthreads();
    float* alr = (float*)(p.ws + WS_ALR);
    const bf16_t* w16 = (const bf16_t*)((const unsigned char*)p.out + RB_BT1) + (size_t)(8192 + l15) * D + 8 * g4;
    for (int gi = wv; bid * 8 + 2048 * gi < MTOT; gi += 8) { const int r0 = bid * 8 + 2048 * gi;
        f32x4 acc = (f32x4){0.f, 0.f, 0.f, 0.f};
        const bf16_t* ap = H + (size_t)(r0 + (l15 & 7)) * D + 8 * g4;
#pragma unroll
        for (int kb = 0; kb < 2; ++kb) { bf16x8 fa[16], fb[16];
#pragma unroll
            for (int s = 0; s < 16; ++s) { fa[s] = *(const bf16x8*)(ap + (kb * 16 + s) * 32); fb[s] = *(const bf16x8*)(w16 + (kb * 16 + s) * 32); }
#pragma unroll
            for (int s = 0; s < 16; ++s) acc = MFMA16(fb[s], fa[s], acc); }
        if (l15 < 8) *(f32x4*)(alr + (size_t)(r0 + l15) * 16 + 4 * g4) = acc; }
}
__device__ __forceinline__ void gla_prep(const Params& p, LAS unsigned char* lds, int tokbase, int nchunk, int nvalid, int h, int chunk0, bool tolds, int ldsK, int ldsDV) {
    int tid_ = threadIdx.x; asm volatile("" : "+v"(tid_)); const int tid = tid_, kap = tid & 127; const int c = __builtin_amdgcn_readfirstlane(tid >> 7);
    bf16_t* proj = (bf16_t*)(p.ws + WS_PROJ); const float* alr = (const float*)(p.ws + WS_ALR); float* dch = (float*)(p.ws + WS_DCH);
    if (c < nchunk) {
        float w2[16];
#pragma unroll
        for (int j = 0; j < 16; ++j) w2[j] = p.w_a2[j * 512 + h * 128 + kap];
        const float ba = p.b_a[h * 128 + kap];
        const int tok0 = tokbase + 64 * c; float run = 0.f;
        bf16_t* kp = proj + (size_t)tok0 * PJ + PC_K + h * 128 + kap; bf16_t* qp = proj + (size_t)tok0 * PJ + PC_Q + h * 128 + kap;
        const float* ar0 = alr + (size_t)tok0 * 16;
#pragma unroll 8
        for (int t = 0; t < nvalid; ++t) { const float* ar = ar0 + t * 16; float x = ba;
#pragma unroll
            for (int j = 0; j < 16; ++j) x += ar[j] * w2[j];
            const float la = -(fmaxf(-x, 0.f) + __logf(1.0f + __expf(-fabsf(x)))) * 0.0625f; run += la;
            const float kk = bf2f(kp[(size_t)t * PJ]), qq = bf2f(qp[(size_t)t * PJ]);
            const bf16_t kt = f2bf(kk * __expf(-run)); kp[(size_t)t * PJ] = kt; qp[(size_t)t * PJ] = f2bf(qq * __expf(run));
            if (tolds) *(LAS bf16_t*)(lds + ldsK + (64 * c + t) * 272 + kap * 2) = kt; }
        const float d = __expf(run); dch[((chunk0 + c) * 4 + h) * 128 + kap] = d; if (tolds) *(LAS float*)(lds + ldsDV + (c * 128 + kap) * 4) = d;
    }
}
constexpr int LA_K = 0, LA_V0 = 69632, LA_V1 = 103424, LA_DV = 137216;
constexpr int RS_QK = 272, RS_V = 528, RS_P = 144, RS_S = 272;
__device__ __forceinline__ void gla_segA(const Params& p, LAS unsigned char* lds, int seg, int h) {
    int tid_ = threadIdx.x; asm volatile("" : "+v"(tid_));
    const int tid = tid_, lane = tid & 63, w = tid >> 6, g4 = lane >> 4, l15 = lane & 15;
    const bf16_t* proj = (const bf16_t*)(p.ws + WS_PROJ); const int tokbase = seg * (SEGCH * 64);
    u32x4 vr[4];
#pragma unroll
    for (int i = 0; i < 4; ++i) { const int e = tid + 512 * i, r = e >> 5, c = e & 31; vr[i] = *(const u32x4*)(proj + (size_t)(tokbase + r) * PJ + PC_V + h * 256 + c * 8); }
    gla_prep(p, lds, tokbase, SEGCH, 64, h, seg * SEGCH, true, LA_K, LA_DV);
#pragma unroll
    for (int i = 0; i < 4; ++i) { const int e = tid + 512 * i, r = e >> 5, c = e & 31; *(LAS u32x4*)(lds + LA_V0 + r * RS_V + c * 16) = vr[i]; }
    __syncthreads();
    f32x4 acc[8][2];
#pragma unroll
    for (int kt = 0; kt < 8; ++kt)
#pragma unroll
        for (int j2 = 0; j2 < 2; ++j2) acc[kt][j2] = (f32x4){0.f, 0.f, 0.f, 0.f};
    for (int ch = 0; ch < SEGCH; ++ch) {
        int tok1 = tokbase + (ch + 1) * 64; asm volatile("" : "+v"(tok1));
        const int vb = (ch & 1) ? LA_V1 : LA_V0, vn = (ch & 1) ? LA_V0 : LA_V1;
        if (ch + 1 < SEGCH) {
#pragma unroll
            for (int i = 0; i < 4; ++i) { const int e = tid + 512 * i, r = e >> 5, c = e & 31; vr[i] = *(const u32x4*)(proj + (size_t)(tok1 + r) * PJ + PC_V + h * 256 + c * 8); } }
#pragma unroll
        for (int ks = 0; ks < 2; ++ks) { bf16x8 Bv[2];
#pragma unroll
            for (int j2 = 0; j2 < 2; ++j2) Bv[j2] = tr_frag(lds + vb + 32 * ks * RS_V + (32 * w + 16 * j2) * 2, RS_V, lane);
#pragma unroll
            for (int kt = 0; kt < 8; ++kt) { const bf16x8 Ak = tr_frag(lds + LA_K + (64 * ch + 32 * ks) * RS_QK + 16 * kt * 2, RS_QK, lane);
#pragma unroll
                for (int j2 = 0; j2 < 2; ++j2) acc[kt][j2] = MFMA16(Ak, Bv[j2], acc[kt][j2]); } }
#pragma unroll
        for (int kt = 0; kt < 8; ++kt) { const f32x4 d = *(const LAS f32x4*)(lds + LA_DV + (ch * 128 + 16 * kt + 4 * g4) * 4);
#pragma unroll
            for (int j2 = 0; j2 < 2; ++j2) acc[kt][j2] = acc[kt][j2] * d; }
        if (ch + 1 < SEGCH) {
#pragma unroll
            for (int i = 0; i < 4; ++i) { const int e = tid + 512 * i, r = e >> 5, c = e & 31; *(LAS u32x4*)(lds + vn + r * RS_V + c * 16) = vr[i]; } }
        __syncthreads();
    }
    bf16_t* us = (bf16_t*)((unsigned char*)p.out + RB_USEG) + ((size_t)(seg * 4 + h) * 256) * 128;
#pragma unroll
    for (int kt = 0; kt < 8; ++kt)
#pragma unroll
        for (int j2 = 0; j2 < 2; ++j2) { u32x2 pk; pk.x = cvt_pk_bf16(acc[kt][j2][0], acc[kt][j2][1]); pk.y = cvt_pk_bf16(acc[kt][j2][2], acc[kt][j2][3]);
            *(u32x2*)(us + (size_t)(32 * w + 16 * j2 + l15) * 128 + 16 * kt + 4 * g4) = pk; }
    if (tid < 128) { float d = 1.f;
#pragma unroll
        for (int c = 0; c < 4; ++c) d *= *(const LAS float*)(lds + LA_DV + (c * 128 + tid) * 4);
        ((float*)(p.ws + WS_DSEG))[(seg * 4 + h) * 128 + tid] = d; }
    __syncthreads();
}
constexpr int L_DV = 6144, L_RED = 6656, L_Q = 8704, L_K = 26112, L_V = 43520, L_P = 77312, L_S = 86528;
__device__ __forceinline__ void gla_out(const Params& p, LAS unsigned char* lds, int sample, int idx  , int h, bool nostore) {
    int tid_ = threadIdx.x; asm volatile("" : "+v"(tid_));
    const int tid = tid_, lane = tid & 63, w = tid >> 6, g4 = lane >> 4, l15 = lane & 15;
    bf16_t* proj = (bf16_t*)(p.ws + WS_PROJ); const float* dch = (const float*)(p.ws + WS_DCH);
    const int nchunk = sample ? 1 : SEGCH, nvalid = sample ? SAMP_T : 64, tokbase = sample ? SEQ + idx * SAMP_T : idx * (SEGCH * 64), chunk0 = sample ? 256 + idx : idx * SEGCH;
    f32x4 acc[8][2];
    if (!sample) { const bf16_t* ss = (const bf16_t*)((unsigned char*)p.out + RB_SSTART) + ((size_t)(idx * 4 + h) * 256) * 128;
#pragma unroll
        for (int kt = 0; kt < 8; ++kt)
#pragma unroll
            for (int j2 = 0; j2 < 2; ++j2) { const u32x2 pk = *(const u32x2*)(ss + (size_t)(32 * w + 16 * j2 + l15) * 128 + 16 * kt + 4 * g4);
                acc[kt][j2] = (f32x4){bflo(pk.x), bfhi(pk.x), bflo(pk.y), bfhi(pk.y)}; }
    } else { const float* s0 = p.state_gla + (size_t)(idx * 4 + h) * 128 * 256;
#pragma unroll
        for (int kt = 0; kt < 8; ++kt)
#pragma unroll
            for (int j2 = 0; j2 < 2; ++j2)
#pragma unroll
                for (int r = 0; r < 4; ++r) acc[kt][j2][r] = s0[(size_t)(16 * kt + 4 * g4 + r) * 256 + 32 * w + 16 * j2 + l15];
    }
    if (tid < 128) {
#pragma unroll
        for (int c = 0; c < SEGCH; ++c) if (c < nchunk) *(LAS float*)(lds + (c * 128 + tid) * 4) = dch[((chunk0 + c) * 4 + h) * 128 + tid]; }
    u32x4 rq[2], rk[2], rv[4];
#define GLA_LOAD_TILES(T0) do { \
        _Pragma("unroll") for (int i = 0; i < 2; ++i) { const int e = tid + 512 * i, r = e >> 4, c = e & 15; const bool ok = r < nvalid; const bf16_t* bp = proj + (size_t)((T0) + r) * PJ + h * 128 + c * 8; \
            rq[i] = ok ? __builtin_nontemporal_load((const u32x4*)(bp + PC_Q)) : (u32x4){0u, 0u, 0u, 0u}; rk[i] = ok ? __builtin_nontemporal_load((const u32x4*)(bp + PC_K)) : (u32x4){0u, 0u, 0u, 0u}; } \
        _Pragma("unroll") for (int i = 0; i < 4; ++i) { const int e = tid + 512 * i, r = e >> 5, c = e & 31; \
            rv[i] = (r < nvalid) ? __builtin_nontemporal_load((const u32x4*)(proj + (size_t)((T0) + r) * PJ + PC_V + h * 256 + c * 8)) : (u32x4){0u, 0u, 0u, 0u}; } } while (0)
    GLA_LOAD_TILES(tokbase);
    for (int ch = 0; ch < nchunk; ++ch) {
        int tok0 = tokbase + ch * 64; asm volatile("" : "+v"(tok0));
#pragma unroll
        for (int i = 0; i < 2; ++i) { const int e = tid + 512 * i, r = e >> 4, c = e & 15; *(LAS u32x4*)(lds + L_Q + r * RS_QK + c * 16) = rq[i]; *(LAS u32x4*)(lds + L_K + r * RS_QK + c * 16) = rk[i]; }
#pragma unroll
        for (int i = 0; i < 4; ++i) { const int e = tid + 512 * i, r = e >> 5, c = e & 31; *(LAS u32x4*)(lds + L_V + r * RS_V + c * 16) = rv[i]; }
#pragma unroll
        for (int kt = 0; kt < 8; ++kt)
#pragma unroll
            for (int j2 = 0; j2 < 2; ++j2) { u32x2 pk; pk.x = cvt_pk_bf16(acc[kt][j2][0], acc[kt][j2][1]); pk.y = cvt_pk_bf16(acc[kt][j2][2], acc[kt][j2][3]);
                *(LAS u32x2*)(lds + L_S + (32 * w + 16 * j2 + l15) * RS_S + (16 * kt + 4 * g4) * 2) = pk; }
        __syncthreads();
        if (ch + 1 < nchunk) { const int tok1 = tok0 + 64; GLA_LOAD_TILES(tok1); }
#pragma unroll
        for (int e = 0; e < 2; ++e) { const int tile = 2 * w + e, st = tile >> 2, tt = tile & 3; f32x4 ap = (f32x4){0.f, 0.f, 0.f, 0.f};
            if (st <= tt) {
#pragma unroll
                for (int ks = 0; ks < 4; ++ks) { const bf16x8 A = row_frag(lds + L_K + 16 * st * RS_QK + ks * 64, RS_QK, lane), B = row_frag(lds + L_Q + 16 * tt * RS_QK + ks * 64, RS_QK, lane); ap = MFMA16(A, B, ap); } }
            const int t = 16 * tt + l15, s0 = 16 * st + 4 * g4;
            u32x2 pk; pk.x = cvt_pk_bf16(s0 <= t ? ap[0] : 0.f, s0 + 1 <= t ? ap[1] : 0.f); pk.y = cvt_pk_bf16(s0 + 2 <= t ? ap[2] : 0.f, s0 + 3 <= t ? ap[3] : 0.f);
            *(LAS u32x2*)(lds + L_P + t * RS_P + s0 * 2) = pk; }
        __syncthreads();
        u32x2 rrv[4][2];
#pragma unroll
        for (int tt = 0; tt < 4; ++tt)
#pragma unroll
            for (int j2 = 0; j2 < 2; ++j2) rrv[tt][j2] = (16 * tt + l15 < nvalid) ? *(const u32x2*)(proj + (size_t)(tok0 + 16 * tt + l15) * PJ + PC_R + h * 256 + 32 * w + 16 * j2 + 4 * g4) : (u32x2){0u, 0u};
        f32x4 ao[2][4];
#pragma unroll
        for (int j2 = 0; j2 < 2; ++j2)
#pragma unroll
            for (int tt = 0; tt < 4; ++tt) ao[j2][tt] = (f32x4){0.f, 0.f, 0.f, 0.f};
#pragma unroll
        for (int ks = 0; ks < 2; ++ks) { bf16x8 Av[2];
#pragma unroll
            for (int j2 = 0; j2 < 2; ++j2) Av[j2] = tr_frag(lds + L_V + 32 * ks * RS_V + (32 * w + 16 * j2) * 2, RS_V, lane);
#pragma unroll
            for (int tt = 0; tt < 4; ++tt) { const bf16x8 Bp = row_frag(lds + L_P + 16 * tt * RS_P + ks * 64, RS_P, lane);
#pragma unroll
                for (int j2 = 0; j2 < 2; ++j2) ao[j2][tt] = MFMA16(Av[j2], Bp, ao[j2][tt]); } }
#pragma unroll
        for (int ks = 0; ks < 4; ++ks) { bf16x8 As[2];
#pragma unroll
            for (int j2 = 0; j2 < 2; ++j2) As[j2] = row_frag(lds + L_S + (32 * w + 16 * j2) * RS_S + ks * 64, RS_S, lane);
#pragma unroll
            for (int tt = 0; tt < 4; ++tt) { const bf16x8 Bq = row_frag(lds + L_Q + 16 * tt * RS_QK + ks * 64, RS_QK, lane);
#pragma unroll
                for (int j2 = 0; j2 < 2; ++j2) ao[j2][tt] = MFMA16(As[j2], Bq, ao[j2][tt]); } }
#pragma unroll
        for (int tt = 0; tt < 4; ++tt) { float ss = 0.f;
#pragma unroll
            for (int j2 = 0; j2 < 2; ++j2) ss += (ao[j2][tt][0] * ao[j2][tt][0] + ao[j2][tt][1] * ao[j2][tt][1]) + (ao[j2][tt][2] * ao[j2][tt][2] + ao[j2][tt][3] * ao[j2][tt][3]);
            ss += __shfl_xor(ss, 16); ss += __shfl_xor(ss, 32);
            if (g4 == 0) *(LAS float*)(lds + L_RED + (w * 64 + 16 * tt + l15) * 4) = ss; }
        __syncthreads();
#pragma unroll
        for (int tt = 0; tt < 4; ++tt) { const int t = 16 * tt + l15; float tot = 0.f;
#pragma unroll
            for (int ww = 0; ww < 8; ++ww) tot += *(const LAS float*)(lds + L_RED + (ww * 64 + t) * 4);
            const float rstd = rsqrtf(tot * (1.0f / 256.0f) + EPS);
            if (t < nvalid && !nostore) {
#pragma unroll
                for (int j2 = 0; j2 < 2; ++j2) { const int v0 = 32 * w + 16 * j2 + 4 * g4; bf16_t* rp = proj + (size_t)(tok0 + t) * PJ + PC_R + h * 256 + v0;
                    const u32x2 rr = rrv[tt][j2]; const f32x4 gn = *(const f32x4*)(p.gla_norm_w + v0); const f32x4 o = ao[j2][tt];
                    u32x2 pk; pk.x = cvt_pk_bf16(o[0] * rstd * gn[0] * siluf_(bflo(rr.x)), o[1] * rstd * gn[1] * siluf_(bfhi(rr.x)));
                    pk.y = cvt_pk_bf16(o[2] * rstd * gn[2] * siluf_(bflo(rr.y)), o[3] * rstd * gn[3] * siluf_(bfhi(rr.y)));
                    *(u32x2*)rp = pk; } } }
#pragma unroll
        for (int ks = 0; ks < 2; ++ks) { bf16x8 Bv[2];
#pragma unroll
            for (int j2 = 0; j2 < 2; ++j2) Bv[j2] = tr_frag(lds + L_V + 32 * ks * RS_V + (32 * w + 16 * j2) * 2, RS_V, lane);
#pragma unroll
            for (int kt = 0; kt < 8; ++kt) { const bf16x8 Ak = tr_frag(lds + L_K + 32 * ks * RS_QK + 16 * kt * 2, RS_QK, lane);
#pragma unroll
                for (int j2 = 0; j2 < 2; ++j2) acc[kt][j2] = MFMA16(Ak, Bv[j2], acc[kt][j2]); } }
#pragma unroll
        for (int kt = 0; kt < 8; ++kt) { const f32x4 d = *(const LAS f32x4*)(lds + (ch * 128 + 16 * kt + 4 * g4) * 4);
#pragma unroll
            for (int j2 = 0; j2 < 2; ++j2) acc[kt][j2] = acc[kt][j2] * d; }
        __syncthreads();
    }
#undef GLA_LOAD_TILES
    if (sample && !nostore) { float* so = p.out + OUT_SS + (size_t)(idx * 4 + h) * 128 * 256;
#pragma unroll
        for (int kt = 0; kt < 8; ++kt)
#pragma unroll
            for (int j2 = 0; j2 < 2; ++j2)
#pragma unroll
                for (int r = 0; r < 4; ++r) so[(size_t)(16 * kt + 4 * g4 + r) * 256 + 32 * w + 16 * j2 + l15] = acc[kt][j2][r];
    }
}
constexpr int G_VN = 0, G_WS = 67584, G_ST = 102400, RS_VN = 528, RS_WS = 272;
__device__ __forceinline__ void gmlp_item(const Params& p, LAS unsigned char* lds, int chunk, int g, bool nostore = false, bool build_ws = true) {
    int tid_ = threadIdx.x; asm volatile("" : "+v"(tid_));
    const int tid = tid_, lane = tid & 63, w = tid >> 6, g4 = lane >> 4, l15 = lane & 15;
    bf16_t* proj = (bf16_t*)(p.ws + WS_PROJ); const int tok0 = chunk * 128;
    u32x4 gvr[8]; u32x2 uzr[8][2];
#pragma unroll
    for (int i = 0; i < 8; ++i) { const int e = tid + 512 * i, r = e >> 5, c = e & 31; gvr[i] = *(const u32x4*)(proj + (size_t)(tok0 + r) * PJ + PC_GV + g * 256 + c * 8); }
#pragma unroll
    for (int it = 0; it < 8; ++it)
#pragma unroll
        for (int j2 = 0; j2 < 2; ++j2) uzr[it][j2] = *(const u32x2*)(proj + (size_t)(tok0 + 16 * it + l15) * PJ + PC_UZ + g * 256 + 32 * w + 16 * j2 + 4 * g4);
    if (tid < 128) { const float* gp = (const float*)(p.ws + WS_GVST) + (size_t)(tok0 + tid) * 32; float s = 0.f, q = 0.f;
#pragma unroll
        for (int k = 0; k < 8; ++k) { const f32x4 v = *(const f32x4*)(gp + 4 * k); s += v[0] + v[2]; q += v[1] + v[3]; }
        const float mean = s * (1.0f / 1024.0f), var = fmaxf(q * (1.0f / 1024.0f) - mean * mean, 0.f);
        *(LAS f32x2*)(lds + G_ST + tid * 8) = (f32x2){mean, rsqrtf(var + EPS)}; }
    if (build_ws)
#pragma unroll
    for (int i = 0; i < 8; ++i) { const int e = tid + 512 * i, r = e >> 5, j4 = (e & 31) * 4; f32x4 v = *(const f32x4*)(p.w_s + (size_t)(g * 128 + r) * 128 + j4);
        if (r < 64 && j4 >= 64) v = (f32x4){0.f, 0.f, 0.f, 0.f};
        u32x2 pk; pk.x = cvt_pk_bf16(v[0], v[1]); pk.y = cvt_pk_bf16(v[2], v[3]); *(LAS u32x2*)(lds + G_WS + r * RS_WS + j4 * 2) = pk; }
    __syncthreads();
#pragma unroll
    for (int i = 0; i < 8; ++i) { const int e = tid + 512 * i, r = e >> 5, c = e & 31; const u32x4 a = gvr[i];
        const f32x2 st = *(const LAS f32x2*)(lds + G_ST + r * 8); const float* lw = p.ln_v_w + g * 256 + c * 8; const float* lb = p.ln_v_b + g * 256 + c * 8;
        const f32x4 w0 = *(const f32x4*)lw, w1 = *(const f32x4*)(lw + 4), b0 = *(const f32x4*)lb, b1 = *(const f32x4*)(lb + 4);
        u32x4 o; o.x = cvt_pk_bf16((bflo(a.x) - st[0]) * st[1] * w0[0] + b0[0], (bfhi(a.x) - st[0]) * st[1] * w0[1] + b0[1]);
        o.y = cvt_pk_bf16((bflo(a.y) - st[0]) * st[1] * w0[2] + b0[2], (bfhi(a.y) - st[0]) * st[1] * w0[3] + b0[3]);
        o.z = cvt_pk_bf16((bflo(a.z) - st[0]) * st[1] * w1[0] + b1[0], (bfhi(a.z) - st[0]) * st[1] * w1[1] + b1[1]);
        o.w = cvt_pk_bf16((bflo(a.w) - st[0]) * st[1] * w1[2] + b1[2], (bfhi(a.w) - st[0]) * st[1] * w1[3] + b1[3]);
        *(LAS u32x4*)(lds + G_VN + r * RS_VN + c * 16) = o; }
    __syncthreads();
    f32x4 acc[2][8];
#pragma unroll
    for (int j2 = 0; j2 < 2; ++j2)
#pragma unroll
        for (int it = 0; it < 8; ++it) acc[j2][it] = (f32x4){0.f, 0.f, 0.f, 0.f};
#pragma unroll
    for (int ks = 0; ks < 4; ++ks) { bf16x8 Av[2];
#pragma unroll
        for (int j2 = 0; j2 < 2; ++j2) Av[j2] = tr_frag(lds + G_VN + 32 * ks * RS_VN + (32 * w + 16 * j2) * 2, RS_VN, lane);
#pragma unroll
        for (int it = 0; it < 8; ++it) { if (ks >= 2 && it < 4) continue; const bf16x8 Bw = row_frag(lds + G_WS + 16 * it * RS_WS + ks * 64, RS_WS, lane);
#pragma unroll
            for (int j2 = 0; j2 < 2; ++j2) acc[j2][it] = MFMA16(Av[j2], Bw, acc[j2][it]); } }
#pragma unroll
    for (int it = 0; it < 8; ++it) { const int i = 16 * it + l15; const float bs = p.b_s[g * 128 + i];
#pragma unroll
        for (int j2 = 0; j2 < 2; ++j2) { bf16_t* rp = proj + (size_t)(tok0 + i) * PJ + PC_UZ + g * 256 + 32 * w + 16 * j2 + 4 * g4; const u32x2 uz = uzr[it][j2]; const f32x4 a = acc[j2][it];
            u32x2 pk; pk.x = cvt_pk_bf16(bflo(uz.x) * (a[0] + bs), bfhi(uz.x) * (a[1] + bs)); pk.y = cvt_pk_bf16(bflo(uz.y) * (a[2] + bs), bfhi(uz.y) * (a[3] + bs)); if (!nostore) *(u32x2*)rp = pk; } }
    __syncthreads();
}
__device__ __forceinline__ void gmlp_sample_item(const Params& p, LAS unsigned char* lds, int b, bool nostore = false) {
    int tid_ = threadIdx.x; asm volatile("" : "+v"(tid_));
    const int tid = tid_, lane = tid & 63, w = tid >> 6; bf16_t* proj = (bf16_t*)(p.ws + WS_PROJ); const int tok0 = SEQ + b * SAMP_T;
    LAS float* vn = (LAS float*)lds; LAS float* wsm = (LAS float*)(lds + 65536); LAS float* st = (LAS float*)(lds + 65536 + 4096);
    for (int i = 0; i < 2; ++i) { const int r = 2 * w + i; const bf16_t* rp = proj + (size_t)(tok0 + r) * PJ + PC_GV;
        const u32x4 a = *(const u32x4*)(rp + lane * 8), bb = *(const u32x4*)(rp + 512 + lane * 8);
        float x[16]; x[0] = bflo(a.x); x[1] = bfhi(a.x); x[2] = bflo(a.y); x[3] = bfhi(a.y); x[4] = bflo(a.z); x[5] = bfhi(a.z); x[6] = bflo(a.w); x[7] = bfhi(a.w);
        x[8] = bflo(bb.x); x[9] = bfhi(bb.x); x[10] = bflo(bb.y); x[11] = bfhi(bb.y); x[12] = bflo(bb.z); x[13] = bfhi(bb.z); x[14] = bflo(bb.w); x[15] = bfhi(bb.w);
        float s = 0.f;
#pragma unroll
        for (int k = 0; k < 16; ++k) s += x[k];
        const float mean = wave_sum(s) * (1.0f / 1024.0f); float q = 0.f;
#pragma unroll
        for (int k = 0; k < 16; ++k) { const float d = x[k] - mean; q += d * d; }
        const float rstd = rsqrtf(wave_sum(q) * (1.0f / 1024.0f) + EPS);
        if (lane == 0) { st[r * 2] = mean; st[r * 2 + 1] = rstd; } }
    for (int e = tid; e < 1024; e += 512) { const int g = e >> 8, i = (e >> 4) & 15, j = e & 15; wsm[e] = p.w_s[(size_t)(g * 128 + i) * 128 + j]; }
    __syncthreads();
    float* vs = p.out + OUT_VS + (size_t)b * SAMP_T * 1024;
    for (int i = 0; i < 4; ++i) { const int e = tid + 512 * i, r = e >> 7, c = (e & 127) * 8; const u32x4 a = *(const u32x4*)(proj + (size_t)(tok0 + r) * PJ + PC_GV + c);
        const float mean = st[r * 2], rstd = st[r * 2 + 1]; const f32x4 w0 = *(const f32x4*)(p.ln_v_w + c), w1 = *(const f32x4*)(p.ln_v_w + c + 4), b0 = *(const f32x4*)(p.ln_v_b + c), b1 = *(const f32x4*)(p.ln_v_b + c + 4);
        f32x4 o0, o1; o0[0] = (bflo(a.x) - mean) * rstd * w0[0] + b0[0]; o0[1] = (bfhi(a.x) - mean) * rstd * w0[1] + b0[1]; o0[2] = (bflo(a.y) - mean) * rstd * w0[2] + b0[2]; o0[3] = (bfhi(a.y) - mean) * rstd * w0[3] + b0[3];
        o1[0] = (bflo(a.z) - mean) * rstd * w1[0] + b1[0]; o1[1] = (bfhi(a.z) - mean) * rstd * w1[1] + b1[1]; o1[2] = (bflo(a.w) - mean) * rstd * w1[2] + b1[2]; o1[3] = (bfhi(a.w) - mean) * rstd * w1[3] + b1[3];
        *(LAS f32x4*)(vn + r * 1024 + c) = o0; *(LAS f32x4*)(vn + r * 1024 + c + 4) = o1; *(f32x4*)(vs + r * 1024 + c) = o0; *(f32x4*)(vs + r * 1024 + c + 4) = o1; }
    __syncthreads();
    { const int c = tid * 2, g = c >> 8; f32x2 v[16];
#pragma unroll
      for (int j = 0; j < 16; ++j) v[j] = *(const LAS f32x2*)(vn + j * 1024 + c);
#pragma unroll
      for (int i = 0; i < 16; ++i) { float s0 = p.b_s[g * 128 + i], s1 = s0;
#pragma unroll
          for (int j = 0; j < 16; ++j) { const float wv = wsm[g * 256 + i * 16 + j]; s0 += wv * v[j][0]; s1 += wv * v[j][1]; }
          bf16_t* rp = proj + (size_t)(tok0 + i) * PJ + PC_UZ + c; const unsigned uz = *(const unsigned*)rp; if (!nostore) *(unsigned*)rp = cvt_pk_bf16(bflo(uz) * s0, bfhi(uz) * s1); } }
    __syncthreads();
}
__device__ __forceinline__ void phase4(const Params& p) {
    const unsigned* useg = (const unsigned*)((unsigned char*)p.out + RB_USEG); unsigned* sst = (unsigned*)((unsigned char*)p.out + RB_SSTART); const float* dseg = (const float*)(p.ws + WS_DSEG);
    int tid_ = threadIdx.x; asm volatile("" : "+v"(tid_)); const int tid = tid_; int bid_ = blockIdx.x; asm volatile("" : "+s"(bid_)); const int bid = bid_;
    for (int e2 = bid * 512 + tid; e2 < 65536; e2 += gridDim.x * 512) {
        const int e = e2 * 2, h = e >> 15, v = (e >> 7) & 255, kap = e & 127; float S0 = 0.f, S1 = 0.f;
        for (int s0 = 0; s0 < NSEG; s0 += 32) { unsigned u[32]; f32x2 dd[32];
#pragma unroll
            for (int s = 0; s < 32; ++s) { u[s] = __builtin_nontemporal_load(useg + (size_t)(s0 + s) * 65536 + e2); dd[s] = *(const f32x2*)(dseg + ((s0 + s) * 4 + h) * 128 + kap); }
#pragma unroll
            for (int s = 0; s < 32; ++s) { sst[(size_t)(s0 + s) * 65536 + e2] = cvt_pk_bf16(S0, S1); S0 = dd[s][0] * S0 + bflo(u[s]); S1 = dd[s][1] * S1 + bfhi(u[s]); } }
        p.out[OUT_SP + (size_t)(h * 128 + kap) * 256 + v] = S0; p.out[OUT_SP + (size_t)(h * 128 + kap + 1) * 256 + v] = S1; }
}
__device__ __forceinline__ void phase8(const Params& p, bool nostore = false) {
    int tid_ = threadIdx.x; asm volatile("" : "+v"(tid_)); const int tid = tid_; int bid_ = blockIdx.x; asm volatile("" : "+s"(bid_)); const int bid = bid_;
    const int lane = tid & 63, wv = tid >> 6;
    for (int row = SEQ + bid * 8 + wv; row < MTOT; row += gridDim.x * 8) { float* yr = p.out + (size_t)row * D;
        f32x4 v[4]; float ss = 0.f;
#pragma unroll
        for (int i = 0; i < 4; ++i) { v[i] = *(const f32x4*)(yr + i * 256 + lane * 4); ss += (v[i][0] * v[i][0] + v[i][1] * v[i][1]) + (v[i][2] * v[i][2] + v[i][3] * v[i][3]); }
        const float rstd = rsqrtf(wave_sum(ss) * (1.0f / D) + EPS);
#pragma unroll
        for (int i = 0; i < 4; ++i) { const int c = i * 256 + lane * 4; const f32x4 fw = *(const f32x4*)(p.final_norm_w + c); if (!nostore) *(f32x4*)(yr + c) = v[i] * rstd * fw; } }
}

__global__ __launch_bounds__(512, 2) void mega(Params p0) {
    extern __shared__ __attribute__((aligned(16))) unsigned char shm[];
    LAS unsigned char* lds = (LAS unsigned char*)shm;
    const bool multi = (p0.ph_hi - p0.ph_lo) > 1;
    if (multi) { volatile LAS unsigned* st = (volatile LAS unsigned*)(lds + LDS_BAR);
        if (threadIdx.x == 0) { st[0] = 0u; st[1] = 0u; }
        __syncthreads();
        (void)xcd_barrier_post((unsigned*)(p0.ws + WS_CTL), st); }
#ifdef PROBE_PH
    constexpr int PDUP = PROBE_PH >= 30 ? 3 : (PROBE_PH >= 20 ? 2 : PROBE_PH);
    const int nph = p0.ph_hi + 1;
#else
    const int nph = p0.ph_hi;
#endif
    for (int pi = p0.ph_lo; pi < nph; ++pi) {
#if defined(__HIP_DEVICE_COMPILE__)
        const __attribute__((address_space(4))) Params* kp = (const __attribute__((address_space(4))) Params*)__builtin_amdgcn_kernarg_segment_ptr();
        asm volatile("" : "+s"(kp));
        const Params p = *kp;
#else
        const Params p = p0;
#endif
        int bid_ = blockIdx.x; asm volatile("" : "+s"(bid_)); const int bid = bid_;
#ifdef PROBE_PH
        const int ph = pi > PDUP ? pi - 1 : pi; const bool first = (pi == PDUP); const bool nostore = first && (p.ph_hi < 100);
#else
        const int ph = pi; const bool nostore = false;
#endif
      {
        if (ph == 0) phase0(p, lds);
        else if (ph == 1) phase1(p);
        else if (ph == 2) { pg8::Order S; S.init(SEQ / 256, 32, gridDim.x, bid); Ptr1 P{(const char*)p.out + RB_H, (const char*)p.out + RB_BT1};
            Epi1 E{(bf16_t*)(p.ws + WS_PROJ), (float*)(p.ws + WS_GVST)};
#ifdef PROBE_PH
            if (!(first && PROBE_PH == 20)) pg8::gemm_phase<Epi1, Ptr1, pg8::Order>(lds, S, P, E, D, D, D);
            if (!(first && PROBE_PH == 21)) sample_gemm1(p, lds, bid);
#else
            if (bid & 8) sample_gemm1(p, lds, bid); pg8::gemm_phase<Epi1, Ptr1, pg8::Order>(lds, S, P, E, D, D, D); if (!(bid & 8)) sample_gemm1(p, lds, bid);
#endif
            }
        else if (ph == 3) {
            const int pm = (bid & 7) * 8 + (bid >> 5), hg = (bid >> 3) & 3;
            gla_segA(p, lds, pm, hg);
            gmlp_item(p, lds, 2 * pm, hg, nostore, true);
            gmlp_item(p, lds, 2 * pm + 1, hg, nostore, false);
            if (bid >= 16 && bid < 80) { const int it = bid - 16; gla_prep(p, lds, SEQ + (it >> 2) * SAMP_T, 1, SAMP_T, it & 3, 256 + (it >> 2), false, 0, 0); __syncthreads(); } }
        else if (ph == 4) { phase4(p); if (bid >= 128 && bid < 192) gla_out(p, lds, 1, (bid - 128) >> 2, (bid - 128) & 3, nostore);
            else if (bid >= 192 && bid < 208) gmlp_sample_item(p, lds, bid - 192, nostore); }
        else if (ph == 5) {
            gla_out(p, lds, 0, (bid & 7) * 8 + (bid >> 5), (bid >> 3) & 3, nostore); }
        else if (ph == 6) { pg8::Order2 S; S.c = bid; Ptr2 P{(const char*)(p.ws + WS_PROJ), (const char*)(p.ws + WS_BTA), (const char*)(p.ws + WS_BTB)};
            Epi2 E{(bf16_t*)(p.ws + WS_PROJ), p.b_gate, nostore}; if (bid & 32) sample_gemm2(p, bid, nostore); pg8::gemm_phase<Epi2, Ptr2, pg8::Order2>(lds, S, P, E, D, PJ, D); if (!(bid & 32)) sample_gemm2(p, bid, nostore); }
        else if (ph == 7) { pg8::Order S; S.init(SEQ / 256, 4, gridDim.x, bid); Ptr3 P{(const char*)(p.ws + WS_PROJ), (const char*)(p.ws + WS_BTO)};
            Epi3 E{p.x_prompt, (const float*)(p.ws + WS_ADA), p.final_norm_w, p.out, (float*)(p.ws + WS_XB), (unsigned*)(p.ws + WS_PCNT)}; if (bid & 8) sample_gemm3(p, bid); pg8::gemm_phase<Epi3, Ptr3, pg8::Order>(lds, S, P, E, D, PJ, D); if (!(bid & 8)) sample_gemm3(p, bid); }
        else if (ph == 8) phase8(p, nostore);
      }
        if (multi && pi + 1 < nph) { XcdBarrier xb; xb.bar = (unsigned*)(p.ws + WS_CTL); xb.x = xb_xcc_id(); xb.st = (volatile LAS unsigned*)(lds + LDS_BAR); xcd_barrier(xb); }
    }
}

#ifndef MK_LAUNCHES
#define MK_LAUNCHES 1
#endif
extern "C" void kernel_launch(void* const* d_in, const int* in_sizes, int n_in, void* d_out, int out_size, void* d_ws, size_t ws_size, hipStream_t stream) {
    static int ready = 0;
    if (ready == 0) {
        if (n_in != 21 || ws_size < WS_END) { fprintf(stderr, "kernel_launch: need 21 inputs and >= %zu bytes of workspace (got %d, %zu)\n", (size_t)WS_END, n_in, ws_size); ready = -1; return; }
        if (hipFuncSetAttribute((const void*)mega, hipFuncAttributeMaxDynamicSharedMemorySize, LDS_BYTES) != hipSuccess) { fprintf(stderr, "kernel_launch: hipFuncSetAttribute failed\n"); ready = -1; return; }
        int per_cu = 0; (void)hipOccupancyMaxActiveBlocksPerMultiprocessor(&per_cu, (const void*)mega, 512, LDS_BYTES); (void)hipGetLastError();
        if (per_cu < 1) fprintf(stderr, "kernel_launch: occupancy query reports %d blocks per CU\n", per_cu);
        ready = 1;
    }
    if (ready < 0) return;
    (void)hipMemsetAsync((char*)d_ws + WS_CTL, 0, 32768, stream);
    Params p{};
    const float** pp = (const float**)&p;
    for (int i = 0; i < 21; ++i) pp[i] = (const float*)d_in[i];
    p.out = (float*)d_out; p.ws = (unsigned char*)d_ws;
    const int nl = MK_LAUNCHES;
    for (int li = 0; li < nl; ++li) {
        p.ph_lo = (nl == 1) ? 0 : li; p.ph_hi = (nl == 1) ? 9 : li + 1;
        void* args[] = {&p};
        hipError_t e;
        if (nl == 1) e = hipLaunchCooperativeKernel((const void*)mega, dim3(256), dim3(512), args, LDS_BYTES, stream);
        else { hipLaunchKernelGGL(mega, dim3(256), dim3(512), LDS_BYTES, stream, p); e = hipPeekAtLastError(); }
        if (e != hipSuccess) { fprintf(stderr, "kernel_launch: launch %d failed: %s\n", li, hipGetErrorString(e)); break; }
    }
}
```
